# Optimizing an MI355X kernel written in HIP

```python
import math
import jax, jax.numpy as jnp
from jax import lax
import numpy as np

D_MODEL = 1024
BATCH = 8
SEQ = 4096
DEPTH = 1
DEC_BATCH = 128
DEC_SEQ = 1
PAST_LEN = 16384
PAGE_SIZE = 128

ATT_HEADS = 8
ATT_KV_HEADS = 2
ATT_GROUP = ATT_HEADS // ATT_KV_HEADS
HEAD_DIM = 64
WINDOW = 128
ATT_BLOCK = WINDOW
ROPE_DIMS = HEAD_DIM // 4
ROPE_THETA = 500000.0
RET_HEADS = 4
RET_DK = 128
RET_DV = 128
RET_CHUNK = 128
RET_THETA = 10000.0
ATT_WIDTH = ATT_HEADS * HEAD_DIM
KV_WIDTH = ATT_KV_HEADS * HEAD_DIM
RET_QK_WIDTH = RET_HEADS * RET_DK
RET_WIDTH = RET_HEADS * RET_DV
MIX_WIDTH = ATT_WIDTH + RET_WIDTH
IN_SPLITS = (ATT_WIDTH, KV_WIDTH, KV_WIDTH, RET_QK_WIDTH, RET_QK_WIDTH, RET_WIDTH, RET_WIDTH)
IN_WIDTH = sum(IN_SPLITS)
D_FF = -(-8 * D_MODEL // (3 * 256)) * 256
DEEPNORM_ALPHA = (2 * DEPTH) ** 0.25
DEEPNORM_BETA = (8 * DEPTH) ** -0.25
LN_EPS = 1e-5
GN_EPS = 1e-6

kernel_name = 'hymba_swa_sink_retention_deepnorm_adaln_step'


def layer_norm(x, w, b):
    xf = x.astype(jnp.float32)
    mu = jnp.mean(xf, -1, keepdims=True)
    var = jnp.mean(jnp.square(xf - mu), -1, keepdims=True)
    return ((xf - mu) * lax.rsqrt(var + LN_EPS) * w.astype(jnp.float32) + b.astype(jnp.float32)).astype(x.dtype)


def rope(x, pos, n_rot, theta):
    half = n_rot // 2
    inv = theta ** (-jnp.arange(half, dtype=jnp.float32) / half)
    ang = pos.astype(jnp.float32)[:, None] * inv[None, :]
    cos = jnp.cos(ang)[:, None, :]
    sin = jnp.sin(ang)[:, None, :]
    xf = x.astype(jnp.float32)
    x1 = xf[..., :half]
    x2 = xf[..., half:n_rot]
    out = jnp.concatenate([x1 * cos - x2 * sin, x2 * cos + x1 * sin, xf[..., n_rot:]], -1)
    return out.astype(x.dtype)


def ada_mod(c, w_ada, b_ada):
    m = jax.nn.silu(c) @ w_ada + b_ada
    shift, scale, gate = jnp.split(m, 3, axis=-1)
    return shift[:, None, :], scale[:, None, :], gate[:, None, :]


def project_in(h, w_in):
    z = h @ w_in
    return jnp.split(z, np.cumsum(IN_SPLITS)[:-1].tolist(), axis=-1)


def attend(q, k, v, qpos, kpos, sinks):
    s = jnp.einsum('bnqhgd,bnkhd->bnhgqk', q, k).astype(jnp.float32) * (HEAD_DIM ** -0.5)
    dist = qpos[:, :, None] - kpos[:, None, :]
    mask = (dist >= 0) & (dist <= WINDOW) & (kpos[:, None, :] >= 0)
    s = jnp.where(mask[None, :, None, None], s, -jnp.inf)
    sink = sinks.astype(jnp.float32).reshape(ATT_KV_HEADS, ATT_GROUP)[None, None, :, :, None, None]
    m = jnp.maximum(jnp.max(s, -1, keepdims=True), sink)
    p = jnp.exp(s - m)
    w = p / (jnp.sum(p, -1, keepdims=True) + jnp.exp(sink - m))
    o = jnp.einsum('bnhgqk,bnkhd->bnqhgd', w.astype(v.dtype), v)
    B, N, Lq = o.shape[:3]
    return o.reshape(B, N * Lq, ATT_WIDTH)


def retention_log_decay():
    return jnp.log1p(-jnp.exp(jnp.linspace(math.log(1.0 / 32), math.log(1.0 / 512), RET_HEADS))).astype(jnp.float32)


def retention_chunk(S, q, k, v, log_gamma):
    q = q.astype(jnp.float32)
    k = k.astype(jnp.float32)
    v = v.astype(jnp.float32)
    Sf = S.astype(jnp.float32)
    L = q.shape[1]
    idx = jnp.arange(L, dtype=jnp.float32)
    diff = idx[:, None] - idx[None, :]
    decay = jnp.where(diff[None] >= 0, jnp.exp(log_gamma[:, None, None] * jnp.maximum(diff, 0.0)[None]), 0.0)
    scores = jnp.einsum('bihd,bjhd->bhij', q, k) * decay[None]
    o = jnp.einsum('bhij,bjhe->bihe', scores, v)
    q_dec = q * jnp.exp(log_gamma[None, :] * (idx[:, None] + 1.0))[None, :, :, None]
    o = o + jnp.einsum('bihd,bhde->bihe', q_dec, Sf)
    k_dec = k * jnp.exp(log_gamma[None, :] * (L - 1.0 - idx[:, None]))[None, :, :, None]
    S_new = jnp.exp(log_gamma * L)[None, :, None, None] * Sf + jnp.einsum('bjhd,bjhe->bhde', k_dec, v)
    return S_new.astype(S.dtype), o


def retention_output(o, g, gn_w):
    mu = jnp.mean(o, -1, keepdims=True)
    var = jnp.mean(jnp.square(o - mu), -1, keepdims=True)
    n = ((o - mu) * lax.rsqrt(var + GN_EPS)).reshape(o.shape[0], o.shape[1], RET_WIDTH)
    n = n * gn_w.astype(jnp.float32)
    return (jax.nn.silu(g.astype(jnp.float32)) * n).astype(g.dtype)


def split_heads(q, k, v, rq, rk, rv, pos):
    B, L, _ = q.shape
    q = rope(q.reshape(B, L, ATT_HEADS, HEAD_DIM), pos, ROPE_DIMS, ROPE_THETA)
    k = rope(k.reshape(B, L, ATT_KV_HEADS, HEAD_DIM), pos, ROPE_DIMS, ROPE_THETA)
    v = v.reshape(B, L, ATT_KV_HEADS, HEAD_DIM)
    rq = rope(rq.reshape(B, L, RET_HEADS, RET_DK), pos, RET_DK, RET_THETA)
    rk = rope(rk.reshape(B, L, RET_HEADS, RET_DK), pos, RET_DK, RET_THETA) * (RET_DK ** -0.5)
    rv = rv.reshape(B, L, RET_HEADS, RET_DV)
    return q, k, v, rq, rk, rv


def mixer_prompt(h, w_in, sinks, gn_w, w_out):
    B, S, _ = h.shape
    q, k, v, rq, rk, rv, rg = project_in(h, w_in)
    pos = jnp.arange(S, dtype=jnp.int32)
    q, k, v, rq, rk, rv = split_heads(q, k, v, rq, rk, rv, pos)
    nb = S // ATT_BLOCK
    qb = q.reshape(B, nb, ATT_BLOCK, ATT_KV_HEADS, ATT_GROUP, HEAD_DIM)
    kb = k.reshape(B, nb, ATT_BLOCK, ATT_KV_HEADS, HEAD_DIM)
    vb = v.reshape(B, nb, ATT_BLOCK, ATT_KV_HEADS, HEAD_DIM)
    pad = ((0, 0), (1, 0), (0, 0), (0, 0), (0, 0))
    k_band = jnp.concatenate([jnp.pad(kb, pad)[:, :-1], kb], axis=2)
    v_band = jnp.concatenate([jnp.pad(vb, pad)[:, :-1], vb], axis=2)
    qpos = pos.reshape(nb, ATT_BLOCK)
    kpos = (jnp.arange(nb, dtype=jnp.int32)[:, None] - 1) * ATT_BLOCK + jnp.arange(2 * ATT_BLOCK, dtype=jnp.int32)[None, :]
    att = attend(qb, k_band, v_band, qpos, kpos, sinks)
    nc = S // RET_CHUNK
    to_chunks = lambda t: jnp.moveaxis(t.reshape(B, nc, RET_CHUNK, RET_HEADS, t.shape[-1]), 1, 0)
    log_gamma = retention_log_decay()
    S0 = jnp.zeros((B, RET_HEADS, RET_DK, RET_DV), jnp.float32)
    S_fin, o = lax.scan(lambda st, xs: retention_chunk(st, xs[0], xs[1], xs[2], log_gamma), S0,
                        (to_chunks(rq), to_chunks(rk), to_chunks(rv)))
    o = jnp.moveaxis(o, 0, 1).reshape(B, S, RET_HEADS, RET_DV)
    ret = retention_output(o, rg, gn_w)
    y = jnp.concatenate([att, ret], -1) @ w_out
    return y, k[:, S - WINDOW:], v[:, S - WINDOW:], S_fin


def mixer_sample(h, cache_k, cache_v, state, w_in, sinks, gn_w, w_out):
    B, L, _ = h.shape
    q, k, v, rq, rk, rv, rg = project_in(h, w_in)
    pos = PAST_LEN + jnp.arange(L, dtype=jnp.int32)
    q, k, v, rq, rk, rv = split_heads(q, k, v, rq, rk, rv, pos)
    k_all = jnp.concatenate([cache_k.astype(k.dtype), k], axis=1)
    v_all = jnp.concatenate([cache_v.astype(v.dtype), v], axis=1)
    kpos = PAST_LEN - WINDOW + jnp.arange(WINDOW + L, dtype=jnp.int32)
    att = attend(q.reshape(B, 1, L, ATT_KV_HEADS, ATT_GROUP, HEAD_DIM), k_all[:, None], v_all[:, None],
                 pos[None], kpos[None], sinks)
    S_new, o = retention_chunk(state, rq, rk, rv, retention_log_decay())
    ret = retention_output(o, rg, gn_w)
    y = jnp.concatenate([att, ret], -1) @ w_out
    return y, k_all[:, L:], v_all[:, L:], S_new


def swiglu(h, w_up, w_down):
    g, u = jnp.split(h @ w_up, 2, axis=-1)
    return (jax.nn.silu(g) * u) @ w_down


def setup_inputs(seed: int = 0) -> dict:
    key = jax.random.key(seed)
    ks = jax.random.split(key, 24)
    nrm = lambda k, shape, s: jax.random.normal(k, shape, jnp.float32) * s
    D = D_MODEL
    return {
        'x_prompt': nrm(ks[0], (BATCH, SEQ, D), 1.0),
        'x_sample': nrm(ks[1], (DEC_BATCH, DEC_SEQ, D), 1.0),
        'c_prompt': nrm(ks[2], (BATCH, D), 1.0),
        'c_sample': nrm(ks[3], (DEC_BATCH, D), 1.0),
        'cache_k': nrm(ks[4], (DEPTH, DEC_BATCH, WINDOW, ATT_KV_HEADS, HEAD_DIM), 1.0),
        'cache_v': nrm(ks[5], (DEPTH, DEC_BATCH, WINDOW, ATT_KV_HEADS, HEAD_DIM), 1.0),
        'state_ret': nrm(ks[6], (DEPTH, DEC_BATCH, RET_HEADS, RET_DK, RET_DV), 0.5),
        'w_ada_mix': nrm(ks[7], (DEPTH, D, 3 * D), 0.1 * D ** -0.5),
        'b_ada_mix': nrm(ks[8], (DEPTH, 3 * D), 0.01),
        'w_in': nrm(ks[9], (DEPTH, D, IN_WIDTH), D ** -0.5),
        'att_sinks': nrm(ks[10], (DEPTH, ATT_HEADS), 1.0),
        'ret_gn_w': 1.0 + nrm(ks[11], (DEPTH, RET_WIDTH), 0.01),
        'w_out': nrm(ks[12], (DEPTH, MIX_WIDTH, D), DEEPNORM_BETA * MIX_WIDTH ** -0.5),
        'ln1_w': 1.0 + nrm(ks[13], (DEPTH, D), 0.01),
        'ln1_b': nrm(ks[14], (DEPTH, D), 0.01),
        'w_ada_ffn': nrm(ks[15], (DEPTH, D, 3 * D), 0.1 * D ** -0.5),
        'b_ada_ffn': nrm(ks[16], (DEPTH, 3 * D), 0.01),
        'w_up': nrm(ks[17], (DEPTH, D, 2 * D_FF), D ** -0.5),
        'w_down': nrm(ks[18], (DEPTH, D_FF, D), DEEPNORM_BETA * D_FF ** -0.5),
        'ln2_w': 1.0 + nrm(ks[19], (DEPTH, D), 0.01),
        'ln2_b': nrm(ks[20], (DEPTH, D), 0.01),
    }


def reference(x_prompt, x_sample, c_prompt, c_sample, cache_k, cache_v, state_ret,
              w_ada_mix, b_ada_mix, w_in, att_sinks, ret_gn_w, w_out, ln1_w, ln1_b,
              w_ada_ffn, b_ada_ffn, w_up, w_down, ln2_w, ln2_b):
    yp, ys = x_prompt, x_sample
    kp_l, vp_l, sp_l, ks_l, vs_l, ss_l = [], [], [], [], [], []
    for l in range(DEPTH):
        shp, scp, gtp = ada_mod(c_prompt, w_ada_mix[l], b_ada_mix[l])
        shs, scs, gts = ada_mod(c_sample, w_ada_mix[l], b_ada_mix[l])
        mp, kp, vp, sp = mixer_prompt(yp * (1.0 + scp) + shp, w_in[l], att_sinks[l], ret_gn_w[l], w_out[l])
        ms, ks, vs, ss = mixer_sample(ys * (1.0 + scs) + shs, cache_k[l], cache_v[l], state_ret[l],
                                      w_in[l], att_sinks[l], ret_gn_w[l], w_out[l])
        yp = layer_norm(DEEPNORM_ALPHA * yp + (1.0 + gtp) * mp, ln1_w[l], ln1_b[l])
        ys = layer_norm(DEEPNORM_ALPHA * ys + (1.0 + gts) * ms, ln1_w[l], ln1_b[l])
        shp, scp, gtp = ada_mod(c_prompt, w_ada_ffn[l], b_ada_ffn[l])
        shs, scs, gts = ada_mod(c_sample, w_ada_ffn[l], b_ada_ffn[l])
        fp = swiglu(yp * (1.0 + scp) + shp, w_up[l], w_down[l])
        fs = swiglu(ys * (1.0 + scs) + shs, w_up[l], w_down[l])
        yp = layer_norm(DEEPNORM_ALPHA * yp + (1.0 + gtp) * fp, ln2_w[l], ln2_b[l])
        ys = layer_norm(DEEPNORM_ALPHA * ys + (1.0 + gts) * fs, ln2_w[l], ln2_b[l])
        kp_l.append(kp); vp_l.append(vp); sp_l.append(sp)
        ks_l.append(ks); vs_l.append(vs); ss_l.append(ss)
    new_k_prompt = jnp.stack(kp_l, 0)
    new_v_prompt = jnp.stack(vp_l, 0)
    new_ret_prompt = jnp.stack(sp_l, 0)
    new_k_sample = jnp.stack(ks_l, 0)
    new_v_sample = jnp.stack(vs_l, 0)
    new_ret_sample = jnp.stack(ss_l, 0)
    return (yp, ys, new_k_prompt, new_v_prompt, new_ret_prompt, new_k_sample, new_v_sample, new_ret_sample)
```

```cpp
#include <hip/hip_runtime.h>
#include <hip/hip_cooperative_groups.h>
#include <cstdio>
namespace cg = cooperative_groups;

#define LAS __attribute__((address_space(3)))
typedef unsigned short bf16_t;
typedef short bf16x8 __attribute__((ext_vector_type(8)));
typedef float f32x4 __attribute__((ext_vector_type(4)));
typedef unsigned u32x4 __attribute__((ext_vector_type(4)));
typedef unsigned u32x2 __attribute__((ext_vector_type(2)));

constexpr int DM = 1024, SEQ = 4096, NBATCH = 8, TP = NBATCH * SEQ  , NS = 128, TV = TP + NS  , TPAD = TP + 256  ;
constexpr int INW = 2816, DFF = 2816, PAST = 16384;
constexpr float ALPHA = 1.189207115002721f;
constexpr float RK_SCALE = 0.08838834764831845f;
constexpr size_t O_YP = 0, O_YS = (size_t)TP * DM, O_KP = O_YS + (size_t)NS * DM, O_VP = O_KP + 131072, O_RP = O_VP + 131072,
                 O_KS = O_RP + 524288, O_VS = O_KS + 2097152, O_RS = O_VS + 2097152;
constexpr size_t al256(size_t x) { return (x + 255) & ~(size_t)255; }
constexpr size_t WS_WIN = 0;
constexpr size_t WS_WOUT = WS_WIN + (size_t)INW * DM * 2;
constexpr size_t WS_WUP = WS_WOUT + (size_t)DM * DM * 2;
constexpr size_t WS_WDOWN = WS_WUP + (size_t)2 * DFF * DM * 2;
constexpr size_t WS_WADA = WS_WDOWN + (size_t)DM * DFF * 2;
constexpr size_t WS_SC = WS_WADA + (size_t)6144 * DM * 2;
constexpr size_t WS_MOD = WS_SC + (size_t)256 * DM * 2;
constexpr size_t WS_ROPEA = WS_MOD + (size_t)256 * 6144 * 4;
constexpr size_t WS_ROPER = al256(WS_ROPEA + (size_t)4097 * 16 * 4);
constexpr size_t WS_STAT1 = al256(WS_ROPER + (size_t)4097 * 128 * 4);
constexpr size_t WS_STAT2 = WS_STAT1 + (size_t)TPAD * 2 * 4;
constexpr size_t WS_H = al256(WS_STAT2 + (size_t)TPAD * 2 * 4);
constexpr size_t WS_Z = WS_H + (size_t)TPAD * DM * 2;
constexpr size_t WS_MIX = WS_Z + (size_t)TPAD * INW * 2;
constexpr size_t WS_SST = WS_MIX + (size_t)TPAD * DM * 2;
constexpr size_t WS_END = WS_SST + (size_t)1024 * 16384 * 2;

struct Params {
    const float *x_prompt, *x_sample, *c_prompt, *c_sample, *cache_k, *cache_v, *state_ret, *w_ada_mix, *b_ada_mix, *w_in, *att_sinks, *ret_gn_w, *w_out,
        *ln1_w, *ln1_b, *w_ada_ffn, *b_ada_ffn, *w_up, *w_down, *ln2_w, *ln2_b;
    float* out; unsigned char* ws;
};

__device__ __forceinline__ unsigned cvt_pk_bf16(float lo, float hi) { unsigned r; asm volatile("v_cvt_pk_bf16_f32 %0, %1, %2" : "=v"(r) : "v"(lo), "v"(hi)); return r; }
__device__ __forceinline__ float bf2f(bf16_t b) { return __uint_as_float(((unsigned)b) << 16); }
__device__ __forceinline__ bf16_t f2bf(float f) { return (bf16_t)(cvt_pk_bf16(f, 0.f) & 0xffffu); }
__device__ __forceinline__ float bflo(unsigned u) { return __uint_as_float(u << 16); }
__device__ __forceinline__ float bfhi(unsigned u) { return __uint_as_float(u & 0xffff0000u); }
__device__ __forceinline__ float silu_f(float v) { return v / (1.f + __expf(-v)); }
__device__ __forceinline__ float log_gamma(int h) {
    return h == 0 ? -0.0317486983145803f : (h == 1 ? -0.012479111952334388f : (h == 2 ? -0.004933717393740471f : -0.0019550348358033506f));
}
__device__ __forceinline__ int att_dim(int p) { if (p >= 16) return p; const int g = p >> 3, j = p & 7; return j < 4 ? 4 * g + j : 8 + 4 * g + (j - 4); }
__device__ __forceinline__ int ret_dim(int p) { const int g = p >> 3, j = p & 7; return j < 4 ? 4 * g + j : 64 + 4 * g + (j - 4); }
__device__ __forceinline__ int in_col(int P) {
    if (P < 640) return (P & ~63) + att_dim(P & 63);
    if (P >= 768 && P < 1792) { const int p = (P - 768) & 127; return P - p + ret_dim(p); }
    return P;
}
__device__ __forceinline__ int up_col(int P) { const int pn = P >> 8, q = P & 255; return q < 128 ? pn * 128 + q : DFF + pn * 128 + (q - 128); }

namespace pg8 {
constexpr int BM = 256, BK = 64, HALF = 128, HTB = HALF * BK * 2, STAGE_BYTES = 8 * HTB, NXCD = 8, WGM = 8;
__device__ __forceinline__ int lds_byte(int r, int c) { const int st = (r >> 4) * 2 + (c >> 5), rr = r & 15, cc = c & 31, ob = rr * 64 + cc * 2; return st * 1024 + (ob ^ (((ob >> 9) & 1) << 5)); }
__device__ __forceinline__ void stage_rc(int b, int& R, int& C) { const int st = b / 1024, sb = b % 1024, swz = sb ^ (((sb >> 9) & 1) << 5); R = (st >> 1) * 16 + swz / 64; C = (st & 1) * 32 + (swz % 64) / 2; }
__device__ __forceinline__ int perm32(int rho) { const int n = rho >> 4, i = rho & 15; return 8 * (i >> 2) + 4 * n + (i & 3); }
struct Unit { int pm, pn; };
struct Gemm { const bf16_t* A; const bf16_t* Bt; int M, N, K; };
struct StaticOrder {
    int nM, nN, nwg, G, c;
    __device__ void init(int M, int N, int G_, int c_) { nM = M / BM; nN = N / BM; nwg = nM * nN; G = G_; c = c_; }
    __device__ bool next(int i, Unit& u) const {
        const long L = (long)i * G + c; if (L >= nwg) return false;
        int wgid = (int)L; { const int q = nwg / NXCD, r = nwg % NXCD, xcd = wgid % NXCD, off = wgid / NXCD; wgid = (xcd < r ? xcd * (q + 1) : r * (q + 1) + (xcd - r) * q) + off; }
        const int nig = WGM * nN, gid = wgid / nig, fm = gid * WGM, gsz = (nM - fm) < WGM ? (nM - fm) : WGM;
        u.pm = fm + ((wgid % nig) % gsz); u.pn = (wgid % nig) / gsz; return true;
    }
};

template <class Epi, class Sched>
__device__ __forceinline__ void gemm_phase(LAS unsigned char* lds, const Gemm g, const Sched& S, const Epi& E) {
    const int tid = threadIdx.x, wid = __builtin_amdgcn_readfirstlane(tid >> 6), lane = tid & 63, wr = wid >> 2, wc = wid & 3, fr = lane & 15, fq = lane >> 4;
    const int K = g.K, nt = K / BK;
    unsigned voffA[2], voffB[2];
#pragma unroll
    for (int i = 0; i < 2; ++i) { int R, C; stage_rc(tid * 16 + i * 8192, R, C); const int Rb = Epi::PERM ? ((R & ~31) + perm32(R & 31)) : R;
        voffA[i] = (unsigned)(R * K + C) * 2u; voffB[i] = (unsigned)(Rb * K + C) * 2u; }
    const size_t kstep = (size_t)(BK * 2);
    const size_t hstep = (size_t)HALF * K * 2;
    const size_t tstep = 2 * hstep;
    const unsigned ldsw = (unsigned)wid * 1024u;
    const int aoff = lds_byte(wr * 64 + fr, fq * 8), boff = lds_byte(wc * 32 + fr, fq * 8);
#define PG8_SA(b, h) (((b) * 2 + (h)) * HTB)
#define PG8_SB(b, h) ((4 + (b) * 2 + (h)) * HTB)
#define PG8_STAGE(bufoff, gbase, voff) do { _Pragma("unroll") for (int _i = 0; _i < 2; ++_i) \
        __builtin_amdgcn_global_load_lds((const unsigned*)((const char*)(gbase) + (voff)[_i]), (LAS unsigned*)(lds + (bufoff) + ldsw + _i * 8192), 16, 0, 0); } while (0)
#define PG8_LDA(dst, b, h) do { _Pragma("unroll") for (int m = 0; m < 4; ++m) _Pragma("unroll") for (int k = 0; k < 2; ++k) dst[m][k] = *(const LAS bf16x8*)(lds + PG8_SA(b, h) + aoff + m * 2048 + k * 1024); } while (0)
#define PG8_LDB(dst, b, h) do { _Pragma("unroll") for (int n = 0; n < 2; ++n) _Pragma("unroll") for (int k = 0; k < 2; ++k) dst[n][k] = *(const LAS bf16x8*)(lds + PG8_SB(b, h) + boff + n * 2048 + k * 1024); } while (0)
#define PG8_MMA(ai, bj, At, Bt) do { __builtin_amdgcn_s_setprio(1); _Pragma("unroll") for (int m = 0; m < 4; ++m) _Pragma("unroll") for (int n = 0; n < 2; ++n) _Pragma("unroll") for (int k = 0; k < 2; ++k) \
        acc[ai][bj][m][n] = __builtin_amdgcn_mfma_f32_16x16x32_bf16(Bt[n][k], At[m][k], acc[ai][bj][m][n], 0, 0, 0); __builtin_amdgcn_s_setprio(0); } while (0)
#define PG8_WAIT_V(n) asm volatile("s_waitcnt vmcnt(" #n ")" ::: "memory")
#define PG8_WAIT_L(n) asm volatile("s_waitcnt lgkmcnt(" #n ")" ::: "memory")
#define PG8_BAR __builtin_amdgcn_s_barrier()
#define PG8_SCHED __builtin_amdgcn_sched_barrier(0)
    Unit cur, nxt; int ui = 0;
    if (!S.next(0, cur)) return;
    f32x4 acc[2][2][4][2];
#pragma unroll
    for (int a = 0; a < 2; ++a)
#pragma unroll
        for (int b = 0; b < 2; ++b)
#pragma unroll
            for (int m = 0; m < 4; ++m)
#pragma unroll
                for (int n = 0; n < 2; ++n) acc[a][b][m][n] = (f32x4){0.f, 0.f, 0.f, 0.f};
    bf16x8 At[4][2], B0[2][2], B1[2][2];
    const char* cA = (const char*)g.A + (size_t)cur.pm * tstep; const char* cB = (const char*)g.Bt + (size_t)cur.pn * tstep;
    PG8_STAGE(PG8_SB(0, 0), cB, voffB); PG8_STAGE(PG8_SA(0, 0), cA, voffA); PG8_STAGE(PG8_SB(0, 1), cB + hstep, voffB); PG8_STAGE(PG8_SA(0, 1), cA + hstep, voffA);
    if (wr == 1) PG8_BAR;
    PG8_WAIT_V(4); PG8_BAR;
    PG8_STAGE(PG8_SB(1, 0), cB + kstep, voffB); PG8_STAGE(PG8_SA(1, 0), cA + kstep, voffA); PG8_STAGE(PG8_SB(1, 1), cB + hstep + kstep, voffB);
    PG8_WAIT_V(6); PG8_BAR;
    for (;;) {
        const bool has_next = S.next(ui + 1, nxt);
        const char* nA = has_next ? (const char*)g.A + (size_t)nxt.pm * tstep : cA; const char* nB = has_next ? (const char*)g.Bt + (size_t)nxt.pn * tstep : cB;
        for (int t = 0; t < nt; t += 2) {
            const bool last = (t == nt - 2);
            const char* a1 = cA + (size_t)(t + 1) * kstep;
            const char* a2 = last ? nA : cA + (size_t)(t + 2) * kstep; const char* b2 = last ? nB : cB + (size_t)(t + 2) * kstep;
            const char* a3 = a2 + kstep; const char* b3 = b2 + kstep;
            PG8_LDB(B0, 0, 0); PG8_SCHED; PG8_LDA(At, 0, 0); PG8_STAGE(PG8_SA(1, 1), a1 + hstep, voffA);
            PG8_WAIT_L(8); PG8_BAR; PG8_WAIT_L(0); PG8_MMA(0, 0, At, B0); PG8_BAR; PG8_SCHED;
            PG8_LDB(B1, 0, 1); PG8_STAGE(PG8_SB(0, 0), b2, voffB);
            PG8_BAR; PG8_WAIT_L(0); PG8_MMA(0, 1, At, B1); PG8_BAR;
            PG8_LDA(At, 0, 1); PG8_STAGE(PG8_SA(0, 0), a2, voffA);
            PG8_BAR; PG8_WAIT_L(0); PG8_MMA(1, 0, At, B0); PG8_BAR; PG8_SCHED;
            PG8_STAGE(PG8_SB(0, 1), b2 + hstep, voffB);
            PG8_WAIT_V(6); PG8_BAR; PG8_MMA(1, 1, At, B1); PG8_BAR;
            PG8_LDB(B0, 1, 0); PG8_SCHED; PG8_LDA(At, 1, 0); PG8_STAGE(PG8_SA(0, 1), a2 + hstep, voffA);
            PG8_WAIT_L(8); PG8_BAR; PG8_WAIT_L(0); PG8_MMA(0, 0, At, B0); PG8_BAR; PG8_SCHED;
            PG8_LDB(B1, 1, 1); PG8_STAGE(PG8_SB(1, 0), b3, voffB);
            PG8_BAR; PG8_WAIT_L(0); PG8_MMA(0, 1, At, B1); PG8_BAR;
            PG8_LDA(At, 1, 1); PG8_STAGE(PG8_SA(1, 0), a3, voffA);
            PG8_BAR; PG8_WAIT_L(0); PG8_MMA(1, 0, At, B0); PG8_BAR; PG8_SCHED;
            PG8_STAGE(PG8_SB(1, 1), b3 + hstep, voffB);
            PG8_WAIT_V(6); PG8_BAR; PG8_MMA(1, 1, At, B1); PG8_BAR;
        }
        E(acc, cur, wr, wc, fr, fq);
        if (!has_next) break;
#pragma unroll
        for (int a = 0; a < 2; ++a)
#pragma unroll
            for (int b = 0; b < 2; ++b)
#pragma unroll
                for (int m = 0; m < 4; ++m)
#pragma unroll
                    for (int n = 0; n < 2; ++n) acc[a][b][m][n] = (f32x4){0.f, 0.f, 0.f, 0.f};
        cur = nxt; cA = nA; cB = nB; ++ui;
    }
    PG8_WAIT_V(0);
    if (wr == 0) PG8_BAR;
    PG8_BAR;
#undef PG8_SA
#undef PG8_SB
#undef PG8_STAGE
#undef PG8_LDA
#undef PG8_LDB
#undef PG8_MMA
#undef PG8_WAIT_V
#undef PG8_WAIT_L
#undef PG8_BAR
#undef PG8_SCHED
}
}
using pg8::Unit;

struct EpiAda {
    static constexpr bool PERM = false;
    float* mod; const float* b_mix; const float* b_ffn;
    __device__ __forceinline__ void operator()(const f32x4 (&acc)[2][2][4][2], const Unit& u, int wr, int wc, int fr, int fq) const {
#pragma unroll
        for (int ai = 0; ai < 2; ++ai)
#pragma unroll
            for (int m = 0; m < 4; ++m) {
                const int r = u.pm * 256 + ai * 128 + wr * 64 + m * 16 + fr;
#pragma unroll
                for (int bj = 0; bj < 2; ++bj)
#pragma unroll
                    for (int n = 0; n < 2; ++n) {
                        const int c = u.pn * 256 + bj * 128 + wc * 32 + n * 16 + fq * 4;
                        const f32x4 bv = c < 3072 ? *(const f32x4*)(b_mix + c) : *(const f32x4*)(b_ffn + c - 3072);
                        *(f32x4*)(mod + (size_t)r * 6144 + c) = acc[ai][bj][m][n] + bv;
                    }
            }
    }
};

struct EpiIn {
    static constexpr bool PERM = true;
    bf16_t* Z; const float* ropeA; const float* ropeR; float* out;
    __device__ __forceinline__ void operator()(const f32x4 (&acc)[2][2][4][2], const Unit& u, int wr, int wc, int fr, int fq) const {
#pragma unroll
        for (int bj = 0; bj < 2; ++bj) {
            const int cb128 = u.pn * 256 + bj * 128;
            const int cb = cb128 + wc * 32 + fq * 8;
            const int region = cb128 < 512 ? 0 : (cb128 < 640 ? 1 : (cb128 < 768 ? 2 : (cb128 < 1280 ? 3 : (cb128 < 1792 ? 4 : 5))));
#pragma unroll
            for (int ai = 0; ai < 2; ++ai)
#pragma unroll
                for (int m = 0; m < 4; ++m) {
                    const int r0 = u.pm * 256 + ai * 128 + wr * 64 + m * 16;
                    if (r0 >= TV) continue;
                    const int r = r0 + fr;
                    const int pos = r < TP ? (r & 4095) : 4096;
                    f32x4 v0 = acc[ai][bj][m][0], v1 = acc[ai][bj][m][1];
                    if (region <= 1) {
                        const int p = cb & 63;
                        if (p < 16) {
                            const int grp = p >> 3;
                            const f32x4 cs = *(const f32x4*)(ropeA + pos * 16 + 4 * grp), sn = *(const f32x4*)(ropeA + pos * 16 + 8 + 4 * grp);
                            const f32x4 a = v0 * cs - v1 * sn, b = v1 * cs + v0 * sn; v0 = a; v1 = b;
                        }
                    } else if (region == 3 || region == 4) {
                        const int g = (cb & 127) >> 3;
                        const f32x4 cs = *(const f32x4*)(ropeR + pos * 128 + 4 * g), sn = *(const f32x4*)(ropeR + pos * 128 + 64 + 4 * g);
                        f32x4 a = v0 * cs - v1 * sn, b = v1 * cs + v0 * sn;
                        if (region == 4) { a *= RK_SCALE; b *= RK_SCALE; }
                        v0 = a; v1 = b;
                    }
                    u32x4 pk; pk[0] = cvt_pk_bf16(v0[0], v0[1]); pk[1] = cvt_pk_bf16(v0[2], v0[3]); pk[2] = cvt_pk_bf16(v1[0], v1[1]); pk[3] = cvt_pk_bf16(v1[2], v1[3]);
                    *(u32x4*)(Z + (size_t)r * INW + cb) = pk;
                    if (region == 1 || region == 2) {
                        const int kvh = (cb >> 6) & 1, p = cb & 63;
                        int d0 = p, d1 = p + 4;
                        if (region == 1 && p < 16) { const int grp = p >> 3; d0 = 4 * grp; d1 = 8 + 4 * grp; }
                        float* dst = nullptr;
                        if (r < TP) { if (pos >= SEQ - 128) dst = out + (region == 1 ? O_KP : O_VP) + ((size_t)((r >> 12) * 128 + (pos - (SEQ - 128))) * 2 + kvh) * 64; }
                        else dst = out + (region == 1 ? O_KS : O_VS) + ((size_t)((r - TP) * 128 + 127) * 2 + kvh) * 64;
                        if (dst) { *(f32x4*)(dst + d0) = v0; *(f32x4*)(dst + d1) = v1; }
                    }
                }
        }
    }
};

struct EpiRes {
    static constexpr bool PERM = false;
    const float* baseP; const float* baseS; float* R; const float* mod; int gate_off; float* stat;
    __device__ __forceinline__ void operator()(const f32x4 (&acc)[2][2][4][2], const Unit& u, int wr, int wc, int fr, int fq) const {
#pragma unroll
        for (int ai = 0; ai < 2; ++ai)
#pragma unroll
            for (int m = 0; m < 4; ++m) {
                const int r0 = u.pm * 256 + ai * 128 + wr * 64 + m * 16;
                if (r0 >= TV) continue;
                const int r = r0 + fr;
                const int mrow = r < TP ? 128 + (r >> 12) : r - TP;
                const float* gate = mod + (size_t)mrow * 6144 + gate_off;
                const float* base = r < TP ? baseP + (size_t)r * DM : baseS + (size_t)(r - TP) * DM;
                float s = 0.f, ss = 0.f;
#pragma unroll
                for (int bj = 0; bj < 2; ++bj)
#pragma unroll
                    for (int n = 0; n < 2; ++n) {
                        const int c = u.pn * 256 + bj * 128 + wc * 32 + n * 16 + fq * 4;
                        const f32x4 xv = *(const f32x4*)(base + c), gv = *(const f32x4*)(gate + c);
                        const f32x4 res = ALPHA * xv + (1.f + gv) * acc[ai][bj][m][n];
                        *(f32x4*)(R + (size_t)r * DM + c) = res;
                        s += res[0] + res[1] + res[2] + res[3];
                        ss += res[0] * res[0] + res[1] * res[1] + res[2] * res[2] + res[3] * res[3];
                    }
                s += __shfl_xor(s, 16); ss += __shfl_xor(ss, 16);
                s += __shfl_xor(s, 32); ss += __shfl_xor(ss, 32);
                if (fq == 0) { atomicAdd(stat + 2 * r, s); atomicAdd(stat + 2 * r + 1, ss); }
            }
    }
};

struct EpiUp {
    static constexpr bool PERM = true;
    bf16_t* F;
    __device__ __forceinline__ void operator()(const f32x4 (&acc)[2][2][4][2], const Unit& u, int wr, int wc, int fr, int fq) const {
#pragma unroll
        for (int ai = 0; ai < 2; ++ai)
#pragma unroll
            for (int m = 0; m < 4; ++m) {
                const int r0 = u.pm * 256 + ai * 128 + wr * 64 + m * 16;
                if (r0 >= TV) continue;
                const int r = r0 + fr;
                float f[8];
#pragma unroll
                for (int n = 0; n < 2; ++n)
#pragma unroll
                    for (int i = 0; i < 4; ++i) { const float g = acc[ai][0][m][n][i]; f[n * 4 + i] = silu_f(g) * acc[ai][1][m][n][i]; }
                u32x4 pk; pk[0] = cvt_pk_bf16(f[0], f[1]); pk[1] = cvt_pk_bf16(f[2], f[3]); pk[2] = cvt_pk_bf16(f[4], f[5]); pk[3] = cvt_pk_bf16(f[6], f[7]);
                *(u32x4*)(F + (size_t)r * DFF + u.pn * 128 + wc * 32 + fq * 8) = pk;
            }
    }
};

__device__ void phase_prep(const Params& p, unsigned char* shm) {
    const int tid = threadIdx.x;
    bf16_t* tile = (bf16_t*)shm;
    for (int tt = blockIdx.x; tt < 4608; tt += gridDim.x) {
        const float* src; bf16_t* dst; int ld, K, mode, t;
        if (tt < 704) { t = tt; src = p.w_in; ld = INW; K = DM; dst = (bf16_t*)(p.ws + WS_WIN); mode = 1; }
        else if (tt < 960) { t = tt - 704; src = p.w_out; ld = DM; K = DM; dst = (bf16_t*)(p.ws + WS_WOUT); mode = 0; }
        else if (tt < 2368) { t = tt - 960; src = p.w_up; ld = 2 * DFF; K = DM; dst = (bf16_t*)(p.ws + WS_WUP); mode = 2; }
        else if (tt < 3072) { t = tt - 2368; src = p.w_down; ld = DM; K = DFF; dst = (bf16_t*)(p.ws + WS_WDOWN); mode = 0; }
        else if (tt < 3840) { t = tt - 3072; src = p.w_ada_mix; ld = 3072; K = DM; dst = (bf16_t*)(p.ws + WS_WADA); mode = 0; }
        else { t = tt - 3840; src = p.w_ada_ffn; ld = 3072; K = DM; dst = (bf16_t*)(p.ws + WS_WADA) + (size_t)3072 * DM; mode = 0; }
        const int nkt = K / 64, rt = t / nkt, kt = t % nkt;
        const int P = rt * 64 + (tid & 63);
        const int L = mode == 1 ? in_col(P) : (mode == 2 ? up_col(P) : P);
#pragma unroll
        for (int i = 0; i < 8; ++i) { const int k = (tid >> 6) + 8 * i; tile[(tid & 63) * 72 + k] = f2bf(src[(size_t)(kt * 64 + k) * ld + L]); }
        __syncthreads();
        { const int pr = tid >> 3, kc = tid & 7; *(u32x4*)(dst + (size_t)(rt * 64 + pr) * K + kt * 64 + kc * 8) = *(const u32x4*)(tile + pr * 72 + kc * 8); }
        __syncthreads();
    }
    const int gt = blockIdx.x * 512 + tid, gs = gridDim.x * 512;
    bf16_t* sc = (bf16_t*)(p.ws + WS_SC);
    for (int i = gt; i < 256 * DM; i += gs) { const int r = i >> 10, k = i & 1023; float v = 0.f; if (r < 128) v = silu_f(p.c_sample[r * DM + k]); else if (r < 136) v = silu_f(p.c_prompt[(r - 128) * DM + k]); sc[i] = f2bf(v); }
    float* st = (float*)(p.ws + WS_STAT1);
    for (int i = gt; i < TPAD * 4; i += gs) st[i] = 0.f;
    float* ra = (float*)(p.ws + WS_ROPEA); float* rr = (float*)(p.ws + WS_ROPER);
    for (int i = gt; i < 4097 * 72; i += gs) {
        const int pos = i / 72, f = i % 72;
        const double pv = pos < 4096 ? (double)pos : (double)PAST;
        const double inv = f < 8 ? exp(-13.122363377404328 * (double)f / 8.0) : exp(-9.210340371976184 * (double)(f - 8) / 64.0);
        const double ang = pv * inv;
        const double kk = rint(ang * 0.15915494309189535);
        const float red = (float)(ang - kk * 6.283185307179586);
        const float cs = cosf(red), sn = sinf(red);
        if (f < 8) { ra[pos * 16 + f] = cs; ra[pos * 16 + 8 + f] = sn; } else { rr[pos * 128 + (f - 8)] = cs; rr[pos * 128 + 64 + (f - 8)] = sn; }
    }
}

__device__ void phase_modulate(const Params& p) {
    const float* mod = (const float*)(p.ws + WS_MOD); bf16_t* H = (bf16_t*)(p.ws + WS_H);
    const int gt = blockIdx.x * 512 + threadIdx.x, gs = gridDim.x * 512;
    for (int i = gt; i < TV * 128; i += gs) {
        const int r = i >> 7, c = (i & 127) * 8;
        const float* xr = r < TP ? p.x_prompt + (size_t)r * DM : p.x_sample + (size_t)(r - TP) * DM;
        const int mrow = r < TP ? 128 + (r >> 12) : r - TP;
        const float* sh = mod + (size_t)mrow * 6144; const float* scl = sh + 1024;
        const f32x4 x0 = *(const f32x4*)(xr + c), x1 = *(const f32x4*)(xr + c + 4);
        const f32x4 h0 = x0 * (1.f + *(const f32x4*)(scl + c)) + *(const f32x4*)(sh + c), h1 = x1 * (1.f + *(const f32x4*)(scl + c + 4)) + *(const f32x4*)(sh + c + 4);
        u32x4 pk; pk[0] = cvt_pk_bf16(h0[0], h0[1]); pk[1] = cvt_pk_bf16(h0[2], h0[3]); pk[2] = cvt_pk_bf16(h1[0], h1[1]); pk[3] = cvt_pk_bf16(h1[2], h1[3]);
        *(u32x4*)(H + (size_t)r * DM + c) = pk;
    }
}

__device__ void attn_item(const Params& p, unsigned char* shm, int item) {
    const int tid = threadIdx.x, wid = tid >> 6, lane = tid & 63, lr = lane & 15, g = lane >> 4;
    const int b = item >> 6, kvh = (item >> 5) & 1, n = item & 31;
    const bf16_t* Z = (const bf16_t*)(p.ws + WS_Z); bf16_t* MIX = (bf16_t*)(p.ws + WS_MIX);
    bf16_t* Ks = (bf16_t*)shm;
    bf16_t* VT = Ks + 256 * 72;
    {
        const int key = tid >> 1, hf = tid & 1;
        const bool valid = (n > 0) || (key >= 128);
        const size_t row = (size_t)b * SEQ + (size_t)(n - 1) * 128 + key;
        const bf16_t* kp = Z + row * INW + 512 + kvh * 64 + hf * 32; const bf16_t* vp = Z + row * INW + 640 + kvh * 64 + hf * 32;
#pragma unroll
        for (int c = 0; c < 4; ++c) {
            u32x4 kv = (u32x4){0u, 0u, 0u, 0u}, vv = (u32x4){0u, 0u, 0u, 0u};
            if (valid) { kv = *(const u32x4*)(kp + c * 8); vv = *(const u32x4*)(vp + c * 8); }
            *(u32x4*)(Ks + key * 72 + hf * 32 + c * 8) = kv;
#pragma unroll
            for (int e = 0; e < 4; ++e) { const int d = hf * 32 + c * 8 + 2 * e; VT[d * 264 + key] = (bf16_t)(vv[e] & 0xffffu); VT[(d + 1) * 264 + key] = (bf16_t)(vv[e] >> 16); }
        }
    }
    __syncthreads();
    for (int qt = 0; qt < 4; ++qt) {
        const int T = wid * 4 + qt, hq = T >> 3, tq = T & 7, t0 = tq * 16, head = kvh * 4 + hq;
        const size_t qrow = (size_t)b * SEQ + (size_t)n * 128 + t0 + lr;
        bf16x8 Qf[2];
#pragma unroll
        for (int kk = 0; kk < 2; ++kk) Qf[kk] = *(const bf16x8*)(Z + qrow * INW + head * 64 + kk * 32 + g * 8);
        const int kt0 = tq < 6 ? tq : 6;
        f32x4 S[10];
#pragma unroll
        for (int jt = 0; jt < 10; ++jt) {
            S[jt] = (f32x4){0.f, 0.f, 0.f, 0.f};
#pragma unroll
            for (int kk = 0; kk < 2; ++kk) {
                const bf16x8 Kf = *(const bf16x8*)(Ks + (16 * (kt0 + jt) + lr) * 72 + kk * 32 + g * 8);
                S[jt] = __builtin_amdgcn_mfma_f32_16x16x32_bf16(Kf, Qf[kk], S[jt], 0, 0, 0);
            }
        }
        const float sink = p.att_sinks[head];
        const int t = t0 + lr;
        float mx = sink;
#pragma unroll
        for (int jt = 0; jt < 10; ++jt)
#pragma unroll
            for (int r = 0; r < 4; ++r) {
                const int i = 16 * (kt0 + jt) + 4 * g + r, dist = 128 + t - i;
                const bool ok = dist >= 0 && dist <= 128 && (n > 0 || i >= 128);
                const float s = ok ? S[jt][r] * 0.125f : -INFINITY;
                S[jt][r] = s; mx = fmaxf(mx, s);
            }
        mx = fmaxf(mx, __shfl_xor(mx, 16)); mx = fmaxf(mx, __shfl_xor(mx, 32));
        float sum = 0.f;
#pragma unroll
        for (int jt = 0; jt < 10; ++jt)
#pragma unroll
            for (int r = 0; r < 4; ++r) { const float e = __expf(S[jt][r] - mx); S[jt][r] = e; sum += e; }
        sum += __shfl_xor(sum, 16); sum += __shfl_xor(sum, 32);
        const float inv = 1.f / (sum + __expf(sink - mx));
        f32x4 O[4];
#pragma unroll
        for (int dt = 0; dt < 4; ++dt) O[dt] = (f32x4){0.f, 0.f, 0.f, 0.f};
#pragma unroll
        for (int jp = 0; jp < 5; ++jp) {
            u32x4 pu; pu[0] = cvt_pk_bf16(S[2 * jp][0] * inv, S[2 * jp][1] * inv); pu[1] = cvt_pk_bf16(S[2 * jp][2] * inv, S[2 * jp][3] * inv);
            pu[2] = cvt_pk_bf16(S[2 * jp + 1][0] * inv, S[2 * jp + 1][1] * inv); pu[3] = cvt_pk_bf16(S[2 * jp + 1][2] * inv, S[2 * jp + 1][3] * inv);
            const bf16x8 Pf = __builtin_bit_cast(bf16x8, pu);
#pragma unroll
            for (int dt = 0; dt < 4; ++dt) {
                const bf16_t* vr = VT + (16 * dt + lr) * 264 + 16 * (kt0 + 2 * jp) + 4 * g;
                const u32x2 a0 = *(const u32x2*)vr, a1 = *(const u32x2*)(vr + 16);
                u32x4 au; au[0] = a0[0]; au[1] = a0[1]; au[2] = a1[0]; au[3] = a1[1];
                O[dt] = __builtin_amdgcn_mfma_f32_16x16x32_bf16(__builtin_bit_cast(bf16x8, au), Pf, O[dt], 0, 0, 0);
            }
        }
#pragma unroll
        for (int dt = 0; dt < 4; ++dt) {
            u32x2 o; o[0] = cvt_pk_bf16(O[dt][0], O[dt][1]); o[1] = cvt_pk_bf16(O[dt][2], O[dt][3]);
            *(u32x2*)(MIX + qrow * DM + head * 64 + 16 * dt + 4 * g) = o;
        }
    }
    __syncthreads();
}

__device__ void retu_item(const Params& p, unsigned char* shm, int item) {
    const int tid = threadIdx.x, wid = tid >> 6, lane = tid & 63, lr = lane & 15, g = lane >> 4;
    const int b = item >> 7, h = (item >> 5) & 3, c = item & 31;
    const bf16_t* Z = (const bf16_t*)(p.ws + WS_Z); float* UT = (float*)(p.ws + WS_H);
    bf16_t* KT = (bf16_t*)shm;
    bf16_t* VT = KT + 128 * 136;
    const float lg = log_gamma(h);
    {
        const int j = tid >> 2, q = tid & 3;
        const size_t row = (size_t)b * SEQ + (size_t)c * 128 + j;
        const float dec = __expf(lg * (float)(127 - j));
        const bf16_t* kp = Z + row * INW + 1280 + h * 128 + q * 32; const bf16_t* vp = Z + row * INW + 1792 + h * 128 + q * 32;
#pragma unroll
        for (int cc = 0; cc < 4; ++cc) {
            const u32x4 kv = *(const u32x4*)(kp + cc * 8), vv = *(const u32x4*)(vp + cc * 8);
#pragma unroll
            for (int e = 0; e < 4; ++e) {
                const int d = q * 32 + cc * 8 + 2 * e;
                KT[d * 136 + j] = f2bf(bflo(kv[e]) * dec); KT[(d + 1) * 136 + j] = f2bf(bfhi(kv[e]) * dec);
                VT[d * 136 + j] = (bf16_t)(vv[e] & 0xffffu); VT[(d + 1) * 136 + j] = (bf16_t)(vv[e] >> 16);
            }
        }
    }
    __syncthreads();
    f32x4 acc[8];
#pragma unroll
    for (int dt = 0; dt < 8; ++dt) acc[dt] = (f32x4){0.f, 0.f, 0.f, 0.f};
#pragma unroll
    for (int kk = 0; kk < 4; ++kk) {
        const bf16x8 Bf = *(const bf16x8*)(VT + (16 * wid + lr) * 136 + kk * 32 + g * 8);
#pragma unroll
        for (int dt = 0; dt < 8; ++dt) {
            const bf16x8 Af = *(const bf16x8*)(KT + (16 * dt + lr) * 136 + kk * 32 + g * 8);
            acc[dt] = __builtin_amdgcn_mfma_f32_16x16x32_bf16(Af, Bf, acc[dt], 0, 0, 0);
        }
    }
    float* up = UT + (size_t)item * 16384 + (size_t)(16 * wid + lr) * 128;
#pragma unroll
    for (int dt = 0; dt < 8; ++dt) *(f32x4*)(up + 16 * dt + 4 * g) = acc[dt];
    __syncthreads();
}

__device__ void phase_scan(const Params& p) {
    const float* UT = (const float*)(p.ws + WS_H); bf16_t* SST = (bf16_t*)(p.ws + WS_SST);
    const int gt = blockIdx.x * 512 + threadIdx.x, gs = gridDim.x * 512;
    for (int i = gt; i < 32 * 16384; i += gs) {
        const int bh = i >> 14, ed = i & 16383, e = ed >> 7, d = ed & 127, h = bh & 3;
        const float gL = __expf(log_gamma(h) * 128.f);
        float s = 0.f;
        const float* up = UT + (size_t)bh * 32 * 16384 + ed; bf16_t* sp = SST + (size_t)bh * 32 * 16384 + ed;
#pragma unroll 8
        for (int c = 0; c < 32; ++c) { const float uv = up[(size_t)c * 16384]; sp[(size_t)c * 16384] = f2bf(s); s = gL * s + uv; }
        p.out[O_RP + ((size_t)bh * 128 + ret_dim(d)) * 128 + e] = s;
    }
}

__device__ void reto_item(const Params& p, unsigned char* shm, int item) {
    const int tid = threadIdx.x, wid = tid >> 6, lane = tid & 63, lr = lane & 15, g = lane >> 4;
    const int b = item >> 7, h = (item >> 5) & 3, c = item & 31;
    const bf16_t* Z = (const bf16_t*)(p.ws + WS_Z); const bf16_t* SST = (const bf16_t*)(p.ws + WS_SST); bf16_t* MIX = (bf16_t*)(p.ws + WS_MIX);
    bf16_t* Ks = (bf16_t*)shm;
    bf16_t* VT = Ks + 128 * 136;
    bf16_t* Ss = VT + 128 * 136;
    const float lg = log_gamma(h);
    const size_t row0 = (size_t)b * SEQ + (size_t)c * 128;
    {
        const int j = tid >> 2, q = tid & 3;
        const bf16_t* kp = Z + (row0 + j) * INW + 1280 + h * 128 + q * 32; const bf16_t* vp = Z + (row0 + j) * INW + 1792 + h * 128 + q * 32;
        const bf16_t* sp = SST + (size_t)item * 16384 + j * 128 + q * 32;
#pragma unroll
        for (int cc = 0; cc < 4; ++cc) {
            const u32x4 kv = *(const u32x4*)(kp + cc * 8), vv = *(const u32x4*)(vp + cc * 8), sv = *(const u32x4*)(sp + cc * 8);
            *(u32x4*)(Ks + j * 136 + q * 32 + cc * 8) = kv;
            *(u32x4*)(Ss + j * 136 + q * 32 + cc * 8) = sv;
#pragma unroll
            for (int e = 0; e < 4; ++e) { const int d = q * 32 + cc * 8 + 2 * e; VT[d * 136 + j] = (bf16_t)(vv[e] & 0xffffu); VT[(d + 1) * 136 + j] = (bf16_t)(vv[e] >> 16); }
        }
    }
    __syncthreads();
    const size_t qrow = row0 + 16 * wid + lr;
    bf16x8 Qf[4];
#pragma unroll
    for (int kk = 0; kk < 4; ++kk) Qf[kk] = *(const bf16x8*)(Z + qrow * INW + 768 + h * 128 + kk * 32 + g * 8);
    f32x4 S[8];
#pragma unroll
    for (int jt = 0; jt < 8; ++jt) {
        S[jt] = (f32x4){0.f, 0.f, 0.f, 0.f};
        if (jt <= wid) {
#pragma unroll
            for (int kk = 0; kk < 4; ++kk) {
                const bf16x8 Kf = *(const bf16x8*)(Ks + (16 * jt + lr) * 136 + kk * 32 + g * 8);
                S[jt] = __builtin_amdgcn_mfma_f32_16x16x32_bf16(Kf, Qf[kk], S[jt], 0, 0, 0);
            }
        }
    }
    const int it = 16 * wid + lr;
#pragma unroll
    for (int jt = 0; jt < 8; ++jt)
#pragma unroll
        for (int r = 0; r < 4; ++r) { const int j = 16 * jt + 4 * g + r; S[jt][r] = (j <= it) ? S[jt][r] * __expf(lg * (float)(it - j)) : 0.f; }
    f32x4 O1[8], O2[8];
#pragma unroll
    for (int et = 0; et < 8; ++et) { O1[et] = (f32x4){0.f, 0.f, 0.f, 0.f}; O2[et] = (f32x4){0.f, 0.f, 0.f, 0.f}; }
#pragma unroll
    for (int jp = 0; jp < 4; ++jp) {
        if (2 * jp <= wid) {
            u32x4 pu; pu[0] = cvt_pk_bf16(S[2 * jp][0], S[2 * jp][1]); pu[1] = cvt_pk_bf16(S[2 * jp][2], S[2 * jp][3]);
            pu[2] = cvt_pk_bf16(S[2 * jp + 1][0], S[2 * jp + 1][1]); pu[3] = cvt_pk_bf16(S[2 * jp + 1][2], S[2 * jp + 1][3]);
            const bf16x8 Pf = __builtin_bit_cast(bf16x8, pu);
#pragma unroll
            for (int et = 0; et < 8; ++et) {
                const bf16_t* vr = VT + (16 * et + lr) * 136 + 32 * jp + 4 * g;
                const u32x2 a0 = *(const u32x2*)vr, a1 = *(const u32x2*)(vr + 16);
                u32x4 au; au[0] = a0[0]; au[1] = a0[1]; au[2] = a1[0]; au[3] = a1[1];
                O1[et] = __builtin_amdgcn_mfma_f32_16x16x32_bf16(__builtin_bit_cast(bf16x8, au), Pf, O1[et], 0, 0, 0);
            }
        }
    }
#pragma unroll
    for (int kk = 0; kk < 4; ++kk)
#pragma unroll
        for (int et = 0; et < 8; ++et) {
            const bf16x8 Sf = *(const bf16x8*)(Ss + (16 * et + lr) * 136 + kk * 32 + g * 8);
            O2[et] = __builtin_amdgcn_mfma_f32_16x16x32_bf16(Sf, Qf[kk], O2[et], 0, 0, 0);
        }
    const float qd = __expf(lg * (float)(it + 1));
    float sum = 0.f;
#pragma unroll
    for (int et = 0; et < 8; ++et)
#pragma unroll
        for (int r = 0; r < 4; ++r) { const float o = O1[et][r] + qd * O2[et][r]; O1[et][r] = o; sum += o; }
    sum += __shfl_xor(sum, 16); sum += __shfl_xor(sum, 32);
    const float mu = sum * (1.f / 128.f);
    float vs = 0.f;
#pragma unroll
    for (int et = 0; et < 8; ++et)
#pragma unroll
        for (int r = 0; r < 4; ++r) { const float dlt = O1[et][r] - mu; vs += dlt * dlt; }
    vs += __shfl_xor(vs, 16); vs += __shfl_xor(vs, 32);
    const float rstd = rsqrtf(vs * (1.f / 128.f) + 1e-6f);
#pragma unroll
    for (int et = 0; et < 8; ++et) {
        const int e = 16 * et + 4 * g;
        const u32x2 gz = *(const u32x2*)(Z + qrow * INW + 2304 + h * 128 + e);
        const f32x4 gw = *(const f32x4*)(p.ret_gn_w + h * 128 + e);
        const float r0 = (O1[et][0] - mu) * rstd * gw[0] * silu_f(bflo(gz[0])), r1 = (O1[et][1] - mu) * rstd * gw[1] * silu_f(bfhi(gz[0]));
        const float r2 = (O1[et][2] - mu) * rstd * gw[2] * silu_f(bflo(gz[1])), r3 = (O1[et][3] - mu) * rstd * gw[3] * silu_f(bfhi(gz[1]));
        u32x2 o; o[0] = cvt_pk_bf16(r0, r1); o[1] = cvt_pk_bf16(r2, r3);
        *(u32x2*)(MIX + qrow * DM + 512 + h * 128 + e) = o;
    }
    __syncthreads();
}

__device__ void sample_item(const Params& p, unsigned char* shm, int b) {
    const int tid = threadIdx.x, wid = tid >> 6, lane = tid & 63;
    const bf16_t* zrow = (const bf16_t*)(p.ws + WS_Z) + (size_t)(TP + b) * INW; bf16_t* mixrow = (bf16_t*)(p.ws + WS_MIX) + (size_t)(TP + b) * DM;
    float* sm = (float*)shm;
    float* qn = sm;
    float* kn = qn + 512;
    float* vn = kn + 128;
    float* rqn = vn + 128;
    float* rkn = rqn + 512;
    float* rvv = rkn + 512;
    float* scs = rvv + 512;
    float* red = scs + 8 * 132;
    float* ov = red + 512;
    { const int hh = tid >> 6, pp = tid & 63; qn[hh * 64 + att_dim(pp)] = bf2f(zrow[tid]); }
    if (tid < 128) { const int hh = tid >> 6, pp = tid & 63; kn[hh * 64 + att_dim(pp)] = bf2f(zrow[512 + tid]); vn[tid] = bf2f(zrow[640 + tid]); }
    { const int hh = tid >> 7, pp = tid & 127; rqn[hh * 128 + ret_dim(pp)] = bf2f(zrow[768 + tid]); rkn[hh * 128 + ret_dim(pp)] = bf2f(zrow[1280 + tid]); rvv[tid] = bf2f(zrow[1792 + tid]); }
    __syncthreads();
    const float* ck = p.cache_k + (size_t)b * 128 * 128; const float* cv = p.cache_v + (size_t)b * 128 * 128;
#pragma unroll
    for (int itr = 0; itr < 2; ++itr) {
        const int idx = tid + 512 * itr, hd = idx >> 7, w = idx & 127, kvh = hd >> 2;
        const float* kr = ck + (w * 2 + kvh) * 64; const float* qr = qn + hd * 64;
        float s = 0.f;
#pragma unroll
        for (int d = 0; d < 64; d += 4) { const f32x4 kv = *(const f32x4*)(kr + d); s += qr[d] * kv[0] + qr[d + 1] * kv[1] + qr[d + 2] * kv[2] + qr[d + 3] * kv[3]; }
        scs[hd * 132 + w] = s * 0.125f;
    }
    if (tid < 8) { const int kvh = tid >> 2; float s = 0.f; for (int d = 0; d < 64; ++d) s += qn[tid * 64 + d] * kn[kvh * 64 + d]; scs[tid * 132 + 128] = s * 0.125f; }
    __syncthreads();
    {
        const float sink = p.att_sinks[wid];
        const float s0 = scs[wid * 132 + lane], s1 = scs[wid * 132 + 64 + lane], s2 = lane == 0 ? scs[wid * 132 + 128] : -INFINITY;
        float mx = fmaxf(fmaxf(s0, s1), fmaxf(s2, sink));
#pragma unroll
        for (int o = 32; o >= 1; o >>= 1) mx = fmaxf(mx, __shfl_xor(mx, o));
        const float e0 = __expf(s0 - mx), e1 = __expf(s1 - mx), e2 = lane == 0 ? __expf(s2 - mx) : 0.f;
        float sum = e0 + e1 + e2;
#pragma unroll
        for (int o = 32; o >= 1; o >>= 1) sum += __shfl_xor(sum, o);
        const float inv = 1.f / (sum + __expf(sink - mx));
        scs[wid * 132 + lane] = e0 * inv; scs[wid * 132 + 64 + lane] = e1 * inv; if (lane == 0) scs[wid * 132 + 128] = e2 * inv;
    }
    __syncthreads();
    {
        const int hd = tid >> 6, d = tid & 63, kvh = hd >> 2;
        float o = scs[hd * 132 + 128] * vn[kvh * 64 + d];
#pragma unroll 8
        for (int w = 0; w < 128; ++w) o += scs[hd * 132 + w] * cv[(w * 2 + kvh) * 64 + d];
        mixrow[hd * 64 + d] = f2bf(o);
    }
    for (int i = tid; i < 127 * 32; i += 512) {
        *(f32x4*)(p.out + O_KS + (size_t)b * 16384 + i * 4) = *(const f32x4*)(ck + 128 + i * 4);
        *(f32x4*)(p.out + O_VS + (size_t)b * 16384 + i * 4) = *(const f32x4*)(cv + 128 + i * 4);
    }
    for (int h = 0; h < 4; ++h) {
        const float gm = __expf(log_gamma(h));
        const int e = tid & 127, dq = tid >> 7;
        const float* sp = p.state_ret + ((size_t)(b * 4 + h) * 128 + dq * 32) * 128 + e;
        float* so = p.out + O_RS + ((size_t)(b * 4 + h) * 128 + dq * 32) * 128 + e;
        const float ve = rvv[h * 128 + e];
        float part = 0.f;
#pragma unroll 8
        for (int d = 0; d < 32; ++d) { const float s = sp[d * 128]; part += rqn[h * 128 + dq * 32 + d] * s; so[d * 128] = gm * s + rkn[h * 128 + dq * 32 + d] * ve; }
        red[dq * 128 + e] = part;
        __syncthreads();
        if (tid < 128) {
            float qk = 0.f;
            for (int d = 0; d < 128; ++d) qk += rqn[h * 128 + d] * rkn[h * 128 + d];
            ov[tid] = qk * ve + gm * (red[e] + red[128 + e] + red[256 + e] + red[384 + e]);
        }
        __syncthreads();
        if (tid < 128) {
            float mu = 0.f; for (int i = 0; i < 128; ++i) mu += ov[i]; mu *= (1.f / 128.f);
            float vs = 0.f; for (int i = 0; i < 128; ++i) { const float dl = ov[i] - mu; vs += dl * dl; }
            const float rstd = rsqrtf(vs * (1.f / 128.f) + 1e-6f);
            const float gz = bf2f(zrow[2304 + h * 128 + e]);
            mixrow[512 + h * 128 + e] = f2bf((ov[e] - mu) * rstd * p.ret_gn_w[h * 128 + e] * silu_f(gz));
        }
        __syncthreads();
    }
}

__device__ void phase_ln1(const Params& p) {
    const float* mod = (const float*)(p.ws + WS_MOD); const float* stat = (const float*)(p.ws + WS_STAT1); bf16_t* H = (bf16_t*)(p.ws + WS_H);
    const int gt = blockIdx.x * 512 + threadIdx.x, gs = gridDim.x * 512;
    for (int i = gt; i < TV * 128; i += gs) {
        const int r = i >> 7, c = (i & 127) * 8;
        float* yr = p.out + (size_t)r * DM + c;
        const float mu = stat[2 * r] * (1.f / 1024.f), var = stat[2 * r + 1] * (1.f / 1024.f) - mu * mu, rstd = rsqrtf(fmaxf(var, 0.f) + 1e-5f);
        const int mrow = r < TP ? 128 + (r >> 12) : r - TP;
        const float* sh = mod + (size_t)mrow * 6144 + 3072 + c; const float* scl = sh + 1024;
        f32x4 y0 = *(const f32x4*)yr, y1 = *(const f32x4*)(yr + 4);
        y0 = (y0 - mu) * rstd * *(const f32x4*)(p.ln1_w + c) + *(const f32x4*)(p.ln1_b + c);
        y1 = (y1 - mu) * rstd * *(const f32x4*)(p.ln1_w + c + 4) + *(const f32x4*)(p.ln1_b + c + 4);
        *(f32x4*)yr = y0; *(f32x4*)(yr + 4) = y1;
        const f32x4 h0 = y0 * (1.f + *(const f32x4*)scl) + *(const f32x4*)sh, h1 = y1 * (1.f + *(const f32x4*)(scl + 4)) + *(const f32x4*)(sh + 4);
        u32x4 pk; pk[0] = cvt_pk_bf16(h0[0], h0[1]); pk[1] = cvt_pk_bf16(h0[2], h0[3]); pk[2] = cvt_pk_bf16(h1[0], h1[1]); pk[3] = cvt_pk_bf16(h1[2], h1[3]);
        *(u32x4*)(H + (size_t)r * DM + c) = pk;
    }
}
__device__ void phase_ln2(const Params& p) {
    const float* stat = (const float*)(p.ws + WS_STAT2);
    const int gt = blockIdx.x * 512 + threadIdx.x, gs = gridDim.x * 512;
    for (int i = gt; i < TV * 128; i += gs) {
        const int r = i >> 7, c = (i & 127) * 8;
        float* yr = p.out + (size_t)r * DM + c;
        const float mu = stat[2 * r] * (1.f / 1024.f), var = stat[2 * r + 1] * (1.f / 1024.f) - mu * mu, rstd = rsqrtf(fmaxf(var, 0.f) + 1e-5f);
        f32x4 y0 = *(const f32x4*)yr, y1 = *(const f32x4*)(yr + 4);
        y0 = (y0 - mu) * rstd * *(const f32x4*)(p.ln2_w + c) + *(const f32x4*)(p.ln2_b + c);
        y1 = (y1 - mu) * rstd * *(const f32x4*)(p.ln2_w + c + 4) + *(const f32x4*)(p.ln2_b + c + 4);
        *(f32x4*)yr = y0; *(f32x4*)(yr + 4) = y1;
    }
}

__global__ void __launch_bounds__(512, 2) fwd(Params p, int ph_lo, int ph_hi, int coop) {
    extern __shared__ __attribute__((aligned(16))) unsigned char shm[];
    cg::grid_group grid = cg::this_grid();
    LAS unsigned char* lds = (LAS unsigned char*)shm;
    const int G = gridDim.x, bid = blockIdx.x;
#ifndef ONLY
#define ONLY -1
#endif
#define PH_BEGIN(n) if ((ONLY < 0 || ONLY == n) && ph_lo <= n && n < ph_hi) { if (n > ph_lo && coop) grid.sync();
#define PH_END }
    PH_BEGIN(0) phase_prep(p, shm); PH_END
    PH_BEGIN(1) { pg8::Gemm g{(const bf16_t*)(p.ws + WS_SC), (const bf16_t*)(p.ws + WS_WADA), 256, 6144, DM}; pg8::StaticOrder S; S.init(g.M, g.N, G, bid);
                  EpiAda E{(float*)(p.ws + WS_MOD), p.b_ada_mix, p.b_ada_ffn}; pg8::gemm_phase(lds, g, S, E); } PH_END
    PH_BEGIN(2) phase_modulate(p); PH_END
    PH_BEGIN(3) { pg8::Gemm g{(const bf16_t*)(p.ws + WS_H), (const bf16_t*)(p.ws + WS_WIN), TPAD, INW, DM}; pg8::StaticOrder S; S.init(g.M, g.N, G, bid);
                  EpiIn E{(bf16_t*)(p.ws + WS_Z), (const float*)(p.ws + WS_ROPEA), (const float*)(p.ws + WS_ROPER), p.out}; pg8::gemm_phase(lds, g, S, E); } PH_END
    PH_BEGIN(4) { for (int it = bid; it < 1024; it += G) retu_item(p, shm, it); for (int it = bid; it < 512; it += G) attn_item(p, shm, it); for (int it = G - 1 - bid; it < 128; it += G) sample_item(p, shm, it); } PH_END
    PH_BEGIN(5) phase_scan(p); PH_END
    PH_BEGIN(6) for (int it = bid; it < 1024; it += G) reto_item(p, shm, it); PH_END
    PH_BEGIN(7) { pg8::Gemm g{(const bf16_t*)(p.ws + WS_MIX), (const bf16_t*)(p.ws + WS_WOUT), TPAD, DM, DM}; pg8::StaticOrder S; S.init(g.M, g.N, G, bid);
                  EpiRes E{p.x_prompt, p.x_sample, p.out, (const float*)(p.ws + WS_MOD), 2048, (float*)(p.ws + WS_STAT1)}; pg8::gemm_phase(lds, g, S, E); } PH_END
    PH_BEGIN(8) phase_ln1(p); PH_END
    PH_BEGIN(9) { pg8::Gemm g{(const bf16_t*)(p.ws + WS_H), (const bf16_t*)(p.ws + WS_WUP), TPAD, 2 * DFF, DM}; pg8::StaticOrder S; S.init(g.M, g.N, G, bid);
                  EpiUp E{(bf16_t*)(p.ws + WS_Z)}; pg8::gemm_phase(lds, g, S, E); } PH_END
    PH_BEGIN(10) { pg8::Gemm g{(const bf16_t*)(p.ws + WS_Z), (const bf16_t*)(p.ws + WS_WDOWN), TPAD, DM, DFF}; pg8::StaticOrder S; S.init(g.M, g.N, G, bid);
                   EpiRes E{p.out + O_YP, p.out + O_YS, p.out, (const float*)(p.ws + WS_MOD), 3072 + 2048, (float*)(p.ws + WS_STAT2)}; pg8::gemm_phase(lds, g, S, E); } PH_END
    PH_BEGIN(11) phase_ln2(p); PH_END
}

extern "C" void kernel_launch(void* const* d_in, const int* in_sizes, int n_in, void* d_out, int out_size, void* d_ws, size_t ws_size, hipStream_t stream) {
    constexpr int LDS_BYTES = 131072;
    static int grid = 0;
    if (!grid) {
        int dev = 0, cus = 0, per_cu = 0;
        (void)hipGetDevice(&dev);
        (void)hipDeviceGetAttribute(&cus, hipDeviceAttributeMultiprocessorCount, dev);
        (void)hipFuncSetAttribute((const void*)fwd, hipFuncAttributeMaxDynamicSharedMemorySize, LDS_BYTES);
        (void)hipOccupancyMaxActiveBlocksPerMultiprocessor(&per_cu, (const void*)fwd, 512, LDS_BYTES);
        grid = cus > 0 ? cus : 256;
        if (ws_size < WS_END) fprintf(stderr, "kernel_launch: workspace too small: %zu < %zu\n", ws_size, (size_t)WS_END);
        fprintf(stderr, "kernel_launch: cus %d per_cu %d grid %d ws %zu need %zu\n", cus, per_cu, grid, ws_size, (size_t)WS_END);
    }
    Params p{};
    const float** f = (const float**)&p;
    for (int i = 0; i < 21; ++i) f[i] = (const float*)d_in[i];
    p.out = (float*)d_out; p.ws = (unsigned char*)d_ws;
#ifndef MULTI_LAUNCH
    int lo = 0, hi = 12, coop = 1;
    void* args[] = {&p, &lo, &hi, &coop};
    hipError_t e = hipLaunchCooperativeKernel((const void*)fwd, dim3(grid), dim3(512), args, LDS_BYTES, stream);
    if (e != hipSuccess) fprintf(stderr, "cooperative launch failed: %s (grid %d)\n", hipGetErrorString(e), grid);
#else
    for (int ph = 0; ph < 12; ++ph) hipLaunchKernelGGL(fwd, dim3(grid), dim3(512), LDS_BYTES, stream, p, ph, ph + 1, 0);
#endif
}
```

```cpp
#include <hip/hip_runtime.h>
#include <hip/hip_cooperative_groups.h>
#include <cstdio>
namespace cg = cooperative_groups;

#define LAS __attribute__((address_space(3)))
typedef unsigned short bf16_t;
typedef short bf16x8 __attribute__((ext_vector_type(8)));
typedef float f32x4 __attribute__((ext_vector_type(4)));
typedef unsigned u32x4 __attribute__((ext_vector_type(4)));
typedef unsigned u32x2 __attribute__((ext_vector_type(2)));

constexpr int DM = 1024, SEQ = 4096, NBATCH = 8, TP = NBATCH * SEQ  , NS = 128, TV = TP + NS  , TPAD = TP + 256  ;
constexpr int INW = 2816, DFF = 2816, PAST = 16384;
constexpr float ALPHA = 1.189207115002721f;
constexpr float RK_SCALE = 0.08838834764831845f;
constexpr size_t O_YP = 0, O_YS = (size_t)TP * DM, O_KP = O_YS + (size_t)NS * DM, O_VP = O_KP + 131072, O_RP = O_VP + 131072,
                 O_KS = O_RP + 524288, O_VS = O_KS + 2097152, O_RS = O_VS + 2097152;
constexpr size_t al256(size_t x) { return (x + 255) & ~(size_t)255; }
constexpr size_t WS_WIN = 0;
constexpr size_t WS_WOUT = WS_WIN + (size_t)INW * DM * 2;
constexpr size_t WS_WUP = WS_WOUT + (size_t)DM * DM * 2;
constexpr size_t WS_WDOWN = WS_WUP + (size_t)2 * DFF * DM * 2;
constexpr size_t WS_WADA = WS_WDOWN + (size_t)DM * DFF * 2;
constexpr size_t WS_SC = WS_WADA + (size_t)6144 * DM * 2;
constexpr size_t WS_MOD = WS_SC + (size_t)256 * DM * 2;
constexpr size_t WS_ROPEA = WS_MOD + (size_t)256 * 6144 * 4;
constexpr size_t WS_ROPER = al256(WS_ROPEA + (size_t)4097 * 16 * 4);
constexpr size_t WS_STAT1 = al256(WS_ROPER + (size_t)4097 * 128 * 4);
constexpr size_t WS_STAT2 = WS_STAT1 + (size_t)TPAD * 2 * 4;
constexpr size_t WS_H = al256(WS_STAT2 + (size_t)TPAD * 2 * 4);
constexpr size_t WS_Z = WS_H + (size_t)TPAD * DM * 2;
constexpr size_t WS_MIX = WS_Z + (size_t)TPAD * INW * 2;
constexpr size_t WS_SST = WS_MIX + (size_t)TPAD * DM * 2;
constexpr size_t WS_BAR = WS_SST + (size_t)1024 * 16384 * 2;
constexpr size_t WS_END = WS_BAR + 16384;

struct Params {
    const float *x_prompt, *x_sample, *c_prompt, *c_sample, *cache_k, *cache_v, *state_ret, *w_ada_mix, *b_ada_mix, *w_in, *att_sinks, *ret_gn_w, *w_out,
        *ln1_w, *ln1_b, *w_ada_ffn, *b_ada_ffn, *w_up, *w_down, *ln2_w, *ln2_b;
    float* out; unsigned char* ws;
};

__device__ __forceinline__ unsigned cvt_pk_bf16(float lo, float hi) { unsigned r; asm volatile("v_cvt_pk_bf16_f32 %0, %1, %2" : "=v"(r) : "v"(lo), "v"(hi)); return r; }
__device__ __forceinline__ float bf2f(bf16_t b) { return __uint_as_float(((unsigned)b) << 16); }
__device__ __forceinline__ bf16_t f2bf(float f) { return (bf16_t)(cvt_pk_bf16(f, 0.f) & 0xffffu); }
__device__ __forceinline__ float bflo(unsigned u) { return __uint_as_float(u << 16); }
__device__ __forceinline__ float bfhi(unsigned u) { return __uint_as_float(u & 0xffff0000u); }
__device__ __forceinline__ float silu_f(float v) { return v / (1.f + __expf(-v)); }
__device__ __forceinline__ float log_gamma(int h) {
    return h == 0 ? -0.0317486983145803f : (h == 1 ? -0.012479111952334388f : (h == 2 ? -0.004933717393740471f : -0.0019550348358033506f));
}
__device__ __forceinline__ int att_dim(int p) { if (p >= 16) return p; const int g = p >> 3, j = p & 7; return j < 4 ? 4 * g + j : 8 + 4 * g + (j - 4); }
__device__ __forceinline__ int ret_dim(int p) { const int g = p >> 3, j = p & 7; return j < 4 ? 4 * g + j : 64 + 4 * g + (j - 4); }
__device__ __forceinline__ int in_col(int P) {
    if (P < 640) return (P & ~63) + att_dim(P & 63);
    if (P >= 768 && P < 1792) { const int p = (P - 768) & 127; return P - p + ret_dim(p); }
    return P;
}
__device__ __forceinline__ int up_col(int P) { const int pn = P >> 8, q = P & 255; return q < 128 ? pn * 128 + q : DFF + pn * 128 + (q - 128); }

namespace pg8 {
constexpr int BM = 256, BK = 64, HALF = 128, HTB = HALF * BK * 2, STAGE_BYTES = 8 * HTB, NXCD = 8, WGM = 8;
__device__ __forceinline__ int lds_byte(int r, int c) { const int st = (r >> 4) * 2 + (c >> 5), rr = r & 15, cc = c & 31, ob = rr * 64 + cc * 2; return st * 1024 + (ob ^ (((ob >> 9) & 1) << 5)); }
__device__ __forceinline__ void stage_rc(int b, int& R, int& C) { const int st = b / 1024, sb = b % 1024, swz = sb ^ (((sb >> 9) & 1) << 5); R = (st >> 1) * 16 + swz / 64; C = (st & 1) * 32 + (swz % 64) / 2; }
__device__ __forceinline__ int perm32(int rho) { const int n = rho >> 4, i = rho & 15; return 8 * (i >> 2) + 4 * n + (i & 3); }
struct Unit { int pm, pn; };
struct Gemm { const bf16_t* A; const bf16_t* Bt; int M, N, K; };
struct StaticOrder {
    int nM, nN, nwg, G, c;
    __device__ void init(int M, int N, int G_, int c_) { nM = M / BM; nN = N / BM; nwg = nM * nN; G = G_; c = c_; }
    __device__ bool next(int i, Unit& u) const {
        const long L = (long)i * G + c; if (L >= nwg) return false;
        int wgid = (int)L; { const int q = nwg / NXCD, r = nwg % NXCD, xcd = wgid % NXCD, off = wgid / NXCD; wgid = (xcd < r ? xcd * (q + 1) : r * (q + 1) + (xcd - r) * q) + off; }
        const int nig = WGM * nN, gid = wgid / nig, fm = gid * WGM, gsz = (nM - fm) < WGM ? (nM - fm) : WGM;
        u.pm = fm + ((wgid % nig) % gsz); u.pn = (wgid % nig) / gsz; return true;
    }
};

template <class Epi, class Sched>
__device__ __forceinline__ void gemm_phase(LAS unsigned char* lds, const Gemm g, const Sched& S, const Epi& E) {
    const int tid = threadIdx.x, wid = __builtin_amdgcn_readfirstlane(tid >> 6), lane = tid & 63, wr = wid >> 2, wc = wid & 3, fr = lane & 15, fq = lane >> 4;
    const int K = g.K, nt = K / BK;
    unsigned voffA[2], voffB[2];
#pragma unroll
    for (int i = 0; i < 2; ++i) { int R, C; stage_rc(tid * 16 + i * 8192, R, C); const int Rb = Epi::PERM ? ((R & ~31) + perm32(R & 31)) : R;
        voffA[i] = (unsigned)(R * K + C) * 2u; voffB[i] = (unsigned)(Rb * K + C) * 2u; }
    const size_t kstep = (size_t)(BK * 2);
    const size_t hstep = (size_t)HALF * K * 2;
    const size_t tstep = 2 * hstep;
    const unsigned ldsw = (unsigned)wid * 1024u;
    const int aoff = lds_byte(wr * 64 + fr, fq * 8), boff = lds_byte(wc * 32 + fr, fq * 8);
#define PG8_SA(b, h) (((b) * 2 + (h)) * HTB)
#define PG8_SB(b, h) ((4 + (b) * 2 + (h)) * HTB)
#define PG8_STAGE(bufoff, gbase, voff) do { _Pragma("unroll") for (int _i = 0; _i < 2; ++_i) \
        __builtin_amdgcn_global_load_lds((const unsigned*)((const char*)(gbase) + (voff)[_i]), (LAS unsigned*)(lds + (bufoff) + ldsw + _i * 8192), 16, 0, 0); } while (0)
#define PG8_LDA(dst, b, h) do { _Pragma("unroll") for (int m = 0; m < 4; ++m) _Pragma("unroll") for (int k = 0; k < 2; ++k) dst[m][k] = *(const LAS bf16x8*)(lds + PG8_SA(b, h) + aoff + m * 2048 + k * 1024); } while (0)
#define PG8_LDB(dst, b, h) do { _Pragma("unroll") for (int n = 0; n < 2; ++n) _Pragma("unroll") for (int k = 0; k < 2; ++k) dst[n][k] = *(const LAS bf16x8*)(lds + PG8_SB(b, h) + boff + n * 2048 + k * 1024); } while (0)
#define PG8_MMA(ai, bj, At, Bt) do { __builtin_amdgcn_s_setprio(1); _Pragma("unroll") for (int m = 0; m < 4; ++m) _Pragma("unroll") for (int n = 0; n < 2; ++n) _Pragma("unroll") for (int k = 0; k < 2; ++k) \
        acc[ai][bj][m][n] = __builtin_amdgcn_mfma_f32_16x16x32_bf16(Bt[n][k], At[m][k], acc[ai][bj][m][n], 0, 0, 0); __builtin_amdgcn_s_setprio(0); } while (0)
#define PG8_WAIT_V(n) asm volatile("s_waitcnt vmcnt(" #n ")" ::: "memory")
#define PG8_WAIT_L(n) asm volatile("s_waitcnt lgkmcnt(" #n ")" ::: "memory")
#define PG8_BAR __builtin_amdgcn_s_barrier()
#define PG8_SCHED __builtin_amdgcn_sched_barrier(0)
    Unit cur, nxt; int ui = 0;
    if (!S.next(0, cur)) return;
    f32x4 acc[2][2][4][2];
#pragma unroll
    for (int a = 0; a < 2; ++a)
#pragma unroll
        for (int b = 0; b < 2; ++b)
#pragma unroll
            for (int m = 0; m < 4; ++m)
#pragma unroll
                for (int n = 0; n < 2; ++n) acc[a][b][m][n] = (f32x4){0.f, 0.f, 0.f, 0.f};
    bf16x8 At[4][2], B0[2][2], B1[2][2];
    const char* cA = (const char*)g.A + (size_t)cur.pm * tstep; const char* cB = (const char*)g.Bt + (size_t)cur.pn * tstep;
    PG8_STAGE(PG8_SB(0, 0), cB, voffB); PG8_STAGE(PG8_SA(0, 0), cA, voffA); PG8_STAGE(PG8_SB(0, 1), cB + hstep, voffB); PG8_STAGE(PG8_SA(0, 1), cA + hstep, voffA);
    if (wr == 1) PG8_BAR;
    PG8_WAIT_V(4); PG8_BAR;
    PG8_STAGE(PG8_SB(1, 0), cB + kstep, voffB); PG8_STAGE(PG8_SA(1, 0), cA + kstep, voffA); PG8_STAGE(PG8_SB(1, 1), cB + hstep + kstep, voffB);
    PG8_WAIT_V(6); PG8_BAR;
    for (;;) {
        const bool has_next = S.next(ui + 1, nxt);
        const char* nA = has_next ? (const char*)g.A + (size_t)nxt.pm * tstep : cA; const char* nB = has_next ? (const char*)g.Bt + (size_t)nxt.pn * tstep : cB;
        for (int t = 0; t < nt; t += 2) {
            const bool last = (t == nt - 2);
            const char* a1 = cA + (size_t)(t + 1) * kstep;
            const char* a2 = last ? nA : cA + (size_t)(t + 2) * kstep; const char* b2 = last ? nB : cB + (size_t)(t + 2) * kstep;
            const char* a3 = a2 + kstep; const char* b3 = b2 + kstep;
            PG8_LDB(B0, 0, 0); PG8_SCHED; PG8_LDA(At, 0, 0); PG8_STAGE(PG8_SA(1, 1), a1 + hstep, voffA);
            PG8_WAIT_L(8); PG8_BAR; PG8_WAIT_L(0); PG8_MMA(0, 0, At, B0); PG8_BAR; PG8_SCHED;
            PG8_LDB(B1, 0, 1); PG8_STAGE(PG8_SB(0, 0), b2, voffB);
            PG8_BAR; PG8_WAIT_L(0); PG8_MMA(0, 1, At, B1); PG8_BAR;
            PG8_LDA(At, 0, 1); PG8_STAGE(PG8_SA(0, 0), a2, voffA);
            PG8_BAR; PG8_WAIT_L(0); PG8_MMA(1, 0, At, B0); PG8_BAR; PG8_SCHED;
            PG8_STAGE(PG8_SB(0, 1), b2 + hstep, voffB);
            PG8_WAIT_V(6); PG8_BAR; PG8_MMA(1, 1, At, B1); PG8_BAR;
            PG8_LDB(B0, 1, 0); PG8_SCHED; PG8_LDA(At, 1, 0); PG8_STAGE(PG8_SA(0, 1), a2 + hstep, voffA);
            PG8_WAIT_L(8); PG8_BAR; PG8_WAIT_L(0); PG8_MMA(0, 0, At, B0); PG8_BAR; PG8_SCHED;
            PG8_LDB(B1, 1, 1); PG8_STAGE(PG8_SB(1, 0), b3, voffB);
            PG8_BAR; PG8_WAIT_L(0); PG8_MMA(0, 1, At, B1); PG8_BAR;
            PG8_LDA(At, 1, 1); PG8_STAGE(PG8_SA(1, 0), a3, voffA);
            PG8_BAR; PG8_WAIT_L(0); PG8_MMA(1, 0, At, B0); PG8_BAR; PG8_SCHED;
            PG8_STAGE(PG8_SB(1, 1), b3 + hstep, voffB);
            PG8_WAIT_V(6); PG8_BAR; PG8_MMA(1, 1, At, B1); PG8_BAR;
        }
        E(acc, cur, wr, wc, fr, fq);
        if (!has_next) break;
#pragma unroll
        for (int a = 0; a < 2; ++a)
#pragma unroll
            for (int b = 0; b < 2; ++b)
#pragma unroll
                for (int m = 0; m < 4; ++m)
#pragma unroll
                    for (int n = 0; n < 2; ++n) acc[a][b][m][n] = (f32x4){0.f, 0.f, 0.f, 0.f};
        cur = nxt; cA = nA; cB = nB; ++ui;
    }
    PG8_WAIT_V(0);
    if (wr == 0) PG8_BAR;
    PG8_BAR;
#undef PG8_SA
#undef PG8_SB
#undef PG8_STAGE
#undef PG8_LDA
#undef PG8_LDB
#undef PG8_MMA
#undef PG8_WAIT_V
#undef PG8_WAIT_L
#undef PG8_BAR
#undef PG8_SCHED
}
}
using pg8::Unit;

struct EpiAda {
    static constexpr bool PERM = false;
    float* mod; const float* b_mix; const float* b_ffn;
    __device__ __forceinline__ void operator()(const f32x4 (&acc)[2][2][4][2], const Unit& u, int wr, int wc, int fr, int fq) const {
#pragma unroll
        for (int ai = 0; ai < 2; ++ai)
#pragma unroll
            for (int m = 0; m < 4; ++m) {
                const int r = u.pm * 256 + ai * 128 + wr * 64 + m * 16 + fr;
#pragma unroll
                for (int bj = 0; bj < 2; ++bj)
#pragma unroll
                    for (int n = 0; n < 2; ++n) {
                        const int c = u.pn * 256 + bj * 128 + wc * 32 + n * 16 + fq * 4;
                        const f32x4 bv = c < 3072 ? *(const f32x4*)(b_mix + c) : *(const f32x4*)(b_ffn + c - 3072);
                        *(f32x4*)(mod + (size_t)r * 6144 + c) = acc[ai][bj][m][n] + bv;
                    }
            }
    }
};

struct EpiIn {
    static constexpr bool PERM = true;
    bf16_t* Z; const float* ropeA; const float* ropeR; float* out;
    __device__ __forceinline__ void operator()(const f32x4 (&acc)[2][2][4][2], const Unit& u, int wr, int wc, int fr, int fq) const {
#pragma unroll
        for (int bj = 0; bj < 2; ++bj) {
            const int cb128 = u.pn * 256 + bj * 128;
            const int cb = cb128 + wc * 32 + fq * 8;
            const int region = cb128 < 512 ? 0 : (cb128 < 640 ? 1 : (cb128 < 768 ? 2 : (cb128 < 1280 ? 3 : (cb128 < 1792 ? 4 : 5))));
#pragma unroll
            for (int ai = 0; ai < 2; ++ai)
#pragma unroll
                for (int m = 0; m < 4; ++m) {
                    const int r0 = u.pm * 256 + ai * 128 + wr * 64 + m * 16;
                    if (r0 >= TV) continue;
                    const int r = r0 + fr;
                    const int pos = r < TP ? (r & 4095) : 4096;
                    f32x4 v0 = acc[ai][bj][m][0], v1 = acc[ai][bj][m][1];
                    if (region <= 1) {
                        const int p = cb & 63;
                        if (p < 16) {
                            const int grp = p >> 3;
                            const f32x4 cs = *(const f32x4*)(ropeA + pos * 16 + 4 * grp), sn = *(const f32x4*)(ropeA + pos * 16 + 8 + 4 * grp);
                            const f32x4 a = v0 * cs - v1 * sn, b = v1 * cs + v0 * sn; v0 = a; v1 = b;
                        }
                    } else if (region == 3 || region == 4) {
                        const int g = (cb & 127) >> 3;
                        const f32x4 cs = *(const f32x4*)(ropeR + pos * 128 + 4 * g), sn = *(const f32x4*)(ropeR + pos * 128 + 64 + 4 * g);
                        f32x4 a = v0 * cs - v1 * sn, b = v1 * cs + v0 * sn;
                        if (region == 4) { a *= RK_SCALE; b *= RK_SCALE; }
                        v0 = a; v1 = b;
                    }
                    u32x4 pk; pk[0] = cvt_pk_bf16(v0[0], v0[1]); pk[1] = cvt_pk_bf16(v0[2], v0[3]); pk[2] = cvt_pk_bf16(v1[0], v1[1]); pk[3] = cvt_pk_bf16(v1[2], v1[3]);
                    *(u32x4*)(Z + (size_t)r * INW + cb) = pk;
                    if (region == 1 || region == 2) {
                        const int kvh = (cb >> 6) & 1, p = cb & 63;
                        int d0 = p, d1 = p + 4;
                        if (region == 1 && p < 16) { const int grp = p >> 3; d0 = 4 * grp; d1 = 8 + 4 * grp; }
                        float* dst = nullptr;
                        if (r < TP) { if (pos >= SEQ - 128) dst = out + (region == 1 ? O_KP : O_VP) + ((size_t)((r >> 12) * 128 + (pos - (SEQ - 128))) * 2 + kvh) * 64; }
                        else dst = out + (region == 1 ? O_KS : O_VS) + ((size_t)((r - TP) * 128 + 127) * 2 + kvh) * 64;
                        if (dst) { *(f32x4*)(dst + d0) = v0; *(f32x4*)(dst + d1) = v1; }
                    }
                }
        }
    }
};

struct EpiRes {
    static constexpr bool PERM = false;
    const float* baseP; const float* baseS; float* R; const float* mod; int gate_off; float* stat;
    __device__ __forceinline__ void operator()(const f32x4 (&acc)[2][2][4][2], const Unit& u, int wr, int wc, int fr, int fq) const {
#pragma unroll
        for (int ai = 0; ai < 2; ++ai)
#pragma unroll
            for (int m = 0; m < 4; ++m) {
                const int r0 = u.pm * 256 + ai * 128 + wr * 64 + m * 16;
                if (r0 >= TV) continue;
                const int r = r0 + fr;
                const int mrow = r < TP ? 128 + (r >> 12) : r - TP;
                const float* gate = mod + (size_t)mrow * 6144 + gate_off;
                const float* base = r < TP ? baseP + (size_t)r * DM : baseS + (size_t)(r - TP) * DM;
                float s = 0.f, ss = 0.f;
#pragma unroll
                for (int bj = 0; bj < 2; ++bj)
#pragma unroll
                    for (int n = 0; n < 2; ++n) {
                        const int c = u.pn * 256 + bj * 128 + wc * 32 + n * 16 + fq * 4;
                        const f32x4 xv = *(const f32x4*)(base + c), gv = *(const f32x4*)(gate + c);
                        const f32x4 res = ALPHA * xv + (1.f + gv) * acc[ai][bj][m][n];
                        *(f32x4*)(R + (size_t)r * DM + c) = res;
                        s += res[0] + res[1] + res[2] + res[3];
                        ss += res[0] * res[0] + res[1] * res[1] + res[2] * res[2] + res[3] * res[3];
                    }
                s += __shfl_xor(s, 16); ss += __shfl_xor(ss, 16);
                s += __shfl_xor(s, 32); ss += __shfl_xor(ss, 32);
                if (fq == 0) { atomicAdd(stat + 2 * r, s); atomicAdd(stat + 2 * r + 1, ss); }
            }
    }
};

struct EpiUp {
    static constexpr bool PERM = true;
    bf16_t* F;
    __device__ __forceinline__ void operator()(const f32x4 (&acc)[2][2][4][2], const Unit& u, int wr, int wc, int fr, int fq) const {
#pragma unroll
        for (int ai = 0; ai < 2; ++ai)
#pragma unroll
            for (int m = 0; m < 4; ++m) {
                const int r0 = u.pm * 256 + ai * 128 + wr * 64 + m * 16;
                if (r0 >= TV) continue;
                const int r = r0 + fr;
                float f[8];
#pragma unroll
                for (int n = 0; n < 2; ++n)
#pragma unroll
                    for (int i = 0; i < 4; ++i) { const float g = acc[ai][0][m][n][i]; f[n * 4 + i] = silu_f(g) * acc[ai][1][m][n][i]; }
                u32x4 pk; pk[0] = cvt_pk_bf16(f[0], f[1]); pk[1] = cvt_pk_bf16(f[2], f[3]); pk[2] = cvt_pk_bf16(f[4], f[5]); pk[3] = cvt_pk_bf16(f[6], f[7]);
                *(u32x4*)(F + (size_t)r * DFF + u.pn * 128 + wc * 32 + fq * 8) = pk;
            }
    }
};

__device__ void phase_prep(const Params& p, unsigned char* shm) {
    const int tid = threadIdx.x;
    bf16_t* tile = (bf16_t*)shm;
    for (int tt = blockIdx.x; tt < 4608; tt += gridDim.x) {
        const float* src; bf16_t* dst; int ld, K, mode, t;
        if (tt < 704) { t = tt; src = p.w_in; ld = INW; K = DM; dst = (bf16_t*)(p.ws + WS_WIN); mode = 1; }
        else if (tt < 960) { t = tt - 704; src = p.w_out; ld = DM; K = DM; dst = (bf16_t*)(p.ws + WS_WOUT); mode = 0; }
        else if (tt < 2368) { t = tt - 960; src = p.w_up; ld = 2 * DFF; K = DM; dst = (bf16_t*)(p.ws + WS_WUP); mode = 2; }
        else if (tt < 3072) { t = tt - 2368; src = p.w_down; ld = DM; K = DFF; dst = (bf16_t*)(p.ws + WS_WDOWN); mode = 0; }
        else if (tt < 3840) { t = tt - 3072; src = p.w_ada_mix; ld = 3072; K = DM; dst = (bf16_t*)(p.ws + WS_WADA); mode = 0; }
        else { t = tt - 3840; src = p.w_ada_ffn; ld = 3072; K = DM; dst = (bf16_t*)(p.ws + WS_WADA) + (size_t)3072 * DM; mode = 0; }
        const int nkt = K / 64, rt = t / nkt, kt = t % nkt;
        const int P = rt * 64 + (tid & 63);
        const int L = mode == 1 ? in_col(P) : (mode == 2 ? up_col(P) : P);
#pragma unroll
        for (int i = 0; i < 8; ++i) { const int k = (tid >> 6) + 8 * i; tile[(tid & 63) * 72 + k] = f2bf(src[(size_t)(kt * 64 + k) * ld + L]); }
        __syncthreads();
        { const int pr = tid >> 3, kc = tid & 7; *(u32x4*)(dst + (size_t)(rt * 64 + pr) * K + kt * 64 + kc * 8) = *(const u32x4*)(tile + pr * 72 + kc * 8); }
        __syncthreads();
    }
    const int gt = blockIdx.x * 512 + tid, gs = gridDim.x * 512;
    bf16_t* sc = (bf16_t*)(p.ws + WS_SC);
    for (int i = gt; i < 256 * DM; i += gs) { const int r = i >> 10, k = i & 1023; float v = 0.f; if (r < 128) v = silu_f(p.c_sample[r * DM + k]); else if (r < 136) v = silu_f(p.c_prompt[(r - 128) * DM + k]); sc[i] = f2bf(v); }
    float* st = (float*)(p.ws + WS_STAT1);
    for (int i = gt; i < TPAD * 4; i += gs) st[i] = 0.f;
    float* ra = (float*)(p.ws + WS_ROPEA); float* rr = (float*)(p.ws + WS_ROPER);
    for (int i = gt; i < 4097 * 72; i += gs) {
        const int pos = i / 72, f = i % 72;
        const double pv = pos < 4096 ? (double)pos : (double)PAST;
        const double inv = f < 8 ? exp(-13.122363377404328 * (double)f / 8.0) : exp(-9.210340371976184 * (double)(f - 8) / 64.0);
        const double ang = pv * inv;
        const double kk = rint(ang * 0.15915494309189535);
        const float red = (float)(ang - kk * 6.283185307179586);
        const float cs = cosf(red), sn = sinf(red);
        if (f < 8) { ra[pos * 16 + f] = cs; ra[pos * 16 + 8 + f] = sn; } else { rr[pos * 128 + (f - 8)] = cs; rr[pos * 128 + 64 + (f - 8)] = sn; }
    }
}

__device__ void phase_modulate(const Params& p) {
    const float* mod = (const float*)(p.ws + WS_MOD); bf16_t* H = (bf16_t*)(p.ws + WS_H);
    const int gt = blockIdx.x * 512 + threadIdx.x, gs = gridDim.x * 512;
    for (int i = gt; i < TV * 128; i += gs) {
        const int r = i >> 7, c = (i & 127) * 8;
        const float* xr = r < TP ? p.x_prompt + (size_t)r * DM : p.x_sample + (size_t)(r - TP) * DM;
        const int mrow = r < TP ? 128 + (r >> 12) : r - TP;
        const float* sh = mod + (size_t)mrow * 6144; const float* scl = sh + 1024;
        const f32x4 x0 = *(const f32x4*)(xr + c), x1 = *(const f32x4*)(xr + c + 4);
        const f32x4 h0 = x0 * (1.f + *(const f32x4*)(scl + c)) + *(const f32x4*)(sh + c), h1 = x1 * (1.f + *(const f32x4*)(scl + c + 4)) + *(const f32x4*)(sh + c + 4);
        u32x4 pk; pk[0] = cvt_pk_bf16(h0[0], h0[1]); pk[1] = cvt_pk_bf16(h0[2], h0[3]); pk[2] = cvt_pk_bf16(h1[0], h1[1]); pk[3] = cvt_pk_bf16(h1[2], h1[3]);
        *(u32x4*)(H + (size_t)r * DM + c) = pk;
    }
}

__device__ void attn_item(const Params& p, unsigned char* shm, int item) {
    const int tid = threadIdx.x, wid = tid >> 6, lane = tid & 63, lr = lane & 15, g = lane >> 4;
    const int b = item >> 6, kvh = (item >> 5) & 1, n = item & 31;
    const bf16_t* Z = (const bf16_t*)(p.ws + WS_Z); bf16_t* MIX = (bf16_t*)(p.ws + WS_MIX);
    bf16_t* Ks = (bf16_t*)shm;
    bf16_t* VT = Ks + 256 * 72;
    {
        const int key = tid >> 1, hf = tid & 1;
        const bool valid = (n > 0) || (key >= 128);
        const size_t row = (size_t)b * SEQ + (size_t)(n - 1) * 128 + key;
        const bf16_t* kp = Z + row * INW + 512 + kvh * 64 + hf * 32; const bf16_t* vp = Z + row * INW + 640 + kvh * 64 + hf * 32;
#pragma unroll
        for (int c = 0; c < 4; ++c) {
            u32x4 kv = (u32x4){0u, 0u, 0u, 0u}, vv = (u32x4){0u, 0u, 0u, 0u};
            if (valid) { kv = *(const u32x4*)(kp + c * 8); vv = *(const u32x4*)(vp + c * 8); }
            *(u32x4*)(Ks + key * 72 + hf * 32 + c * 8) = kv;
#pragma unroll
            for (int e = 0; e < 4; ++e) { const int d = hf * 32 + c * 8 + 2 * e; VT[d * 264 + key] = (bf16_t)(vv[e] & 0xffffu); VT[(d + 1) * 264 + key] = (bf16_t)(vv[e] >> 16); }
        }
    }
    __syncthreads();
    for (int qt = 0; qt < 4; ++qt) {
        const int T = wid * 4 + qt, hq = T >> 3, tq = T & 7, t0 = tq * 16, head = kvh * 4 + hq;
        const size_t qrow = (size_t)b * SEQ + (size_t)n * 128 + t0 + lr;
        bf16x8 Qf[2];
#pragma unroll
        for (int kk = 0; kk < 2; ++kk) Qf[kk] = *(const bf16x8*)(Z + qrow * INW + head * 64 + kk * 32 + g * 8);
        const int kt0 = tq < 6 ? tq : 6;
        f32x4 S[10];
#pragma unroll
        for (int jt = 0; jt < 10; ++jt) {
            S[jt] = (f32x4){0.f, 0.f, 0.f, 0.f};
#pragma unroll
            for (int kk = 0; kk < 2; ++kk) {
                const bf16x8 Kf = *(const bf16x8*)(Ks + (16 * (kt0 + jt) + lr) * 72 + kk * 32 + g * 8);
                S[jt] = __builtin_amdgcn_mfma_f32_16x16x32_bf16(Kf, Qf[kk], S[jt], 0, 0, 0);
            }
        }
        const float sink = p.att_sinks[head];
        const int t = t0 + lr;
        float mx = sink;
#pragma unroll
        for (int jt = 0; jt < 10; ++jt)
#pragma unroll
            for (int r = 0; r < 4; ++r) {
                const int i = 16 * (kt0 + jt) + 4 * g + r, dist = 128 + t - i;
                const bool ok = dist >= 0 && dist <= 128 && (n > 0 || i >= 128);
                const float s = ok ? S[jt][r] * 0.125f : -INFINITY;
                S[jt][r] = s; mx = fmaxf(mx, s);
            }
        mx = fmaxf(mx, __shfl_xor(mx, 16)); mx = fmaxf(mx, __shfl_xor(mx, 32));
        float sum = 0.f;
#pragma unroll
        for (int jt = 0; jt < 10; ++jt)
#pragma unroll
            for (int r = 0; r < 4; ++r) { const float e = __expf(S[jt][r] - mx); S[jt][r] = e; sum += e; }
        sum += __shfl_xor(sum, 16); sum += __shfl_xor(sum, 32);
        const float inv = 1.f / (sum + __expf(sink - mx));
        f32x4 O[4];
#pragma unroll
        for (int dt = 0; dt < 4; ++dt) O[dt] = (f32x4){0.f, 0.f, 0.f, 0.f};
#pragma unroll
        for (int jp = 0; jp < 5; ++jp) {
            u32x4 pu; pu[0] = cvt_pk_bf16(S[2 * jp][0] * inv, S[2 * jp][1] * inv); pu[1] = cvt_pk_bf16(S[2 * jp][2] * inv, S[2 * jp][3] * inv);
            pu[2] = cvt_pk_bf16(S[2 * jp + 1][0] * inv, S[2 * jp + 1][1] * inv); pu[3] = cvt_pk_bf16(S[2 * jp + 1][2] * inv, S[2 * jp + 1][3] * inv);
            const bf16x8 Pf = __builtin_bit_cast(bf16x8, pu);
#pragma unroll
            for (int dt = 0; dt < 4; ++dt) {
                const bf16_t* vr = VT + (16 * dt + lr) * 264 + 16 * (kt0 + 2 * jp) + 4 * g;
                const u32x2 a0 = *(const u32x2*)vr, a1 = *(const u32x2*)(vr + 16);
                u32x4 au; au[0] = a0[0]; au[1] = a0[1]; au[2] = a1[0]; au[3] = a1[1];
                O[dt] = __builtin_amdgcn_mfma_f32_16x16x32_bf16(__builtin_bit_cast(bf16x8, au), Pf, O[dt], 0, 0, 0);
            }
        }
#pragma unroll
        for (int dt = 0; dt < 4; ++dt) {
            u32x2 o; o[0] = cvt_pk_bf16(O[dt][0], O[dt][1]); o[1] = cvt_pk_bf16(O[dt][2], O[dt][3]);
            *(u32x2*)(MIX + qrow * DM + head * 64 + 16 * dt + 4 * g) = o;
        }
    }
    __syncthreads();
}

__device__ void retu_item(const Params& p, unsigned char* shm, int item) {
    const int tid = threadIdx.x, wid = tid >> 6, lane = tid & 63, lr = lane & 15, g = lane >> 4;
    const int b = item >> 7, h = (item >> 5) & 3, c = item & 31;
    const bf16_t* Z = (const bf16_t*)(p.ws + WS_Z); float* UT = (float*)(p.ws + WS_H);
    bf16_t* KT = (bf16_t*)shm;
    bf16_t* VT = KT + 128 * 136;
    const float lg = log_gamma(h);
    {
        const int j = tid >> 2, q = tid & 3;
        const size_t row = (size_t)b * SEQ + (size_t)c * 128 + j;
        const float dec = __expf(lg * (float)(127 - j));
        const bf16_t* kp = Z + row * INW + 1280 + h * 128 + q * 32; const bf16_t* vp = Z + row * INW + 1792 + h * 128 + q * 32;
#pragma unroll
        for (int cc = 0; cc < 4; ++cc) {
            const u32x4 kv = *(const u32x4*)(kp + cc * 8), vv = *(const u32x4*)(vp + cc * 8);
#pragma unroll
            for (int e = 0; e < 4; ++e) {
                const int d = q * 32 + cc * 8 + 2 * e;
                KT[d * 136 + j] = f2bf(bflo(kv[e]) * dec); KT[(d + 1) * 136 + j] = f2bf(bfhi(kv[e]) * dec);
                VT[d * 136 + j] = (bf16_t)(vv[e] & 0xffffu); VT[(d + 1) * 136 + j] = (bf16_t)(vv[e] >> 16);
            }
        }
    }
    __syncthreads();
    f32x4 acc[8];
#pragma unroll
    for (int dt = 0; dt < 8; ++dt) acc[dt] = (f32x4){0.f, 0.f, 0.f, 0.f};
#pragma unroll
    for (int kk = 0; kk < 4; ++kk) {
        const bf16x8 Bf = *(const bf16x8*)(VT + (16 * wid + lr) * 136 + kk * 32 + g * 8);
#pragma unroll
        for (int dt = 0; dt < 8; ++dt) {
            const bf16x8 Af = *(const bf16x8*)(KT + (16 * dt + lr) * 136 + kk * 32 + g * 8);
            acc[dt] = __builtin_amdgcn_mfma_f32_16x16x32_bf16(Af, Bf, acc[dt], 0, 0, 0);
        }
    }
    float* up = UT + (size_t)item * 16384 + (size_t)(16 * wid + lr) * 128;
#pragma unroll
    for (int dt = 0; dt < 8; ++dt) *(f32x4*)(up + 16 * dt + 4 * g) = acc[dt];
    __syncthreads();
}

__device__ void phase_scan(const Params& p) {
    const float* UT = (const float*)(p.ws + WS_H); bf16_t* SST = (bf16_t*)(p.ws + WS_SST);
    const int gt = blockIdx.x * 512 + threadIdx.x, gs = gridDim.x * 512;
    for (int i = gt; i < 32 * 16384; i += gs) {
        const int bh = i >> 14, ed = i & 16383, e = ed >> 7, d = ed & 127, h = bh & 3;
        const float gL = __expf(log_gamma(h) * 128.f);
        float s = 0.f;
        const float* up = UT + (size_t)bh * 32 * 16384 + ed; bf16_t* sp = SST + (size_t)bh * 32 * 16384 + ed;
#pragma unroll 8
        for (int c = 0; c < 32; ++c) { const float uv = up[(size_t)c * 16384]; sp[(size_t)c * 16384] = f2bf(s); s = gL * s + uv; }
        p.out[O_RP + ((size_t)bh * 128 + ret_dim(d)) * 128 + e] = s;
    }
}

__device__ void reto_item(const Params& p, unsigned char* shm, int item) {
    const int tid = threadIdx.x, wid = tid >> 6, lane = tid & 63, lr = lane & 15, g = lane >> 4;
    const int b = item >> 7, h = (item >> 5) & 3, c = item & 31;
    const bf16_t* Z = (const bf16_t*)(p.ws + WS_Z); const bf16_t* SST = (const bf16_t*)(p.ws + WS_SST); bf16_t* MIX = (bf16_t*)(p.ws + WS_MIX);
    bf16_t* Ks = (bf16_t*)shm;
    bf16_t* VT = Ks + 128 * 136;
    bf16_t* Ss = VT + 128 * 136;
    const float lg = log_gamma(h);
    const size_t row0 = (size_t)b * SEQ + (size_t)c * 128;
    {
        const int j = tid >> 2, q = tid & 3;
        const bf16_t* kp = Z + (row0 + j) * INW + 1280 + h * 128 + q * 32; const bf16_t* vp = Z + (row0 + j) * INW + 1792 + h * 128 + q * 32;
        const bf16_t* sp = SST + (size_t)item * 16384 + j * 128 + q * 32;
#pragma unroll
        for (int cc = 0; cc < 4; ++cc) {
            const u32x4 kv = *(const u32x4*)(kp + cc * 8), vv = *(const u32x4*)(vp + cc * 8), sv = *(const u32x4*)(sp + cc * 8);
            *(u32x4*)(Ks + j * 136 + q * 32 + cc * 8) = kv;
            *(u32x4*)(Ss + j * 136 + q * 32 + cc * 8) = sv;
#pragma unroll
            for (int e = 0; e < 4; ++e) { const int d = q * 32 + cc * 8 + 2 * e; VT[d * 136 + j] = (bf16_t)(vv[e] & 0xffffu); VT[(d + 1) * 136 + j] = (bf16_t)(vv[e] >> 16); }
        }
    }
    __syncthreads();
    const size_t qrow = row0 + 16 * wid + lr;
    bf16x8 Qf[4];
#pragma unroll
    for (int kk = 0; kk < 4; ++kk) Qf[kk] = *(const bf16x8*)(Z + qrow * INW + 768 + h * 128 + kk * 32 + g * 8);
    f32x4 S[8];
#pragma unroll
    for (int jt = 0; jt < 8; ++jt) {
        S[jt] = (f32x4){0.f, 0.f, 0.f, 0.f};
        if (jt <= wid) {
#pragma unroll
            for (int kk = 0; kk < 4; ++kk) {
                const bf16x8 Kf = *(const bf16x8*)(Ks + (16 * jt + lr) * 136 + kk * 32 + g * 8);
                S[jt] = __builtin_amdgcn_mfma_f32_16x16x32_bf16(Kf, Qf[kk], S[jt], 0, 0, 0);
            }
        }
    }
    const int it = 16 * wid + lr;
#pragma unroll
    for (int jt = 0; jt < 8; ++jt)
#pragma unroll
        for (int r = 0; r < 4; ++r) { const int j = 16 * jt + 4 * g + r; S[jt][r] = (j <= it) ? S[jt][r] * __expf(lg * (float)(it - j)) : 0.f; }
    f32x4 O1[8], O2[8];
#pragma unroll
    for (int et = 0; et < 8; ++et) { O1[et] = (f32x4){0.f, 0.f, 0.f, 0.f}; O2[et] = (f32x4){0.f, 0.f, 0.f, 0.f}; }
#pragma unroll
    for (int jp = 0; jp < 4; ++jp) {
        if (2 * jp <= wid) {
            u32x4 pu; pu[0] = cvt_pk_bf16(S[2 * jp][0], S[2 * jp][1]); pu[1] = cvt_pk_bf16(S[2 * jp][2], S[2 * jp][3]);
            pu[2] = cvt_pk_bf16(S[2 * jp + 1][0], S[2 * jp + 1][1]); pu[3] = cvt_pk_bf16(S[2 * jp + 1][2], S[2 * jp + 1][3]);
            const bf16x8 Pf = __builtin_bit_cast(bf16x8, pu);
#pragma unroll
            for (int et = 0; et < 8; ++et) {
                const bf16_t* vr = VT + (16 * et + lr) * 136 + 32 * jp + 4 * g;
                const u32x2 a0 = *(const u32x2*)vr, a1 = *(const u32x2*)(vr + 16);
                u32x4 au; au[0] = a0[0]; au[1] = a0[1]; au[2] = a1[0]; au[3] = a1[1];
                O1[et] = __builtin_amdgcn_mfma_f32_16x16x32_bf16(__builtin_bit_cast(bf16x8, au), Pf, O1[et], 0, 0, 0);
            }
        }
    }
#pragma unroll
    for (int kk = 0; kk < 4; ++kk)
#pragma unroll
        for (int et = 0; et < 8; ++et) {
            const bf16x8 Sf = *(const bf16x8*)(Ss + (16 * et + lr) * 136 + kk * 32 + g * 8);
            O2[et] = __builtin_amdgcn_mfma_f32_16x16x32_bf16(Sf, Qf[kk], O2[et], 0, 0, 0);
        }
    const float qd = __expf(lg * (float)(it + 1));
    float sum = 0.f;
#pragma unroll
    for (int et = 0; et < 8; ++et)
#pragma unroll
        for (int r = 0; r < 4; ++r) { const float o = O1[et][r] + qd * O2[et][r]; O1[et][r] = o; sum += o; }
    sum += __shfl_xor(sum, 16); sum += __shfl_xor(sum, 32);
    const float mu = sum * (1.f / 128.f);
    float vs = 0.f;
#pragma unroll
    for (int et = 0; et < 8; ++et)
#pragma unroll
        for (int r = 0; r < 4; ++r) { const float dlt = O1[et][r] - mu; vs += dlt * dlt; }
    vs += __shfl_xor(vs, 16); vs += __shfl_xor(vs, 32);
    const float rstd = rsqrtf(vs * (1.f / 128.f) + 1e-6f);
#pragma unroll
    for (int et = 0; et < 8; ++et) {
        const int e = 16 * et + 4 * g;
        const u32x2 gz = *(const u32x2*)(Z + qrow * INW + 2304 + h * 128 + e);
        const f32x4 gw = *(const f32x4*)(p.ret_gn_w + h * 128 + e);
        const float r0 = (O1[et][0] - mu) * rstd * gw[0] * silu_f(bflo(gz[0])), r1 = (O1[et][1] - mu) * rstd * gw[1] * silu_f(bfhi(gz[0]));
        const float r2 = (O1[et][2] - mu) * rstd * gw[2] * silu_f(bflo(gz[1])), r3 = (O1[et][3] - mu) * rstd * gw[3] * silu_f(bfhi(gz[1]));
        u32x2 o; o[0] = cvt_pk_bf16(r0, r1); o[1] = cvt_pk_bf16(r2, r3);
        *(u32x2*)(MIX + qrow * DM + 512 + h * 128 + e) = o;
    }
    __syncthreads();
}

__device__ void sample_item(const Params& p, unsigned char* shm, int b) {
    const int tid = threadIdx.x, wid = tid >> 6, lane = tid & 63;
    const bf16_t* zrow = (const bf16_t*)(p.ws + WS_Z) + (size_t)(TP + b) * INW; bf16_t* mixrow = (bf16_t*)(p.ws + WS_MIX) + (size_t)(TP + b) * DM;
    float* sm = (float*)shm;
    float* qn = sm;
    float* kn = qn + 512;
    float* vn = kn + 128;
    float* rqn = vn + 128;
    float* rkn = rqn + 512;
    float* rvv = rkn + 512;
    float* scs = rvv + 512;
    float* red = scs + 8 * 132;
    float* ov = red + 512;
    { const int hh = tid >> 6, pp = tid & 63; qn[hh * 64 + att_dim(pp)] = bf2f(zrow[tid]); }
    if (tid < 128) { const int hh = tid >> 6, pp = tid & 63; kn[hh * 64 + att_dim(pp)] = bf2f(zrow[512 + tid]); vn[tid] = bf2f(zrow[640 + tid]); }
    { const int hh = tid >> 7, pp = tid & 127; rqn[hh * 128 + ret_dim(pp)] = bf2f(zrow[768 + tid]); rkn[hh * 128 + ret_dim(pp)] = bf2f(zrow[1280 + tid]); rvv[tid] = bf2f(zrow[1792 + tid]); }
    __syncthreads();
    const float* ck = p.cache_k + (size_t)b * 128 * 128; const float* cv = p.cache_v + (size_t)b * 128 * 128;
#pragma unroll
    for (int itr = 0; itr < 2; ++itr) {
        const int idx = tid + 512 * itr, hd = idx >> 7, w = idx & 127, kvh = hd >> 2;
        const float* kr = ck + (w * 2 + kvh) * 64; const float* qr = qn + hd * 64;
        float s = 0.f;
#pragma unroll
        for (int d = 0; d < 64; d += 4) { const f32x4 kv = *(const f32x4*)(kr + d); s += qr[d] * kv[0] + qr[d + 1] * kv[1] + qr[d + 2] * kv[2] + qr[d + 3] * kv[3]; }
        scs[hd * 132 + w] = s * 0.125f;
    }
    if (tid < 8) { const int kvh = tid >> 2; float s = 0.f; for (int d = 0; d < 64; ++d) s += qn[tid * 64 + d] * kn[kvh * 64 + d]; scs[tid * 132 + 128] = s * 0.125f; }
    __syncthreads();
    {
        const float sink = p.att_sinks[wid];
        const float s0 = scs[wid * 132 + lane], s1 = scs[wid * 132 + 64 + lane], s2 = lane == 0 ? scs[wid * 132 + 128] : -INFINITY;
        float mx = fmaxf(fmaxf(s0, s1), fmaxf(s2, sink));
#pragma unroll
        for (int o = 32; o >= 1; o >>= 1) mx = fmaxf(mx, __shfl_xor(mx, o));
        const float e0 = __expf(s0 - mx), e1 = __expf(s1 - mx), e2 = lane == 0 ? __expf(s2 - mx) : 0.f;
        float sum = e0 + e1 + e2;
#pragma unroll
        for (int o = 32; o >= 1; o >>= 1) sum += __shfl_xor(sum, o);
        const float inv = 1.f / (sum + __expf(sink - mx));
        scs[wid * 132 + lane] = e0 * inv; scs[wid * 132 + 64 + lane] = e1 * inv; if (lane == 0) scs[wid * 132 + 128] = e2 * inv;
    }
    __syncthreads();
    {
        const int hd = tid >> 6, d = tid & 63, kvh = hd >> 2;
        float o = scs[hd * 132 + 128] * vn[kvh * 64 + d];
#pragma unroll 8
        for (int w = 0; w < 128; ++w) o += scs[hd * 132 + w] * cv[(w * 2 + kvh) * 64 + d];
        mixrow[hd * 64 + d] = f2bf(o);
    }
    for (int i = tid; i < 127 * 32; i += 512) {
        *(f32x4*)(p.out + O_KS + (size_t)b * 16384 + i * 4) = *(const f32x4*)(ck + 128 + i * 4);
        *(f32x4*)(p.out + O_VS + (size_t)b * 16384 + i * 4) = *(const f32x4*)(cv + 128 + i * 4);
    }
    for (int h = 0; h < 4; ++h) {
        const float gm = __expf(log_gamma(h));
        const int e = tid & 127, dq = tid >> 7;
        const float* sp = p.state_ret + ((size_t)(b * 4 + h) * 128 + dq * 32) * 128 + e;
        float* so = p.out + O_RS + ((size_t)(b * 4 + h) * 128 + dq * 32) * 128 + e;
        const float ve = rvv[h * 128 + e];
        float part = 0.f;
#pragma unroll 8
        for (int d = 0; d < 32; ++d) { const float s = sp[d * 128]; part += rqn[h * 128 + dq * 32 + d] * s; so[d * 128] = gm * s + rkn[h * 128 + dq * 32 + d] * ve; }
        red[dq * 128 + e] = part;
        __syncthreads();
        if (tid < 128) {
            float qk = 0.f;
            for (int d = 0; d < 128; ++d) qk += rqn[h * 128 + d] * rkn[h * 128 + d];
            ov[tid] = qk * ve + gm * (red[e] + red[128 + e] + red[256 + e] + red[384 + e]);
        }
        __syncthreads();
        if (tid < 128) {
            float mu = 0.f; for (int i = 0; i < 128; ++i) mu += ov[i]; mu *= (1.f / 128.f);
            float vs = 0.f; for (int i = 0; i < 128; ++i) { const float dl = ov[i] - mu; vs += dl * dl; }
            const float rstd = rsqrtf(vs * (1.f / 128.f) + 1e-6f);
            const float gz = bf2f(zrow[2304 + h * 128 + e]);
            mixrow[512 + h * 128 + e] = f2bf((ov[e] - mu) * rstd * p.ret_gn_w[h * 128 + e] * silu_f(gz));
        }
        __syncthreads();
    }
}

__device__ void phase_ln1(const Params& p) {
    const float* mod = (const float*)(p.ws + WS_MOD); const float* stat = (const float*)(p.ws + WS_STAT1); bf16_t* H = (bf16_t*)(p.ws + WS_H);
    const int gt = blockIdx.x * 512 + threadIdx.x, gs = gridDim.x * 512;
    for (int i = gt; i < TV * 128; i += gs) {
        const int r = i >> 7, c = (i & 127) * 8;
        float* yr = p.out + (size_t)r * DM + c;
        const float mu = stat[2 * r] * (1.f / 1024.f), var = stat[2 * r + 1] * (1.f / 1024.f) - mu * mu, rstd = rsqrtf(fmaxf(var, 0.f) + 1e-5f);
        const int mrow = r < TP ? 128 + (r >> 12) : r - TP;
        const float* sh = mod + (size_t)mrow * 6144 + 3072 + c; const float* scl = sh + 1024;
        f32x4 y0 = *(const f32x4*)yr, y1 = *(const f32x4*)(yr + 4);
        y0 = (y0 - mu) * rstd * *(const f32x4*)(p.ln1_w + c) + *(const f32x4*)(p.ln1_b + c);
        y1 = (y1 - mu) * rstd * *(const f32x4*)(p.ln1_w + c + 4) + *(const f32x4*)(p.ln1_b + c + 4);
        *(f32x4*)yr = y0; *(f32x4*)(yr + 4) = y1;
        const f32x4 h0 = y0 * (1.f + *(const f32x4*)scl) + *(const f32x4*)sh, h1 = y1 * (1.f + *(const f32x4*)(scl + 4)) + *(const f32x4*)(sh + 4);
        u32x4 pk; pk[0] = cvt_pk_bf16(h0[0], h0[1]); pk[1] = cvt_pk_bf16(h0[2], h0[3]); pk[2] = cvt_pk_bf16(h1[0], h1[1]); pk[3] = cvt_pk_bf16(h1[2], h1[3]);
        *(u32x4*)(H + (size_t)r * DM + c) = pk;
    }
}
__device__ void phase_ln2(const Params& p) {
    const float* stat = (const float*)(p.ws + WS_STAT2);
    const int gt = blockIdx.x * 512 + threadIdx.x, gs = gridDim.x * 512;
    for (int i = gt; i < TV * 128; i += gs) {
        const int r = i >> 7, c = (i & 127) * 8;
        float* yr = p.out + (size_t)r * DM + c;
        const float mu = stat[2 * r] * (1.f / 1024.f), var = stat[2 * r + 1] * (1.f / 1024.f) - mu * mu, rstd = rsqrtf(fmaxf(var, 0.f) + 1e-5f);
        f32x4 y0 = *(const f32x4*)yr, y1 = *(const f32x4*)(yr + 4);
        y0 = (y0 - mu) * rstd * *(const f32x4*)(p.ln2_w + c) + *(const f32x4*)(p.ln2_b + c);
        y1 = (y1 - mu) * rstd * *(const f32x4*)(p.ln2_w + c + 4) + *(const f32x4*)(p.ln2_b + c + 4);
        *(f32x4*)yr = y0; *(f32x4*)(yr + 4) = y1;
    }
}

#define XB_TMO      128
#define XB_XCNT(j)  (256  + 64 * (j))
#define XB_XSUB(j)  (1280 + 64 * (j))
#define XB_XGEN(j)  (2304 + 64 * (j))
#define XB_TOP      3328
#define XB_TOPGEN   3392
#define XCD_BAR_WORDS 3456
#define XB_SPIN_CAP (1u << 18)
__device__ __forceinline__ unsigned xb_ld(unsigned* p)              { return __hip_atomic_load(p, __ATOMIC_RELAXED, __HIP_MEMORY_SCOPE_AGENT); }
__device__ __forceinline__ unsigned xb_add(unsigned* p, unsigned v) { return __hip_atomic_fetch_add(p, v, __ATOMIC_RELAXED, __HIP_MEMORY_SCOPE_AGENT); }
__device__ __forceinline__ unsigned xb_xcc_id() { return (unsigned)__builtin_amdgcn_s_getreg((3 << 11) | 20) & 0xFu; }
#define XB_SPIN(cond, bar) do { unsigned _sp = 0; while (cond) { __builtin_amdgcn_s_sleep(1); \
    if ((++_sp & 255u) == 0u) { if (xb_ld(&(bar)[XB_TMO])) break; if (_sp > XB_SPIN_CAP) { atomicAdd(&(bar)[XB_TMO], 1u); break; } } } } while (0)
struct XcdBarrier { unsigned* bar; unsigned x; volatile LAS unsigned* st; };
__device__ __forceinline__ XcdBarrier xcd_barrier_post(unsigned* bar, volatile LAS unsigned* st) {
    XcdBarrier b; b.bar = bar; b.x = xb_xcc_id(); b.st = st;
    if (threadIdx.x == 0) (void)xb_add(&bar[XB_XCNT(b.x)], 1u);
    return b;
}
__device__ __forceinline__ void xcd_barrier_complete(unsigned* bar, unsigned x, unsigned& nloc, unsigned& nx) {
    const unsigned G = gridDim.x * gridDim.y * gridDim.z;
    unsigned sum, cnt, mine, sp = 0u;
    for (;;) {
        sum = 0u; cnt = 0u; mine = 0u;
#pragma unroll
        for (unsigned j = 0; j < 16; ++j) { const unsigned c = xb_ld(&bar[XB_XCNT(j)]); sum += c; cnt += (c > 0u) ? 1u : 0u; mine = (j == x) ? c : mine; }
        if (sum == G) break;
        __builtin_amdgcn_s_sleep(1);
        if ((++sp & 255u) == 0u) { if (xb_ld(&bar[XB_TMO])) break; if (sp > XB_SPIN_CAP) { atomicAdd(&bar[XB_TMO], 1u); break; } }
    }
    nloc = mine > 0u ? mine : 1u; nx = cnt > 0u ? cnt : 1u;
}
__device__ __forceinline__ void xcd_barrier(const XcdBarrier& b) {
    asm volatile("s_waitcnt vmcnt(0)" ::: "memory");
    __syncthreads();
    if (threadIdx.x == 0) {
        unsigned* bar = b.bar;
        __builtin_amdgcn_s_waitcnt(0);
        unsigned nloc = b.st[0], nx = b.st[1];
        if (nloc == 0u) { xcd_barrier_complete(bar, b.x, nloc, nx); b.st[0] = nloc; b.st[1] = nx; }
        const unsigned old = xb_add(&bar[XB_XSUB(b.x)], 1u);
        const unsigned gen = old / nloc;
        if (old + 1u == (gen + 1u) * nloc) {
            __builtin_amdgcn_fence(__ATOMIC_RELEASE, "agent");
            asm volatile("s_waitcnt vmcnt(0)" ::: "memory");
            const unsigned og = xb_add(&bar[XB_TOP], 1u);
            const unsigned tg = og / nx;
            if (og + 1u == (tg + 1u) * nx) xb_add(&bar[XB_TOPGEN], 1u);
            else XB_SPIN(xb_ld(&bar[XB_TOPGEN]) == tg, bar);
            __builtin_amdgcn_fence(__ATOMIC_ACQUIRE, "agent");
            xb_add(&bar[XB_XGEN(b.x)], 1u);
            asm volatile("s_waitcnt vmcnt(0)" ::: "memory");
        } else {
            XB_SPIN(xb_ld(&bar[XB_XGEN(b.x)]) == gen, bar);
            __builtin_amdgcn_fence(__ATOMIC_ACQUIRE, "agent");
            asm volatile("s_waitcnt vmcnt(0)" ::: "memory");
        }
    }
    __syncthreads();
}

typedef __attribute__((address_space(4))) const unsigned char* kptr_t;
__device__ __forceinline__ Params load_params() {
#if defined(__HIP_DEVICE_COMPILE__)
    kptr_t k = (kptr_t)__builtin_amdgcn_kernarg_segment_ptr();
    asm volatile("" : "+s"(k));
    Params r;
    __builtin_memcpy(&r, (const __attribute__((address_space(4))) void*)k, sizeof(Params));
    return r;
#else
    return Params{};
#endif
}
__global__ void __launch_bounds__(512, 2) fwd(Params p_arg, int ph_lo, int ph_hi, int coop) {
    extern __shared__ __attribute__((aligned(16))) unsigned char shm[];
    cg::grid_group grid = cg::this_grid();
    LAS unsigned char* lds = (LAS unsigned char*)shm;
    const int G = gridDim.x, bid = blockIdx.x;
    volatile LAS unsigned* bst = (volatile LAS unsigned*)(lds + 131072);
    if (threadIdx.x < 4) bst[threadIdx.x] = 0u;
    __syncthreads();
    (void)xcd_barrier_post((unsigned*)(p_arg.ws + WS_BAR), bst);
    if (coop > 1) grid.sync();
#define GSYNC() do { XcdBarrier xb_; xb_.bar = (unsigned*)(load_params().ws + WS_BAR); xb_.x = xb_xcc_id(); xb_.st = (volatile LAS unsigned*)((LAS unsigned char*)shm + 131072); xcd_barrier(xb_); } while (0)
#ifndef ONLY
#define ONLY -1
#endif
#ifndef REP_PH
#define REP_PH -1
#endif
#ifndef REP_SYNC
#define REP_SYNC 0
#endif
#define PH_BEGIN(n) if ((ONLY < 0 || ONLY == n) && ph_lo <= n && n < ph_hi) { if (n > ph_lo && coop) GSYNC(); for (int rep_ = 0; rep_ < (REP_PH == n ? 2 : 1); ++rep_) { if (rep_) GSYNC(); const Params p = load_params();
#define PH_END } }
    for (int i_ = 0; i_ < REP_SYNC; ++i_) GSYNC();
    PH_BEGIN(0) phase_prep(p, shm); PH_END
    PH_BEGIN(1) { pg8::Gemm g{(const bf16_t*)(p.ws + WS_SC), (const bf16_t*)(p.ws + WS_WADA), 256, 6144, DM}; pg8::StaticOrder S; S.init(g.M, g.N, G, bid);
                  EpiAda E{(float*)(p.ws + WS_MOD), p.b_ada_mix, p.b_ada_ffn}; pg8::gemm_phase(lds, g, S, E); } PH_END
    PH_BEGIN(2) phase_modulate(p); PH_END
    PH_BEGIN(3) { pg8::Gemm g{(const bf16_t*)(p.ws + WS_H), (const bf16_t*)(p.ws + WS_WIN), TPAD, INW, DM}; pg8::StaticOrder S; S.init(g.M, g.N, G, bid);
                  EpiIn E{(bf16_t*)(p.ws + WS_Z), (const float*)(p.ws + WS_ROPEA), (const float*)(p.ws + WS_ROPER), p.out}; pg8::gemm_phase(lds, g, S, E); } PH_END
    PH_BEGIN(4) { for (int it = bid; it < 1024; it += G) retu_item(p, shm, it); for (int it = bid; it < 512; it += G) attn_item(p, shm, it); for (int it = G - 1 - bid; it < 128; it += G) sample_item(p, shm, it); } PH_END
    PH_BEGIN(5) phase_scan(p); PH_END
    PH_BEGIN(6) for (int it = bid; it < 1024; it += G) reto_item(p, shm, it); PH_END
    PH_BEGIN(7) { pg8::Gemm g{(const bf16_t*)(p.ws + WS_MIX), (const bf16_t*)(p.ws + WS_WOUT), TPAD, DM, DM}; pg8::StaticOrder S; S.init(g.M, g.N, G, bid);
                  EpiRes E{p.x_prompt, p.x_sample, p.out, (const float*)(p.ws + WS_MOD), 2048, (float*)(p.ws + WS_STAT1)}; pg8::gemm_phase(lds, g, S, E); } PH_END
    PH_BEGIN(8) phase_ln1(p); PH_END
    PH_BEGIN(9) { pg8::Gemm g{(const bf16_t*)(p.ws + WS_H), (const bf16_t*)(p.ws + WS_WUP), TPAD, 2 * DFF, DM}; pg8::StaticOrder S; S.init(g.M, g.N, G, bid);
                  EpiUp E{(bf16_t*)(p.ws + WS_Z)}; pg8::gemm_phase(lds, g, S, E); } PH_END
    PH_BEGIN(10) { pg8::Gemm g{(const bf16_t*)(p.ws + WS_Z), (const bf16_t*)(p.ws + WS_WDOWN), TPAD, DM, DFF}; pg8::StaticOrder S; S.init(g.M, g.N, G, bid);
                   EpiRes E{p.out + O_YP, p.out + O_YS, p.out, (const float*)(p.ws + WS_MOD), 3072 + 2048, (float*)(p.ws + WS_STAT2)}; pg8::gemm_phase(lds, g, S, E); } PH_END
    PH_BEGIN(11) phase_ln2(p); PH_END
}

extern "C" void kernel_launch(void* const* d_in, const int* in_sizes, int n_in, void* d_out, int out_size, void* d_ws, size_t ws_size, hipStream_t stream) {
    constexpr int LDS_BYTES = 131072 + 64;
    static int grid = 0;
    if (!grid) {
        int dev = 0, cus = 0, per_cu = 0;
        (void)hipGetDevice(&dev);
        (void)hipDeviceGetAttribute(&cus, hipDeviceAttributeMultiprocessorCount, dev);
        (void)hipFuncSetAttribute((const void*)fwd, hipFuncAttributeMaxDynamicSharedMemorySize, LDS_BYTES);
        (void)hipOccupancyMaxActiveBlocksPerMultiprocessor(&per_cu, (const void*)fwd, 512, LDS_BYTES);
        grid = cus > 0 ? cus : 256;
        if (ws_size < WS_END) fprintf(stderr, "kernel_launch: workspace too small: %zu < %zu\n", ws_size, (size_t)WS_END);
        fprintf(stderr, "kernel_launch: cus %d per_cu %d grid %d ws %zu need %zu\n", cus, per_cu, grid, ws_size, (size_t)WS_END);
    }
    Params p{};
    const float** f = (const float**)&p;
    for (int i = 0; i < 21; ++i) f[i] = (const float*)d_in[i];
    p.out = (float*)d_out; p.ws = (unsigned char*)d_ws;
#ifndef MULTI_LAUNCH
    (void)hipMemsetAsync((unsigned char*)d_ws + WS_BAR, 0, 16384, stream);
    int lo = 0, hi = 12, coop = 1;
    void* args[] = {&p, &lo, &hi, &coop};
    hipError_t e = hipLaunchCooperativeKernel((const void*)fwd, dim3(grid), dim3(512), args, LDS_BYTES, stream);
    if (e != hipSuccess) fprintf(stderr, "cooperative launch failed: %s (grid %d)\n", hipGetErrorString(e), grid);
#else
    for (int ph = 0; ph < 12; ++ph) hipLaunchKernelGGL(fwd, dim3(grid), dim3(512), LDS_BYTES, stream, p, ph, ph + 1, 0);
#endif
}
```

```cpp
#include <hip/hip_runtime.h>
#include <hip/hip_cooperative_groups.h>
#include <cstdio>
namespace cg = cooperative_groups;

#define LAS __attribute__((address_space(3)))
typedef unsigned short bf16_t;
typedef short bf16x8 __attribute__((ext_vector_type(8)));
typedef float f32x4 __attribute__((ext_vector_type(4)));
typedef unsigned u32x4 __attribute__((ext_vector_type(4)));
typedef unsigned u32x2 __attribute__((ext_vector_type(2)));

constexpr int DM = 1024, SEQ = 4096, NBATCH = 8, TP = NBATCH * SEQ  , NS = 128, TV = TP + NS  , TPAD = TP + 256  ;
constexpr int INW = 2816, DFF = 2816, PAST = 16384;
constexpr float ALPHA = 1.189207115002721f;
constexpr float RK_SCALE = 0.08838834764831845f;
constexpr size_t O_YP = 0, O_YS = (size_t)TP * DM, O_KP = O_YS + (size_t)NS * DM, O_VP = O_KP + 131072, O_RP = O_VP + 131072,
                 O_KS = O_RP + 524288, O_VS = O_KS + 2097152, O_RS = O_VS + 2097152;
constexpr size_t al256(size_t x) { return (x + 255) & ~(size_t)255; }
constexpr size_t WS_WIN = 0;
constexpr size_t WS_WOUT = WS_WIN + (size_t)INW * DM * 2;
constexpr size_t WS_WUP = WS_WOUT + (size_t)DM * DM * 2;
constexpr size_t WS_WDOWN = WS_WUP + (size_t)2 * DFF * DM * 2;
constexpr size_t WS_WADA = WS_WDOWN + (size_t)DM * DFF * 2;
constexpr size_t WS_SC = WS_WADA + (size_t)6144 * DM * 2;
constexpr size_t WS_MOD = WS_SC + (size_t)256 * DM * 2;
constexpr size_t WS_ROPEA = WS_MOD + (size_t)256 * 6144 * 4;
constexpr size_t WS_ROPER = al256(WS_ROPEA + (size_t)4097 * 16 * 4);
constexpr size_t WS_STAT1 = al256(WS_ROPER + (size_t)4097 * 128 * 4);
constexpr size_t WS_STAT2 = WS_STAT1 + (size_t)TPAD * 2 * 4;
constexpr size_t WS_H = al256(WS_STAT2 + (size_t)TPAD * 2 * 4);
constexpr size_t WS_Z = WS_H + (size_t)TPAD * DM * 2;
constexpr size_t WS_MIX = WS_Z + (size_t)TPAD * INW * 2;
constexpr size_t WS_SST = WS_MIX + (size_t)TPAD * DM * 2;
constexpr size_t WS_BAR = WS_SST + (size_t)1024 * 16384 * 2;
constexpr size_t WS_END = WS_BAR + 16384;

struct Params {
    const float *x_prompt, *x_sample, *c_prompt, *c_sample, *cache_k, *cache_v, *state_ret, *w_ada_mix, *b_ada_mix, *w_in, *att_sinks, *ret_gn_w, *w_out,
        *ln1_w, *ln1_b, *w_ada_ffn, *b_ada_ffn, *w_up, *w_down, *ln2_w, *ln2_b;
    float* out; unsigned char* ws;
};

__device__ __forceinline__ unsigned cvt_pk_bf16(float lo, float hi) { unsigned r; asm volatile("v_cvt_pk_bf16_f32 %0, %1, %2" : "=v"(r) : "v"(lo), "v"(hi)); return r; }
__device__ __forceinline__ float bf2f(bf16_t b) { return __uint_as_float(((unsigned)b) << 16); }
__device__ __forceinline__ bf16_t f2bf(float f) { return (bf16_t)(cvt_pk_bf16(f, 0.f) & 0xffffu); }
__device__ __forceinline__ float bflo(unsigned u) { return __uint_as_float(u << 16); }
__device__ __forceinline__ float bfhi(unsigned u) { return __uint_as_float(u & 0xffff0000u); }
__device__ __forceinline__ float silu_f(float v) { return v / (1.f + __expf(-v)); }
__device__ __forceinline__ float log_gamma(int h) {
    return h == 0 ? -0.0317486983145803f : (h == 1 ? -0.012479111952334388f : (h == 2 ? -0.004933717393740471f : -0.0019550348358033506f));
}
__device__ __forceinline__ int att_dim(int p) { if (p >= 16) return p; const int g = p >> 3, j = p & 7; return j < 4 ? 4 * g + j : 8 + 4 * g + (j - 4); }
__device__ __forceinline__ int ret_dim(int p) { const int g = p >> 3, j = p & 7; return j < 4 ? 4 * g + j : 64 + 4 * g + (j - 4); }
__device__ __forceinline__ int in_col(int P) {
    if (P < 640) return (P & ~63) + att_dim(P & 63);
    if (P >= 768 && P < 1792) { const int p = (P - 768) & 127; return P - p + ret_dim(p); }
    return P;
}
__device__ __forceinline__ int up_col(int P) { const int pn = P >> 8, q = P & 255; return q < 128 ? pn * 128 + q : DFF + pn * 128 + (q - 128); }

namespace pg8 {
constexpr int BM = 256, BK = 64, HALF = 128, HTB = HALF * BK * 2, STAGE_BYTES = 8 * HTB, NXCD = 8, WGM = 8;
__device__ __forceinline__ int lds_byte(int r, int c) { const int st = (r >> 4) * 2 + (c >> 5), rr = r & 15, cc = c & 31, ob = rr * 64 + cc * 2; return st * 1024 + (ob ^ (((ob >> 9) & 1) << 5)); }
__device__ __forceinline__ void stage_rc(int b, int& R, int& C) { const int st = b / 1024, sb = b % 1024, swz = sb ^ (((sb >> 9) & 1) << 5); R = (st >> 1) * 16 + swz / 64; C = (st & 1) * 32 + (swz % 64) / 2; }
__device__ __forceinline__ int perm32(int rho) { const int n = rho >> 4, i = rho & 15; return 8 * (i >> 2) + 4 * n + (i & 3); }
struct Unit { int pm, pn; };
struct Gemm { const bf16_t* A; const bf16_t* Bt; int M, N, K; };
struct StaticOrder {
    int nM, nN, nwg, G, c;
    __device__ void init(int M, int N, int G_, int c_) { nM = M / BM; nN = N / BM; nwg = nM * nN; G = G_; c = c_; }
    __device__ bool next(int i, Unit& u) const {
        const long L = (long)i * G + c; if (L >= nwg) return false;
        int wgid = (int)L; { const int q = nwg / NXCD, r = nwg % NXCD, xcd = wgid % NXCD, off = wgid / NXCD; wgid = (xcd < r ? xcd * (q + 1) : r * (q + 1) + (xcd - r) * q) + off; }
        const int nig = WGM * nN, gid = wgid / nig, fm = gid * WGM, gsz = (nM - fm) < WGM ? (nM - fm) : WGM;
        u.pm = fm + ((wgid % nig) % gsz); u.pn = (wgid % nig) / gsz; return true;
    }
};

template <class Epi, class Sched>
__device__ __forceinline__ void gemm_phase(LAS unsigned char* lds, const Gemm g, const Sched& S, const Epi& E) {
    const int tid = threadIdx.x, wid = __builtin_amdgcn_readfirstlane(tid >> 6), lane = tid & 63, wr = wid >> 2, wc = wid & 3, fr = lane & 15, fq = lane >> 4;
    const int K = g.K, nt = K / BK;
    unsigned voffA[2], voffB[2];
#pragma unroll
    for (int i = 0; i < 2; ++i) { int R, C; stage_rc(tid * 16 + i * 8192, R, C); const int Rb = Epi::PERM ? ((R & ~31) + perm32(R & 31)) : R;
        voffA[i] = (unsigned)(R * K + C) * 2u; voffB[i] = (unsigned)(Rb * K + C) * 2u; }
    const size_t kstep = (size_t)(BK * 2);
    const size_t hstep = (size_t)HALF * K * 2;
    const size_t tstep = 2 * hstep;
    const unsigned ldsw = (unsigned)wid * 1024u;
    const int aoff = lds_byte(wr * 64 + fr, fq * 8), boff = lds_byte(wc * 32 + fr, fq * 8);
#define PG8_SA(b, h) (((b) * 2 + (h)) * HTB)
#define PG8_SB(b, h) ((4 + (b) * 2 + (h)) * HTB)
#define PG8_STAGE(bufoff, gbase, voff) do { _Pragma("unroll") for (int _i = 0; _i < 2; ++_i) \
        __builtin_amdgcn_global_load_lds((const unsigned*)((const char*)(gbase) + (voff)[_i]), (LAS unsigned*)(lds + (bufoff) + ldsw + _i * 8192), 16, 0, 0); } while (0)
#define PG8_LDA(dst, b, h) do { _Pragma("unroll") for (int m = 0; m < 4; ++m) _Pragma("unroll") for (int k = 0; k < 2; ++k) dst[m][k] = *(const LAS bf16x8*)(lds + PG8_SA(b, h) + aoff + m * 2048 + k * 1024); } while (0)
#define PG8_LDB(dst, b, h) do { _Pragma("unroll") for (int n = 0; n < 2; ++n) _Pragma("unroll") for (int k = 0; k < 2; ++k) dst[n][k] = *(const LAS bf16x8*)(lds + PG8_SB(b, h) + boff + n * 2048 + k * 1024); } while (0)
#define PG8_MMA(ai, bj, At, Bt) do { __builtin_amdgcn_s_setprio(1); _Pragma("unroll") for (int m = 0; m < 4; ++m) _Pragma("unroll") for (int n = 0; n < 2; ++n) _Pragma("unroll") for (int k = 0; k < 2; ++k) \
        acc[ai][bj][m][n] = __builtin_amdgcn_mfma_f32_16x16x32_bf16(Bt[n][k], At[m][k], acc[ai][bj][m][n], 0, 0, 0); __builtin_amdgcn_s_setprio(0); } while (0)
#define PG8_WAIT_V(n) asm volatile("s_waitcnt vmcnt(" #n ")" ::: "memory")
#define PG8_WAIT_L(n) asm volatile("s_waitcnt lgkmcnt(" #n ")" ::: "memory")
#define PG8_BAR __builtin_amdgcn_s_barrier()
#define PG8_SCHED __builtin_amdgcn_sched_barrier(0)
    Unit cur, nxt; int ui = 0;
    if (!S.next(0, cur)) return;
    f32x4 acc[2][2][4][2];
#pragma unroll
    for (int a = 0; a < 2; ++a)
#pragma unroll
        for (int b = 0; b < 2; ++b)
#pragma unroll
            for (int m = 0; m < 4; ++m)
#pragma unroll
                for (int n = 0; n < 2; ++n) acc[a][b][m][n] = (f32x4){0.f, 0.f, 0.f, 0.f};
    bf16x8 At[4][2], B0[2][2], B1[2][2];
    const char* cA = (const char*)g.A + (size_t)cur.pm * tstep; const char* cB = (const char*)g.Bt + (size_t)cur.pn * tstep;
    PG8_STAGE(PG8_SB(0, 0), cB, voffB); PG8_STAGE(PG8_SA(0, 0), cA, voffA); PG8_STAGE(PG8_SB(0, 1), cB + hstep, voffB); PG8_STAGE(PG8_SA(0, 1), cA + hstep, voffA);
    if (wr == 1) PG8_BAR;
    PG8_WAIT_V(4); PG8_BAR;
    PG8_STAGE(PG8_SB(1, 0), cB + kstep, voffB); PG8_STAGE(PG8_SA(1, 0), cA + kstep, voffA); PG8_STAGE(PG8_SB(1, 1), cB + hstep + kstep, voffB);
    PG8_WAIT_V(6); PG8_BAR;
    for (;;) {
        const bool has_next = S.next(ui + 1, nxt);
        const char* nA = has_next ? (const char*)g.A + (size_t)nxt.pm * tstep : cA; const char* nB = has_next ? (const char*)g.Bt + (size_t)nxt.pn * tstep : cB;
        for (int t = 0; t < nt; t += 2) {
            const bool last = (t == nt - 2);
            const char* a1 = cA + (size_t)(t + 1) * kstep;
            const char* a2 = last ? nA : cA + (size_t)(t + 2) * kstep; const char* b2 = last ? nB : cB + (size_t)(t + 2) * kstep;
            const char* a3 = a2 + kstep; const char* b3 = b2 + kstep;
            PG8_LDB(B0, 0, 0); PG8_SCHED; PG8_LDA(At, 0, 0); PG8_STAGE(PG8_SA(1, 1), a1 + hstep, voffA);
            PG8_WAIT_L(8); PG8_BAR; PG8_WAIT_L(0); PG8_MMA(0, 0, At, B0); PG8_BAR; PG8_SCHED;
            PG8_LDB(B1, 0, 1); PG8_STAGE(PG8_SB(0, 0), b2, voffB);
            PG8_BAR; PG8_WAIT_L(0); PG8_MMA(0, 1, At, B1); PG8_BAR;
            PG8_LDA(At, 0, 1); PG8_STAGE(PG8_SA(0, 0), a2, voffA);
            PG8_BAR; PG8_WAIT_L(0); PG8_MMA(1, 0, At, B0); PG8_BAR; PG8_SCHED;
            PG8_STAGE(PG8_SB(0, 1), b2 + hstep, voffB);
            PG8_WAIT_V(6); PG8_BAR; PG8_MMA(1, 1, At, B1); PG8_BAR;
            PG8_LDB(B0, 1, 0); PG8_SCHED; PG8_LDA(At, 1, 0); PG8_STAGE(PG8_SA(0, 1), a2 + hstep, voffA);
            PG8_WAIT_L(8); PG8_BAR; PG8_WAIT_L(0); PG8_MMA(0, 0, At, B0); PG8_BAR; PG8_SCHED;
            PG8_LDB(B1, 1, 1); PG8_STAGE(PG8_SB(1, 0), b3, voffB);
            PG8_BAR; PG8_WAIT_L(0); PG8_MMA(0, 1, At, B1); PG8_BAR;
            PG8_LDA(At, 1, 1); PG8_STAGE(PG8_SA(1, 0), a3, voffA);
            PG8_BAR; PG8_WAIT_L(0); PG8_MMA(1, 0, At, B0); PG8_BAR; PG8_SCHED;
            PG8_STAGE(PG8_SB(1, 1), b3 + hstep, voffB);
            PG8_WAIT_V(6); PG8_BAR; PG8_MMA(1, 1, At, B1); PG8_BAR;
        }
        E(acc, cur, wr, wc, fr, fq);
        if (!has_next) break;
#pragma unroll
        for (int a = 0; a < 2; ++a)
#pragma unroll
            for (int b = 0; b < 2; ++b)
#pragma unroll
                for (int m = 0; m < 4; ++m)
#pragma unroll
                    for (int n = 0; n < 2; ++n) acc[a][b][m][n] = (f32x4){0.f, 0.f, 0.f, 0.f};
        cur = nxt; cA = nA; cB = nB; ++ui;
    }
    PG8_WAIT_V(0);
    if (wr == 0) PG8_BAR;
    PG8_BAR;
#undef PG8_SA
#undef PG8_SB
#undef PG8_STAGE
#undef PG8_LDA
#undef PG8_LDB
#undef PG8_MMA
#undef PG8_WAIT_V
#undef PG8_WAIT_L
#undef PG8_BAR
#undef PG8_SCHED
}
}
using pg8::Unit;

struct EpiAda {
    static constexpr bool PERM = false;
    float* mod; const float* b_mix; const float* b_ffn;
    __device__ __forceinline__ void operator()(const f32x4 (&acc)[2][2][4][2], const Unit& u, int wr, int wc, int fr, int fq) const {
#pragma unroll
        for (int ai = 0; ai < 2; ++ai)
#pragma unroll
            for (int m = 0; m < 4; ++m) {
                const int r = u.pm * 256 + ai * 128 + wr * 64 + m * 16 + fr;
#pragma unroll
                for (int bj = 0; bj < 2; ++bj)
#pragma unroll
                    for (int n = 0; n < 2; ++n) {
                        const int c = u.pn * 256 + bj * 128 + wc * 32 + n * 16 + fq * 4;
                        const f32x4 bv = c < 3072 ? *(const f32x4*)(b_mix + c) : *(const f32x4*)(b_ffn + c - 3072);
                        *(f32x4*)(mod + (size_t)r * 6144 + c) = acc[ai][bj][m][n] + bv;
                    }
            }
    }
};

struct EpiIn {
    static constexpr bool PERM = true;
    bf16_t* Z; const float* ropeA; const float* ropeR; float* out;
    __device__ __forceinline__ void operator()(const f32x4 (&acc)[2][2][4][2], const Unit& u, int wr, int wc, int fr, int fq) const {
#pragma unroll
        for (int bj = 0; bj < 2; ++bj) {
            const int cb128 = u.pn * 256 + bj * 128;
            const int cb = cb128 + wc * 32 + fq * 8;
            const int region = cb128 < 512 ? 0 : (cb128 < 640 ? 1 : (cb128 < 768 ? 2 : (cb128 < 1280 ? 3 : (cb128 < 1792 ? 4 : 5))));
#pragma unroll
            for (int ai = 0; ai < 2; ++ai)
#pragma unroll
                for (int m = 0; m < 4; ++m) {
                    const int r0 = u.pm * 256 + ai * 128 + wr * 64 + m * 16;
                    if (r0 >= TV) continue;
                    const int r = r0 + fr;
                    const int pos = r < TP ? (r & 4095) : 4096;
                    f32x4 v0 = acc[ai][bj][m][0], v1 = acc[ai][bj][m][1];
                    if (region <= 1) {
                        const int p = cb & 63;
                        if (p < 16) {
                            const int grp = p >> 3;
                            const f32x4 cs = *(const f32x4*)(ropeA + pos * 16 + 4 * grp), sn = *(const f32x4*)(ropeA + pos * 16 + 8 + 4 * grp);
                            const f32x4 a = v0 * cs - v1 * sn, b = v1 * cs + v0 * sn; v0 = a; v1 = b;
                        }
                    } else if (region == 3 || region == 4) {
                        const int g = (cb & 127) >> 3;
                        const f32x4 cs = *(const f32x4*)(ropeR + pos * 128 + 4 * g), sn = *(const f32x4*)(ropeR + pos * 128 + 64 + 4 * g);
                        f32x4 a = v0 * cs - v1 * sn, b = v1 * cs + v0 * sn;
                        if (region == 4) { a *= RK_SCALE; b *= RK_SCALE; }
                        v0 = a; v1 = b;
                    }
                    u32x4 pk; pk[0] = cvt_pk_bf16(v0[0], v0[1]); pk[1] = cvt_pk_bf16(v0[2], v0[3]); pk[2] = cvt_pk_bf16(v1[0], v1[1]); pk[3] = cvt_pk_bf16(v1[2], v1[3]);
                    *(u32x4*)(Z + (size_t)r * INW + cb) = pk;
                    if (region == 1 || region == 2) {
                        const int kvh = (cb >> 6) & 1, p = cb & 63;
                        int d0 = p, d1 = p + 4;
                        if (region == 1 && p < 16) { const int grp = p >> 3; d0 = 4 * grp; d1 = 8 + 4 * grp; }
                        float* dst = nullptr;
                        if (r < TP) { if (pos >= SEQ - 128) dst = out + (region == 1 ? O_KP : O_VP) + ((size_t)((r >> 12) * 128 + (pos - (SEQ - 128))) * 2 + kvh) * 64; }
                        else dst = out + (region == 1 ? O_KS : O_VS) + ((size_t)((r - TP) * 128 + 127) * 2 + kvh) * 64;
                        if (dst) { *(f32x4*)(dst + d0) = v0; *(f32x4*)(dst + d1) = v1; }
                    }
                }
        }
    }
};

struct EpiRes {
    static constexpr bool PERM = false;
    const float* baseP; const float* baseS; float* R; const float* mod; int gate_off; float* stat;
    __device__ __forceinline__ void operator()(const f32x4 (&acc)[2][2][4][2], const Unit& u, int wr, int wc, int fr, int fq) const {
#pragma unroll
        for (int ai = 0; ai < 2; ++ai)
#pragma unroll
            for (int m = 0; m < 4; ++m) {
                const int r0 = u.pm * 256 + ai * 128 + wr * 64 + m * 16;
                if (r0 >= TV) continue;
                const int r = r0 + fr;
                const int mrow = r < TP ? 128 + (r >> 12) : r - TP;
                const float* gate = mod + (size_t)mrow * 6144 + gate_off;
                const float* base = r < TP ? baseP + (size_t)r * DM : baseS + (size_t)(r - TP) * DM;
                float s = 0.f, ss = 0.f;
#pragma unroll
                for (int bj = 0; bj < 2; ++bj)
#pragma unroll
                    for (int n = 0; n < 2; ++n) {
                        const int c = u.pn * 256 + bj * 128 + wc * 32 + n * 16 + fq * 4;
                        const f32x4 xv = *(const f32x4*)(base + c), gv = *(const f32x4*)(gate + c);
                        const f32x4 res = ALPHA * xv + (1.f + gv) * acc[ai][bj][m][n];
                        *(f32x4*)(R + (size_t)r * DM + c) = res;
                        s += res[0] + res[1] + res[2] + res[3];
                        ss += res[0] * res[0] + res[1] * res[1] + res[2] * res[2] + res[3] * res[3];
                    }
                s += __shfl_xor(s, 16); ss += __shfl_xor(ss, 16);
                s += __shfl_xor(s, 32); ss += __shfl_xor(ss, 32);
                if (fq == 0) { atomicAdd(stat + 2 * r, s); atomicAdd(stat + 2 * r + 1, ss); }
            }
    }
};

struct EpiUp {
    static constexpr bool PERM = true;
    bf16_t* F;
    __device__ __forceinline__ void operator()(const f32x4 (&acc)[2][2][4][2], const Unit& u, int wr, int wc, int fr, int fq) const {
#pragma unroll
        for (int ai = 0; ai < 2; ++ai)
#pragma unroll
            for (int m = 0; m < 4; ++m) {
                const int r0 = u.pm * 256 + ai * 128 + wr * 64 + m * 16;
                if (r0 >= TV) continue;
                const int r = r0 + fr;
                float f[8];
#pragma unroll
                for (int n = 0; n < 2; ++n)
#pragma unroll
                    for (int i = 0; i < 4; ++i) { const float g = acc[ai][0][m][n][i]; f[n * 4 + i] = silu_f(g) * acc[ai][1][m][n][i]; }
                u32x4 pk; pk[0] = cvt_pk_bf16(f[0], f[1]); pk[1] = cvt_pk_bf16(f[2], f[3]); pk[2] = cvt_pk_bf16(f[4], f[5]); pk[3] = cvt_pk_bf16(f[6], f[7]);
                *(u32x4*)(F + (size_t)r * DFF + u.pn * 128 + wc * 32 + fq * 8) = pk;
            }
    }
};

__device__ void phase_prep(const Params& p, unsigned char* shm) {
    const int tid = threadIdx.x;
    bf16_t* tile = (bf16_t*)shm;
    for (int tt = blockIdx.x; tt < 1152; tt += gridDim.x) {
        const float* src; bf16_t* dst; int ld, K, mode, t;
        if (tt < 176) { t = tt; src = p.w_in; ld = INW; K = DM; dst = (bf16_t*)(p.ws + WS_WIN); mode = 1; }
        else if (tt < 240) { t = tt - 176; src = p.w_out; ld = DM; K = DM; dst = (bf16_t*)(p.ws + WS_WOUT); mode = 0; }
        else if (tt < 592) { t = tt - 240; src = p.w_up; ld = 2 * DFF; K = DM; dst = (bf16_t*)(p.ws + WS_WUP); mode = 2; }
        else if (tt < 768) { t = tt - 592; src = p.w_down; ld = DM; K = DFF; dst = (bf16_t*)(p.ws + WS_WDOWN); mode = 0; }
        else if (tt < 960) { t = tt - 768; src = p.w_ada_mix; ld = 3072; K = DM; dst = (bf16_t*)(p.ws + WS_WADA); mode = 0; }
        else { t = tt - 960; src = p.w_ada_ffn; ld = 3072; K = DM; dst = (bf16_t*)(p.ws + WS_WADA) + (size_t)3072 * DM; mode = 0; }
        const int nkt = K / 256, rt = t / nkt, kt = t % nkt;
        const int P = rt * 64 + (tid & 63);
        const int L = mode == 1 ? in_col(P) : (mode == 2 ? up_col(P) : P);
        const float* sp = src + (size_t)(kt * 256 + (tid >> 6)) * ld + L;
#pragma unroll
        for (int i = 0; i < 32; ++i) tile[(tid & 63) * 264 + (tid >> 6) + 8 * i] = f2bf(sp[(size_t)(8 * i) * ld]);
        __syncthreads();
        { const int pr = tid >> 3, kc = tid & 7;
#pragma unroll
          for (int j = 0; j < 4; ++j) *(u32x4*)(dst + (size_t)(rt * 64 + pr) * K + kt * 256 + (kc + 8 * j) * 8) = *(const u32x4*)(tile + pr * 264 + (kc + 8 * j) * 8); }
        __syncthreads();
    }
    const int gt = blockIdx.x * 512 + tid, gs = gridDim.x * 512;
    bf16_t* sc = (bf16_t*)(p.ws + WS_SC);
    for (int i = gt; i < 256 * DM; i += gs) { const int r = i >> 10, k = i & 1023; float v = 0.f; if (r < 128) v = silu_f(p.c_sample[r * DM + k]); else if (r < 136) v = silu_f(p.c_prompt[(r - 128) * DM + k]); sc[i] = f2bf(v); }
    float* st = (float*)(p.ws + WS_STAT1);
    for (int i = gt; i < TPAD * 4; i += gs) st[i] = 0.f;
    float* ra = (float*)(p.ws + WS_ROPEA); float* rr = (float*)(p.ws + WS_ROPER);
    for (int i = gt; i < 4097 * 72; i += gs) {
        const int pos = i / 72, f = i % 72;
        const double pv = pos < 4096 ? (double)pos : (double)PAST;
        const double inv = f < 8 ? exp(-13.122363377404328 * (double)f / 8.0) : exp(-9.210340371976184 * (double)(f - 8) / 64.0);
        const double ang = pv * inv;
        const double kk = rint(ang * 0.15915494309189535);
        const float red = (float)(ang - kk * 6.283185307179586);
        const float cs = cosf(red), sn = sinf(red);
        if (f < 8) { ra[pos * 16 + f] = cs; ra[pos * 16 + 8 + f] = sn; } else { rr[pos * 128 + (f - 8)] = cs; rr[pos * 128 + 64 + (f - 8)] = sn; }
    }
}

__device__ void phase_modulate(const Params& p) {
    const float* mod = (const float*)(p.ws + WS_MOD); bf16_t* H = (bf16_t*)(p.ws + WS_H);
    const int gt = blockIdx.x * 512 + threadIdx.x, gs = gridDim.x * 512;
    for (int i = gt; i < TV * 128; i += gs) {
        const int r = i >> 7, c = (i & 127) * 8;
        const float* xr = r < TP ? p.x_prompt + (size_t)r * DM : p.x_sample + (size_t)(r - TP) * DM;
        const int mrow = r < TP ? 128 + (r >> 12) : r - TP;
        const float* sh = mod + (size_t)mrow * 6144; const float* scl = sh + 1024;
        const f32x4 x0 = *(const f32x4*)(xr + c), x1 = *(const f32x4*)(xr + c + 4);
        const f32x4 h0 = x0 * (1.f + *(const f32x4*)(scl + c)) + *(const f32x4*)(sh + c), h1 = x1 * (1.f + *(const f32x4*)(scl + c + 4)) + *(const f32x4*)(sh + c + 4);
        u32x4 pk; pk[0] = cvt_pk_bf16(h0[0], h0[1]); pk[1] = cvt_pk_bf16(h0[2], h0[3]); pk[2] = cvt_pk_bf16(h1[0], h1[1]); pk[3] = cvt_pk_bf16(h1[2], h1[3]);
        *(u32x4*)(H + (size_t)r * DM + c) = pk;
    }
}

__device__ void attn_item(const Params& p, unsigned char* shm, int item) {
    const int tid = threadIdx.x, wid = tid >> 6, lane = tid & 63, lr = lane & 15, g = lane >> 4;
    const int b = item >> 6, kvh = (item >> 5) & 1, n = item & 31;
    const bf16_t* Z = (const bf16_t*)(p.ws + WS_Z); bf16_t* MIX = (bf16_t*)(p.ws + WS_MIX);
    bf16_t* Ks = (bf16_t*)shm;
    bf16_t* VT = Ks + 256 * 72;
    {
        const int key = tid >> 1, hf = tid & 1;
        const bool valid = (n > 0) || (key >= 128);
        const size_t row = (size_t)b * SEQ + (size_t)(n - 1) * 128 + key;
        const bf16_t* kp = Z + row * INW + 512 + kvh * 64 + hf * 32; const bf16_t* vp = Z + row * INW + 640 + kvh * 64 + hf * 32;
#pragma unroll
        for (int c = 0; c < 4; ++c) {
            u32x4 kv = (u32x4){0u, 0u, 0u, 0u}, vv = (u32x4){0u, 0u, 0u, 0u};
            if (valid) { kv = *(const u32x4*)(kp + c * 8); vv = *(const u32x4*)(vp + c * 8); }
            *(u32x4*)(Ks + key * 72 + hf * 32 + c * 8) = kv;
#pragma unroll
            for (int e = 0; e < 4; ++e) { const int d = hf * 32 + c * 8 + 2 * e; VT[d * 264 + key] = (bf16_t)(vv[e] & 0xffffu); VT[(d + 1) * 264 + key] = (bf16_t)(vv[e] >> 16); }
        }
    }
    __syncthreads();
    for (int qt = 0; qt < 4; ++qt) {
        const int T = wid * 4 + qt, hq = T >> 3, tq = T & 7, t0 = tq * 16, head = kvh * 4 + hq;
        const size_t qrow = (size_t)b * SEQ + (size_t)n * 128 + t0 + lr;
        bf16x8 Qf[2];
#pragma unroll
        for (int kk = 0; kk < 2; ++kk) Qf[kk] = *(const bf16x8*)(Z + qrow * INW + head * 64 + kk * 32 + g * 8);
        const int kt0 = tq < 6 ? tq : 6;
        f32x4 S[10];
#pragma unroll
        for (int jt = 0; jt < 10; ++jt) {
            S[jt] = (f32x4){0.f, 0.f, 0.f, 0.f};
#pragma unroll
            for (int kk = 0; kk < 2; ++kk) {
                const bf16x8 Kf = *(const bf16x8*)(Ks + (16 * (kt0 + jt) + lr) * 72 + kk * 32 + g * 8);
                S[jt] = __builtin_amdgcn_mfma_f32_16x16x32_bf16(Kf, Qf[kk], S[jt], 0, 0, 0);
            }
        }
        const float sink = p.att_sinks[head];
        const int t = t0 + lr;
        float mx = sink;
#pragma unroll
        for (int jt = 0; jt < 10; ++jt)
#pragma unroll
            for (int r = 0; r < 4; ++r) {
                const int i = 16 * (kt0 + jt) + 4 * g + r, dist = 128 + t - i;
                const bool ok = dist >= 0 && dist <= 128 && (n > 0 || i >= 128);
                const float s = ok ? S[jt][r] * 0.125f : -INFINITY;
                S[jt][r] = s; mx = fmaxf(mx, s);
            }
        mx = fmaxf(mx, __shfl_xor(mx, 16)); mx = fmaxf(mx, __shfl_xor(mx, 32));
        float sum = 0.f;
#pragma unroll
        for (int jt = 0; jt < 10; ++jt)
#pragma unroll
            for (int r = 0; r < 4; ++r) { const float e = __expf(S[jt][r] - mx); S[jt][r] = e; sum += e; }
        sum += __shfl_xor(sum, 16); sum += __shfl_xor(sum, 32);
        const float inv = 1.f / (sum + __expf(sink - mx));
        f32x4 O[4];
#pragma unroll
        for (int dt = 0; dt < 4; ++dt) O[dt] = (f32x4){0.f, 0.f, 0.f, 0.f};
#pragma unroll
        for (int jp = 0; jp < 5; ++jp) {
            u32x4 pu; pu[0] = cvt_pk_bf16(S[2 * jp][0] * inv, S[2 * jp][1] * inv); pu[1] = cvt_pk_bf16(S[2 * jp][2] * inv, S[2 * jp][3] * inv);
            pu[2] = cvt_pk_bf16(S[2 * jp + 1][0] * inv, S[2 * jp + 1][1] * inv); pu[3] = cvt_pk_bf16(S[2 * jp + 1][2] * inv, S[2 * jp + 1][3] * inv);
            const bf16x8 Pf = __builtin_bit_cast(bf16x8, pu);
#pragma unroll
            for (int dt = 0; dt < 4; ++dt) {
                const bf16_t* vr = VT + (16 * dt + lr) * 264 + 16 * (kt0 + 2 * jp) + 4 * g;
                const u32x2 a0 = *(const u32x2*)vr, a1 = *(const u32x2*)(vr + 16);
                u32x4 au; au[0] = a0[0]; au[1] = a0[1]; au[2] = a1[0]; au[3] = a1[1];
                O[dt] = __builtin_amdgcn_mfma_f32_16x16x32_bf16(__builtin_bit_cast(bf16x8, au), Pf, O[dt], 0, 0, 0);
            }
        }
#pragma unroll
        for (int dt = 0; dt < 4; ++dt) {
            u32x2 o; o[0] = cvt_pk_bf16(O[dt][0], O[dt][1]); o[1] = cvt_pk_bf16(O[dt][2], O[dt][3]);
            *(u32x2*)(MIX + qrow * DM + head * 64 + 16 * dt + 4 * g) = o;
        }
    }
    __syncthreads();
}

__device__ void retu_item(const Params& p, unsigned char* shm, int item) {
    const int tid = threadIdx.x, wid = tid >> 6, lane = tid & 63, lr = lane & 15, g = lane >> 4;
    const int b = item >> 7, h = (item >> 5) & 3, c = item & 31;
    const bf16_t* Z = (const bf16_t*)(p.ws + WS_Z); float* UT = (float*)(p.ws + WS_H);
    bf16_t* KT = (bf16_t*)shm;
    bf16_t* VT = KT + 128 * 136;
    const float lg = log_gamma(h);
    {
        const int j = tid >> 2, q = tid & 3;
        const size_t row = (size_t)b * SEQ + (size_t)c * 128 + j;
        const float dec = __expf(lg * (float)(127 - j));
        const bf16_t* kp = Z + row * INW + 1280 + h * 128 + q * 32; const bf16_t* vp = Z + row * INW + 1792 + h * 128 + q * 32;
#pragma unroll
        for (int cc = 0; cc < 4; ++cc) {
            const u32x4 kv = *(const u32x4*)(kp + cc * 8), vv = *(const u32x4*)(vp + cc * 8);
#pragma unroll
            for (int e = 0; e < 4; ++e) {
                const int d = q * 32 + cc * 8 + 2 * e;
                KT[d * 136 + j] = f2bf(bflo(kv[e]) * dec); KT[(d + 1) * 136 + j] = f2bf(bfhi(kv[e]) * dec);
                VT[d * 136 + j] = (bf16_t)(vv[e] & 0xffffu); VT[(d + 1) * 136 + j] = (bf16_t)(vv[e] >> 16);
            }
        }
    }
    __syncthreads();
    f32x4 acc[8];
#pragma unroll
    for (int dt = 0; dt < 8; ++dt) acc[dt] = (f32x4){0.f, 0.f, 0.f, 0.f};
#pragma unroll
    for (int kk = 0; kk < 4; ++kk) {
        const bf16x8 Bf = *(const bf16x8*)(VT + (16 * wid + lr) * 136 + kk * 32 + g * 8);
#pragma unroll
        for (int dt = 0; dt < 8; ++dt) {
            const bf16x8 Af = *(const bf16x8*)(KT + (16 * dt + lr) * 136 + kk * 32 + g * 8);
            acc[dt] = __builtin_amdgcn_mfma_f32_16x16x32_bf16(Af, Bf, acc[dt], 0, 0, 0);
        }
    }
    float* up = UT + (size_t)item * 16384 + (size_t)(16 * wid + lr) * 128;
#pragma unroll
    for (int dt = 0; dt < 8; ++dt) *(f32x4*)(up + 16 * dt + 4 * g) = acc[dt];
    __syncthreads();
}

__device__ void phase_scan(const Params& p) {
    const float* UT = (const float*)(p.ws + WS_H); bf16_t* SST = (bf16_t*)(p.ws + WS_SST);
    const int gt = blockIdx.x * 512 + threadIdx.x, gs = gridDim.x * 512;
    for (int i = gt; i < 32 * 16384; i += gs) {
        const int bh = i >> 14, ed = i & 16383, e = ed >> 7, d = ed & 127, h = bh & 3;
        const float gL = __expf(log_gamma(h) * 128.f);
        float s = 0.f;
        const float* up = UT + (size_t)bh * 32 * 16384 + ed; bf16_t* sp = SST + (size_t)bh * 32 * 16384 + ed;
#pragma unroll 8
        for (int c = 0; c < 32; ++c) { const float uv = up[(size_t)c * 16384]; sp[(size_t)c * 16384] = f2bf(s); s = gL * s + uv; }
        p.out[O_RP + ((size_t)bh * 128 + ret_dim(d)) * 128 + e] = s;
    }
}

__device__ void reto_item(const Params& p, unsigned char* shm, int item) {
    const int tid = threadIdx.x, wid = tid >> 6, lane = tid & 63, lr = lane & 15, g = lane >> 4;
    const int b = item >> 7, h = (item >> 5) & 3, c = item & 31;
    const bf16_t* Z = (const bf16_t*)(p.ws + WS_Z); const bf16_t* SST = (const bf16_t*)(p.ws + WS_SST); bf16_t* MIX = (bf16_t*)(p.ws + WS_MIX);
    bf16_t* Ks = (bf16_t*)shm;
    bf16_t* VT = Ks + 128 * 136;
    bf16_t* Ss = VT + 128 * 136;
    const float lg = log_gamma(h);
    const size_t row0 = (size_t)b * SEQ + (size_t)c * 128;
    {
        const int j = tid >> 2, q = tid & 3;
        const bf16_t* kp = Z + (row0 + j) * INW + 1280 + h * 128 + q * 32; const bf16_t* vp = Z + (row0 + j) * INW + 1792 + h * 128 + q * 32;
        const bf16_t* sp = SST + (size_t)item * 16384 + j * 128 + q * 32;
#pragma unroll
        for (int cc = 0; cc < 4; ++cc) {
            const u32x4 kv = *(const u32x4*)(kp + cc * 8), vv = *(const u32x4*)(vp + cc * 8), sv = *(const u32x4*)(sp + cc * 8);
            *(u32x4*)(Ks + j * 136 + q * 32 + cc * 8) = kv;
            *(u32x4*)(Ss + j * 136 + q * 32 + cc * 8) = sv;
#pragma unroll
            for (int e = 0; e < 4; ++e) { const int d = q * 32 + cc * 8 + 2 * e; VT[d * 136 + j] = (bf16_t)(vv[e] & 0xffffu); VT[(d + 1) * 136 + j] = (bf16_t)(vv[e] >> 16); }
        }
    }
    __syncthreads();
    const size_t qrow = row0 + 16 * wid + lr;
    bf16x8 Qf[4];
#pragma unroll
    for (int kk = 0; kk < 4; ++kk) Qf[kk] = *(const bf16x8*)(Z + qrow * INW + 768 + h * 128 + kk * 32 + g * 8);
    f32x4 S[8];
#pragma unroll
    for (int jt = 0; jt < 8; ++jt) {
        S[jt] = (f32x4){0.f, 0.f, 0.f, 0.f};
        if (jt <= wid) {
#pragma unroll
            for (int kk = 0; kk < 4; ++kk) {
                const bf16x8 Kf = *(const bf16x8*)(Ks + (16 * jt + lr) * 136 + kk * 32 + g * 8);
                S[jt] = __builtin_amdgcn_mfma_f32_16x16x32_bf16(Kf, Qf[kk], S[jt], 0, 0, 0);
            }
        }
    }
    const int it = 16 * wid + lr;
#pragma unroll
    for (int jt = 0; jt < 8; ++jt)
#pragma unroll
        for (int r = 0; r < 4; ++r) { const int j = 16 * jt + 4 * g + r; S[jt][r] = (j <= it) ? S[jt][r] * __expf(lg * (float)(it - j)) : 0.f; }
    f32x4 O1[8], O2[8];
#pragma unroll
    for (int et = 0; et < 8; ++et) { O1[et] = (f32x4){0.f, 0.f, 0.f, 0.f}; O2[et] = (f32x4){0.f, 0.f, 0.f, 0.f}; }
#pragma unroll
    for (int jp = 0; jp < 4; ++jp) {
        if (2 * jp <= wid) {
            u32x4 pu; pu[0] = cvt_pk_bf16(S[2 * jp][0], S[2 * jp][1]); pu[1] = cvt_pk_bf16(S[2 * jp][2], S[2 * jp][3]);
            pu[2] = cvt_pk_bf16(S[2 * jp + 1][0], S[2 * jp + 1][1]); pu[3] = cvt_pk_bf16(S[2 * jp + 1][2], S[2 * jp + 1][3]);
            const bf16x8 Pf = __builtin_bit_cast(bf16x8, pu);
#pragma unroll
            for (int et = 0; et < 8; ++et) {
                const bf16_t* vr = VT + (16 * et + lr) * 136 + 32 * jp + 4 * g;
                const u32x2 a0 = *(const u32x2*)vr, a1 = *(const u32x2*)(vr + 16);
                u32x4 au; au[0] = a0[0]; au[1] = a0[1]; au[2] = a1[0]; au[3] = a1[1];
                O1[et] = __builtin_amdgcn_mfma_f32_16x16x32_bf16(__builtin_bit_cast(bf16x8, au), Pf, O1[et], 0, 0, 0);
            }
        }
    }
#pragma unroll
    for (int kk = 0; kk < 4; ++kk)
#pragma unroll
        for (int et = 0; et < 8; ++et) {
            const bf16x8 Sf = *(const bf16x8*)(Ss + (16 * et + lr) * 136 + kk * 32 + g * 8);
            O2[et] = __builtin_amdgcn_mfma_f32_16x16x32_bf16(Sf, Qf[kk], O2[et], 0, 0, 0);
        }
    const float qd = __expf(lg * (float)(it + 1));
    float sum = 0.f;
#pragma unroll
    for (int et = 0; et < 8; ++et)
#pragma unroll
        for (int r = 0; r < 4; ++r) { const float o = O1[et][r] + qd * O2[et][r]; O1[et][r] = o; sum += o; }
    sum += __shfl_xor(sum, 16); sum += __shfl_xor(sum, 32);
    const float mu = sum * (1.f / 128.f);
    float vs = 0.f;
#pragma unroll
    for (int et = 0; et < 8; ++et)
#pragma unroll
        for (int r = 0; r < 4; ++r) { const float dlt = O1[et][r] - mu; vs += dlt * dlt; }
    vs += __shfl_xor(vs, 16); vs += __shfl_xor(vs, 32);
    const float rstd = rsqrtf(vs * (1.f / 128.f) + 1e-6f);
#pragma unroll
    for (int et = 0; et < 8; ++et) {
        const int e = 16 * et + 4 * g;
        const u32x2 gz = *(const u32x2*)(Z + qrow * INW + 2304 + h * 128 + e);
        const f32x4 gw = *(const f32x4*)(p.ret_gn_w + h * 128 + e);
        const float r0 = (O1[et][0] - mu) * rstd * gw[0] * silu_f(bflo(gz[0])), r1 = (O1[et][1] - mu) * rstd * gw[1] * silu_f(bfhi(gz[0]));
        const float r2 = (O1[et][2] - mu) * rstd * gw[2] * silu_f(bflo(gz[1])), r3 = (O1[et][3] - mu) * rstd * gw[3] * silu_f(bfhi(gz[1]));
        u32x2 o; o[0] = cvt_pk_bf16(r0, r1); o[1] = cvt_pk_bf16(r2, r3);
        *(u32x2*)(MIX + qrow * DM + 512 + h * 128 + e) = o;
    }
    __syncthreads();
}

__device__ void sample_att(const Params& p, unsigned char* shm, int b) {
    const int tid = threadIdx.x, wid = tid >> 6, lane = tid & 63;
    const bf16_t* zrow = (const bf16_t*)(p.ws + WS_Z) + (size_t)(TP + b) * INW; bf16_t* mixrow = (bf16_t*)(p.ws + WS_MIX) + (size_t)(TP + b) * DM;
    float* sm = (float*)shm;
    float* qn = sm;
    float* kn = qn + 512;
    float* vn = kn + 128;
    float* scs = vn + 128;
    { const int hh = tid >> 6, pp = tid & 63; qn[hh * 64 + att_dim(pp)] = bf2f(zrow[tid]); }
    if (tid < 128) { const int hh = tid >> 6, pp = tid & 63; kn[hh * 64 + att_dim(pp)] = bf2f(zrow[512 + tid]); vn[tid] = bf2f(zrow[640 + tid]); }
    __syncthreads();
    const float* ck = p.cache_k + (size_t)b * 128 * 128; const float* cv = p.cache_v + (size_t)b * 128 * 128;
#pragma unroll
    for (int itr = 0; itr < 2; ++itr) {
        const int idx = tid + 512 * itr, hd = idx >> 7, w = idx & 127, kvh = hd >> 2;
        const float* kr = ck + (w * 2 + kvh) * 64; const float* qr = qn + hd * 64;
        float s = 0.f;
#pragma unroll
        for (int d = 0; d < 64; d += 4) { const f32x4 kv = *(const f32x4*)(kr + d); s += qr[d] * kv[0] + qr[d + 1] * kv[1] + qr[d + 2] * kv[2] + qr[d + 3] * kv[3]; }
        scs[hd * 132 + w] = s * 0.125f;
    }
    if (tid < 8) { const int kvh = tid >> 2; float s = 0.f; for (int d = 0; d < 64; ++d) s += qn[tid * 64 + d] * kn[kvh * 64 + d]; scs[tid * 132 + 128] = s * 0.125f; }
    __syncthreads();
    {
        const float sink = p.att_sinks[wid];
        const float s0 = scs[wid * 132 + lane], s1 = scs[wid * 132 + 64 + lane], s2 = lane == 0 ? scs[wid * 132 + 128] : -INFINITY;
        float mx = fmaxf(fmaxf(s0, s1), fmaxf(s2, sink));
#pragma unroll
        for (int o = 32; o >= 1; o >>= 1) mx = fmaxf(mx, __shfl_xor(mx, o));
        const float e0 = __expf(s0 - mx), e1 = __expf(s1 - mx), e2 = lane == 0 ? __expf(s2 - mx) : 0.f;
        float sum = e0 + e1 + e2;
#pragma unroll
        for (int o = 32; o >= 1; o >>= 1) sum += __shfl_xor(sum, o);
        const float inv = 1.f / (sum + __expf(sink - mx));
        scs[wid * 132 + lane] = e0 * inv; scs[wid * 132 + 64 + lane] = e1 * inv; if (lane == 0) scs[wid * 132 + 128] = e2 * inv;
    }
    __syncthreads();
    {
        const int hd = tid >> 6, d = tid & 63, kvh = hd >> 2;
        float o = scs[hd * 132 + 128] * vn[kvh * 64 + d];
#pragma unroll 16
        for (int w = 0; w < 128; ++w) o += scs[hd * 132 + w] * cv[(w * 2 + kvh) * 64 + d];
        mixrow[hd * 64 + d] = f2bf(o);
    }
    for (int i = tid; i < 127 * 32; i += 512) {
        *(f32x4*)(p.out + O_KS + (size_t)b * 16384 + i * 4) = *(const f32x4*)(ck + 128 + i * 4);
        *(f32x4*)(p.out + O_VS + (size_t)b * 16384 + i * 4) = *(const f32x4*)(cv + 128 + i * 4);
    }
    __syncthreads();
}
__device__ void sample_ret(const Params& p, unsigned char* shm, int item) {
    const int tid = threadIdx.x, b = item >> 2, h = item & 3;
    const bf16_t* zrow = (const bf16_t*)(p.ws + WS_Z) + (size_t)(TP + b) * INW; bf16_t* mixrow = (bf16_t*)(p.ws + WS_MIX) + (size_t)(TP + b) * DM;
    float* sm = (float*)shm;
    float* rqn = sm;
    float* rkn = rqn + 128;
    float* red = rkn + 128;
    float* qkp = red + 512;
    float* ov = qkp + 4;
    if (tid < 128) { const int dn = ret_dim(tid); rqn[dn] = bf2f(zrow[768 + h * 128 + tid]); rkn[dn] = bf2f(zrow[1280 + h * 128 + tid]); }
    __syncthreads();
    const float gm = __expf(log_gamma(h));
    const int e = tid & 127, dq = tid >> 7;
    const float* sp = p.state_ret + ((size_t)(b * 4 + h) * 128 + dq * 32) * 128 + e;
    float* so = p.out + O_RS + ((size_t)(b * 4 + h) * 128 + dq * 32) * 128 + e;
    const float ve = bf2f(zrow[1792 + h * 128 + e]);
    float sv[32];
#pragma unroll
    for (int d = 0; d < 32; ++d) sv[d] = sp[d * 128];
    float part = 0.f, qk = 0.f;
#pragma unroll
    for (int d = 0; d < 32; ++d) { const float qd = rqn[dq * 32 + d], kd = rkn[dq * 32 + d]; part += qd * sv[d]; qk += qd * kd; so[d * 128] = gm * sv[d] + kd * ve; }
    red[dq * 128 + e] = part; if (e == 0) qkp[dq] = qk;
    __syncthreads();
    if (tid < 128) ov[tid] = (qkp[0] + qkp[1] + qkp[2] + qkp[3]) * ve + gm * (red[e] + red[128 + e] + red[256 + e] + red[384 + e]);
    __syncthreads();
    if (tid < 64) {
        const float o0 = ov[tid], o1 = ov[tid + 64];
        float sum = o0 + o1;
#pragma unroll
        for (int o = 32; o >= 1; o >>= 1) sum += __shfl_xor(sum, o);
        const float mu = sum * (1.f / 128.f);
        float vs = (o0 - mu) * (o0 - mu) + (o1 - mu) * (o1 - mu);
#pragma unroll
        for (int o = 32; o >= 1; o >>= 1) vs += __shfl_xor(vs, o);
        const float rstd = rsqrtf(vs * (1.f / 128.f) + 1e-6f);
#pragma unroll
        for (int k = 0; k < 2; ++k) { const int ee = tid + 64 * k; const float gz = bf2f(zrow[2304 + h * 128 + ee]);
            mixrow[512 + h * 128 + ee] = f2bf(((k ? o1 : o0) - mu) * rstd * p.ret_gn_w[h * 128 + ee] * silu_f(gz)); }
    }
    __syncthreads();
}

template <int NB>
__device__ __forceinline__ void sg_mma(const bf16_t* arow, const bf16_t* b0, const bf16_t* b1, int K, f32x4& acc0, f32x4& acc1) {
#pragma unroll 8
    for (int k = 0; k < K; k += 32) {
        const bf16x8 a = *(const bf16x8*)(arow + k);
        const bf16x8 w0 = *(const bf16x8*)(b0 + k);
        acc0 = __builtin_amdgcn_mfma_f32_16x16x32_bf16(w0, a, acc0, 0, 0, 0);
        if (NB == 2) { const bf16x8 w1 = *(const bf16x8*)(b1 + k); acc1 = __builtin_amdgcn_mfma_f32_16x16x32_bf16(w1, a, acc1, 0, 0, 0); }
    }
}
__device__ void sg_res(const Params& p, int item, const bf16_t* A, const bf16_t* Bt, int K, const float* base, int gate_off, float* stat) {
    const int tid = threadIdx.x, wid = tid >> 6, lane = tid & 63, lr = lane & 15, g = lane >> 4;
    const int n0 = item * 16, m = 16 * wid + lr;
    f32x4 acc = (f32x4){0.f, 0.f, 0.f, 0.f}, dummy = acc;
    sg_mma<1>(A + (size_t)(TP + m) * K + 8 * g, Bt + (size_t)(n0 + lr) * K + 8 * g, nullptr, K, acc, dummy);
    const int c = n0 + 4 * g;
    const float* gate = (const float*)(p.ws + WS_MOD) + (size_t)m * 6144 + gate_off;
    const f32x4 xv = *(const f32x4*)(base + (size_t)m * DM + c), gv = *(const f32x4*)(gate + c);
    const f32x4 res = ALPHA * xv + (1.f + gv) * acc;
    *(f32x4*)(p.out + O_YS + (size_t)m * DM + c) = res;
    float s = res[0] + res[1] + res[2] + res[3], ss = res[0] * res[0] + res[1] * res[1] + res[2] * res[2] + res[3] * res[3];
    s += __shfl_xor(s, 16); ss += __shfl_xor(ss, 16); s += __shfl_xor(s, 32); ss += __shfl_xor(ss, 32);
    if (g == 0) { atomicAdd(stat + 2 * (TP + m), s); atomicAdd(stat + 2 * (TP + m) + 1, ss); }
}
__device__ void sg_up(const Params& p, int item) {
    const int tid = threadIdx.x, wid = tid >> 6, lane = tid & 63, lr = lane & 15, g = lane >> 4;
    const int n0 = item * 16, m = 16 * wid + lr, pn = n0 >> 7, off = n0 & 127;
    const bf16_t* A = (const bf16_t*)(p.ws + WS_H); const bf16_t* Bt = (const bf16_t*)(p.ws + WS_WUP);
    f32x4 ag = (f32x4){0.f, 0.f, 0.f, 0.f}, au = ag;
    sg_mma<2>(A + (size_t)(TP + m) * DM + 8 * g, Bt + (size_t)(256 * pn + off + lr) * DM + 8 * g, Bt + (size_t)(256 * pn + 128 + off + lr) * DM + 8 * g, DM, ag, au);
    u32x2 o; o[0] = cvt_pk_bf16(silu_f(ag[0]) * au[0], silu_f(ag[1]) * au[1]); o[1] = cvt_pk_bf16(silu_f(ag[2]) * au[2], silu_f(ag[3]) * au[3]);
    *(u32x2*)((bf16_t*)(p.ws + WS_Z) + (size_t)(TP + m) * DFF + n0 + 4 * g) = o;
}

__device__ void phase_ln1(const Params& p) {
    const float* mod = (const float*)(p.ws + WS_MOD); const float* stat = (const float*)(p.ws + WS_STAT1); bf16_t* H = (bf16_t*)(p.ws + WS_H);
    const int gt = blockIdx.x * 512 + threadIdx.x, gs = gridDim.x * 512;
    for (int i = gt; i < TV * 128; i += gs) {
        const int r = i >> 7, c = (i & 127) * 8;
        float* yr = p.out + (size_t)r * DM + c;
        const float mu = stat[2 * r] * (1.f / 1024.f), var = stat[2 * r + 1] * (1.f / 1024.f) - mu * mu, rstd = rsqrtf(fmaxf(var, 0.f) + 1e-5f);
        const int mrow = r < TP ? 128 + (r >> 12) : r - TP;
        const float* sh = mod + (size_t)mrow * 6144 + 3072 + c; const float* scl = sh + 1024;
        f32x4 y0 = *(const f32x4*)yr, y1 = *(const f32x4*)(yr + 4);
        y0 = (y0 - mu) * rstd * *(const f32x4*)(p.ln1_w + c) + *(const f32x4*)(p.ln1_b + c);
        y1 = (y1 - mu) * rstd * *(const f32x4*)(p.ln1_w + c + 4) + *(const f32x4*)(p.ln1_b + c + 4);
        *(f32x4*)yr = y0; *(f32x4*)(yr + 4) = y1;
        const f32x4 h0 = y0 * (1.f + *(const f32x4*)scl) + *(const f32x4*)sh, h1 = y1 * (1.f + *(const f32x4*)(scl + 4)) + *(const f32x4*)(sh + 4);
        u32x4 pk; pk[0] = cvt_pk_bf16(h0[0], h0[1]); pk[1] = cvt_pk_bf16(h0[2], h0[3]); pk[2] = cvt_pk_bf16(h1[0], h1[1]); pk[3] = cvt_pk_bf16(h1[2], h1[3]);
        *(u32x4*)(H + (size_t)r * DM + c) = pk;
    }
}
__device__ void phase_ln2(const Params& p) {
    const float* stat = (const float*)(p.ws + WS_STAT2);
    const int gt = blockIdx.x * 512 + threadIdx.x, gs = gridDim.x * 512;
    for (int i = gt; i < TV * 128; i += gs) {
        const int r = i >> 7, c = (i & 127) * 8;
        float* yr = p.out + (size_t)r * DM + c;
        const float mu = stat[2 * r] * (1.f / 1024.f), var = stat[2 * r + 1] * (1.f / 1024.f) - mu * mu, rstd = rsqrtf(fmaxf(var, 0.f) + 1e-5f);
        f32x4 y0 = *(const f32x4*)yr, y1 = *(const f32x4*)(yr + 4);
        y0 = (y0 - mu) * rstd * *(const f32x4*)(p.ln2_w + c) + *(const f32x4*)(p.ln2_b + c);
        y1 = (y1 - mu) * rstd * *(const f32x4*)(p.ln2_w + c + 4) + *(const f32x4*)(p.ln2_b + c + 4);
        *(f32x4*)yr = y0; *(f32x4*)(yr + 4) = y1;
    }
}

#define XB_TMO      128
#define XB_XCNT(j)  (256  + 64 * (j))
#define XB_XSUB(j)  (1280 + 64 * (j))
#define XB_XGEN(j)  (2304 + 64 * (j))
#define XB_TOP      3328
#define XB_TOPGEN   3392
#define XCD_BAR_WORDS 3456
#define XB_SPIN_CAP (1u << 18)
__device__ __forceinline__ unsigned xb_ld(unsigned* p)              { return __hip_atomic_load(p, __ATOMIC_RELAXED, __HIP_MEMORY_SCOPE_AGENT); }
__device__ __forceinline__ unsigned xb_add(unsigned* p, unsigned v) { return __hip_atomic_fetch_add(p, v, __ATOMIC_RELAXED, __HIP_MEMORY_SCOPE_AGENT); }
__device__ __forceinline__ unsigned xb_xcc_id() { return (unsigned)__builtin_amdgcn_s_getreg((3 << 11) | 20) & 0xFu; }
#define XB_SPIN(cond, bar) do { unsigned _sp = 0; while (cond) { __builtin_amdgcn_s_sleep(1); \
    if ((++_sp & 255u) == 0u) { if (xb_ld(&(bar)[XB_TMO])) break; if (_sp > XB_SPIN_CAP) { atomicAdd(&(bar)[XB_TMO], 1u); break; } } } } while (0)
struct XcdBarrier { unsigned* bar; unsigned x; volatile LAS unsigned* st; };
__device__ __forceinline__ XcdBarrier xcd_barrier_post(unsigned* bar, volatile LAS unsigned* st) {
    XcdBarrier b; b.bar = bar; b.x = xb_xcc_id(); b.st = st;
    if (threadIdx.x == 0) (void)xb_add(&bar[XB_XCNT(b.x)], 1u);
    return b;
}
__device__ __forceinline__ void xcd_barrier_complete(unsigned* bar, unsigned x, unsigned& nloc, unsigned& nx) {
    const unsigned G = gridDim.x * gridDim.y * gridDim.z;
    unsigned sum, cnt, mine, sp = 0u;
    for (;;) {
        sum = 0u; cnt = 0u; mine = 0u;
#pragma unroll
        for (unsigned j = 0; j < 16; ++j) { const unsigned c = xb_ld(&bar[XB_XCNT(j)]); sum += c; cnt += (c > 0u) ? 1u : 0u; mine = (j == x) ? c : mine; }
        if (sum == G) break;
        __builtin_amdgcn_s_sleep(1);
        if ((++sp & 255u) == 0u) { if (xb_ld(&bar[XB_TMO])) break; if (sp > XB_SPIN_CAP) { atomicAdd(&bar[XB_TMO], 1u); break; } }
    }
    nloc = mine > 0u ? mine : 1u; nx = cnt > 0u ? cnt : 1u;
}
__device__ __forceinline__ void xcd_barrier(const XcdBarrier& b) {
    asm volatile("s_waitcnt vmcnt(0)" ::: "memory");
    __syncthreads();
    if (threadIdx.x == 0) {
        unsigned* bar = b.bar;
        __builtin_amdgcn_s_waitcnt(0);
        unsigned nloc = b.st[0], nx = b.st[1];
        if (nloc == 0u) { xcd_barrier_complete(bar, b.x, nloc, nx); b.st[0] = nloc; b.st[1] = nx; }
        const unsigned old = xb_add(&bar[XB_XSUB(b.x)], 1u);
        const unsigned gen = old / nloc;
        if (old + 1u == (gen + 1u) * nloc) {
            __builtin_amdgcn_fence(__ATOMIC_RELEASE, "agent");
            asm volatile("s_waitcnt vmcnt(0)" ::: "memory");
            const unsigned og = xb_add(&bar[XB_TOP], 1u);
            const unsigned tg = og / nx;
            if (og + 1u == (tg + 1u) * nx) xb_add(&bar[XB_TOPGEN], 1u);
            else XB_SPIN(xb_ld(&bar[XB_TOPGEN]) == tg, bar);
            __builtin_amdgcn_fence(__ATOMIC_ACQUIRE, "agent");
            xb_add(&bar[XB_XGEN(b.x)], 1u);
            asm volatile("s_waitcnt vmcnt(0)" ::: "memory");
        } else {
            XB_SPIN(xb_ld(&bar[XB_XGEN(b.x)]) == gen, bar);
            __builtin_amdgcn_fence(__ATOMIC_ACQUIRE, "agent");
            asm volatile("s_waitcnt vmcnt(0)" ::: "memory");
        }
    }
    __syncthreads();
}

typedef __attribute__((address_space(4))) const unsigned char* kptr_t;
__device__ __forceinline__ Params load_params() {
#if defined(__HIP_DEVICE_COMPILE__)
    kptr_t k = (kptr_t)__builtin_amdgcn_kernarg_segment_ptr();
    asm volatile("" : "+s"(k));
    Params r;
    __builtin_memcpy(&r, (const __attribute__((address_space(4))) void*)k, sizeof(Params));
    return r;
#else
    return Params{};
#endif
}
__global__ void __launch_bounds__(512, 2) fwd(Params p_arg, int ph_lo, int ph_hi, int coop) {
    extern __shared__ __attribute__((aligned(16))) unsigned char shm[];
    cg::grid_group grid = cg::this_grid();
    LAS unsigned char* lds = (LAS unsigned char*)shm;
    const int G = gridDim.x, bid = blockIdx.x;
    volatile LAS unsigned* bst = (volatile LAS unsigned*)(lds + 131072);
    if (threadIdx.x < 4) bst[threadIdx.x] = 0u;
    __syncthreads();
    (void)xcd_barrier_post((unsigned*)(p_arg.ws + WS_BAR), bst);
    if (coop > 1) grid.sync();
#define GSYNC() do { XcdBarrier xb_; xb_.bar = (unsigned*)(load_params().ws + WS_BAR); xb_.x = xb_xcc_id(); xb_.st = (volatile LAS unsigned*)((LAS unsigned char*)shm + 131072); xcd_barrier(xb_); } while (0)
#ifndef ONLY
#define ONLY -1
#endif
#ifndef REP_PH
#define REP_PH -1
#endif
#ifndef REP_SYNC
#define REP_SYNC 0
#endif
#define PH_BEGIN(n) if ((ONLY < 0 || ONLY == n) && ph_lo <= n && n < ph_hi) { if (n > ph_lo && coop) GSYNC(); for (int rep_ = 0; rep_ < (REP_PH == n ? 2 : 1); ++rep_) { if (rep_) GSYNC(); const Params p = load_params();
#define PH_END } }
    for (int i_ = 0; i_ < REP_SYNC; ++i_) GSYNC();
    PH_BEGIN(0) phase_prep(p, shm); PH_END
    PH_BEGIN(1) { pg8::Gemm g{(const bf16_t*)(p.ws + WS_SC), (const bf16_t*)(p.ws + WS_WADA), 256, 6144, DM}; pg8::StaticOrder S; S.init(g.M, g.N, G, bid);
                  EpiAda E{(float*)(p.ws + WS_MOD), p.b_ada_mix, p.b_ada_ffn}; pg8::gemm_phase(lds, g, S, E); } PH_END
    PH_BEGIN(2) phase_modulate(p); PH_END
    PH_BEGIN(3) { pg8::Gemm g{(const bf16_t*)(p.ws + WS_H), (const bf16_t*)(p.ws + WS_WIN), TPAD, INW, DM}; pg8::StaticOrder S; S.init(g.M, g.N, G, bid);
                  EpiIn E{(bf16_t*)(p.ws + WS_Z), (const float*)(p.ws + WS_ROPEA), (const float*)(p.ws + WS_ROPER), p.out}; pg8::gemm_phase(lds, g, S, E); } PH_END
    PH_BEGIN(4) { for (int it = bid; it < 1024; it += G) retu_item(p, shm, it); for (int it = bid; it < 512; it += G) attn_item(p, shm, it); for (int it = G - 1 - bid; it < 512; it += G) sample_ret(p, shm, it); for (int it = bid; it < 128; it += G) sample_att(p, shm, it); } PH_END
    PH_BEGIN(5) phase_scan(p); PH_END
    PH_BEGIN(6) for (int it = bid; it < 1024; it += G) reto_item(p, shm, it); PH_END
    PH_BEGIN(7) { for (int it = G - 1 - bid; it < 64; it += G) sg_res(p, it, (const bf16_t*)(p.ws + WS_MIX), (const bf16_t*)(p.ws + WS_WOUT), DM, p.x_sample, 2048, (float*)(p.ws + WS_STAT1));
                  pg8::Gemm g{(const bf16_t*)(p.ws + WS_MIX), (const bf16_t*)(p.ws + WS_WOUT), TP, DM, DM}; pg8::StaticOrder S; S.init(g.M, g.N, G, bid);
                  EpiRes E{p.x_prompt, p.x_sample, p.out, (const float*)(p.ws + WS_MOD), 2048, (float*)(p.ws + WS_STAT1)}; pg8::gemm_phase(lds, g, S, E); } PH_END
    PH_BEGIN(8) phase_ln1(p); PH_END
    PH_BEGIN(9) { for (int it = G - 1 - bid; it < 176; it += G) sg_up(p, it);
                  pg8::Gemm g{(const bf16_t*)(p.ws + WS_H), (const bf16_t*)(p.ws + WS_WUP), TP, 2 * DFF, DM}; pg8::StaticOrder S; S.init(g.M, g.N, G, bid);
                  EpiUp E{(bf16_t*)(p.ws + WS_Z)}; pg8::gemm_phase(lds, g, S, E); } PH_END
    PH_BEGIN(10) { for (int it = G - 1 - bid; it < 64; it += G) sg_res(p, it, (const bf16_t*)(p.ws + WS_Z), (const bf16_t*)(p.ws + WS_WDOWN), DFF, p.out + O_YS, 3072 + 2048, (float*)(p.ws + WS_STAT2));
                   pg8::Gemm g{(const bf16_t*)(p.ws + WS_Z), (const bf16_t*)(p.ws + WS_WDOWN), TP, DM, DFF}; pg8::StaticOrder S; S.init(g.M, g.N, G, bid);
                   EpiRes E{p.out + O_YP, p.out + O_YS, p.out, (const float*)(p.ws + WS_MOD), 3072 + 2048, (float*)(p.ws + WS_STAT2)}; pg8::gemm_phase(lds, g, S, E); } PH_END
    PH_BEGIN(11) phase_ln2(p); PH_END
}

extern "C" void kernel_launch(void* const* d_in, const int* in_sizes, int n_in, void* d_out, int out_size, void* d_ws, size_t ws_size, hipStream_t stream) {
    constexpr int LDS_BYTES = 131072 + 64;
    static int grid = 0;
    if (!grid) {
        int dev = 0, cus = 0, per_cu = 0;
        (void)hipGetDevice(&dev);
        (void)hipDeviceGetAttribute(&cus, hipDeviceAttributeMultiprocessorCount, dev);
        (void)hipFuncSetAttribute((const void*)fwd, hipFuncAttributeMaxDynamicSharedMemorySize, LDS_BYTES);
        (void)hipOccupancyMaxActiveBlocksPerMultiprocessor(&per_cu, (const void*)fwd, 512, LDS_BYTES);
        grid = cus > 0 ? cus : 256;
        if (ws_size < WS_END) fprintf(stderr, "kernel_launch: workspace too small: %zu < %zu\n", ws_size, (size_t)WS_END);
        fprintf(stderr, "kernel_launch: cus %d per_cu %d grid %d ws %zu need %zu\n", cus, per_cu, grid, ws_size, (size_t)WS_END);
    }
    Params p{};
    const float** f = (const float**)&p;
    for (int i = 0; i < 21; ++i) f[i] = (const float*)d_in[i];
    p.out = (float*)d_out; p.ws = (unsigned char*)d_ws;
#ifndef MULTI_LAUNCH
    (void)hipMemsetAsync((unsigned char*)d_ws + WS_BAR, 0, 16384, stream);
    int lo = 0, hi = 12, coop = 1;
    void* args[] = {&p, &lo, &hi, &coop};
    hipError_t e = hipLaunchCooperativeKernel((const void*)fwd, dim3(grid), dim3(512), args, LDS_BYTES, stream);
    if (e != hipSuccess) fprintf(stderr, "cooperative launch failed: %s (grid %d)\n", hipGetErrorString(e), grid);
#else
    for (int ph = 0; ph < 12; ++ph) hipLaunchKernelGGL(fwd, dim3(grid), dim3(512), LDS_BYTES, stream, p, ph, ph + 1, 0);
#endif
}
```

```cpp
#include <hip/hip_runtime.h>
#include <hip/hip_cooperative_groups.h>
#include <cstdio>
namespace cg = cooperative_groups;

#define LAS __attribute__((address_space(3)))
typedef unsigned short bf16_t;
typedef short bf16x8 __attribute__((ext_vector_type(8)));
typedef float f32x4 __attribute__((ext_vector_type(4)));
typedef unsigned u32x4 __attribute__((ext_vector_type(4)));
typedef unsigned u32x2 __attribute__((ext_vector_type(2)));

constexpr int DM = 1024, SEQ = 4096, NBATCH = 8, TP = NBATCH * SEQ  , NS = 128, TV = TP + NS  , TPAD = TP + 256  ;
constexpr int INW = 2816, DFF = 2816, PAST = 16384;
constexpr float ALPHA = 1.189207115002721f;
constexpr float RK_SCALE = 0.08838834764831845f;
constexpr size_t O_YP = 0, O_YS = (size_t)TP * DM, O_KP = O_YS + (size_t)NS * DM, O_VP = O_KP + 131072, O_RP = O_VP + 131072,
                 O_KS = O_RP + 524288, O_VS = O_KS + 2097152, O_RS = O_VS + 2097152;
constexpr size_t al256(size_t x) { return (x + 255) & ~(size_t)255; }
constexpr size_t WS_WIN = 0;
constexpr size_t WS_WOUT = WS_WIN + (size_t)INW * DM * 2;
constexpr size_t WS_WUP = WS_WOUT + (size_t)DM * DM * 2;
constexpr size_t WS_WDOWN = WS_WUP + (size_t)2 * DFF * DM * 2;
constexpr size_t WS_WADA = WS_WDOWN + (size_t)DM * DFF * 2;
constexpr size_t WS_SC = WS_WADA + (size_t)6144 * DM * 2;
constexpr size_t WS_MOD = WS_SC + (size_t)256 * DM * 2;
constexpr size_t WS_ROPEA = WS_MOD + (size_t)256 * 6144 * 4;
constexpr size_t WS_ROPER = al256(WS_ROPEA + (size_t)4097 * 16 * 4);
constexpr size_t WS_STAT1 = al256(WS_ROPER + (size_t)4097 * 128 * 4);
constexpr size_t WS_STAT2 = WS_STAT1 + (size_t)TPAD * 2 * 4;
constexpr size_t WS_H = al256(WS_STAT2 + (size_t)TPAD * 2 * 4);
constexpr size_t WS_Z = WS_H + (size_t)TPAD * DM * 2;
constexpr size_t WS_MIX = WS_Z + (size_t)TPAD * INW * 2;
constexpr size_t WS_SST = WS_MIX + (size_t)TPAD * DM * 2;
constexpr size_t WS_BAR = WS_SST + (size_t)1024 * 16384 * 2;
constexpr size_t WS_CNT = WS_BAR + 16384;
constexpr size_t WS_END = WS_CNT + 528 * 64;

struct Params {
    const float *x_prompt, *x_sample, *c_prompt, *c_sample, *cache_k, *cache_v, *state_ret, *w_ada_mix, *b_ada_mix, *w_in, *att_sinks, *ret_gn_w, *w_out,
        *ln1_w, *ln1_b, *w_ada_ffn, *b_ada_ffn, *w_up, *w_down, *ln2_w, *ln2_b;
    float* out; unsigned char* ws;
};

__device__ __forceinline__ unsigned cvt_pk_bf16(float lo, float hi) { unsigned r; asm volatile("v_cvt_pk_bf16_f32 %0, %1, %2" : "=v"(r) : "v"(lo), "v"(hi)); return r; }
__device__ __forceinline__ float bf2f(bf16_t b) { return __uint_as_float(((unsigned)b) << 16); }
__device__ __forceinline__ bf16_t f2bf(float f) { return (bf16_t)(cvt_pk_bf16(f, 0.f) & 0xffffu); }
__device__ __forceinline__ float bflo(unsigned u) { return __uint_as_float(u << 16); }
__device__ __forceinline__ float bfhi(unsigned u) { return __uint_as_float(u & 0xffff0000u); }
__device__ __forceinline__ float silu_f(float v) { return v / (1.f + __expf(-v)); }
__device__ __forceinline__ float log_gamma(int h) {
    return h == 0 ? -0.0317486983145803f : (h == 1 ? -0.012479111952334388f : (h == 2 ? -0.004933717393740471f : -0.0019550348358033506f));
}
__device__ __forceinline__ int att_dim(int p) { if (p >= 16) return p; const int g = p >> 3, j = p & 7; return j < 4 ? 4 * g + j : 8 + 4 * g + (j - 4); }
__device__ __forceinline__ int ret_dim(int p) { const int g = p >> 3, j = p & 7; return j < 4 ? 4 * g + j : 64 + 4 * g + (j - 4); }
__device__ __forceinline__ int in_col(int P) {
    if (P < 640) return (P & ~63) + att_dim(P & 63);
    if (P >= 768 && P < 1792) { const int p = (P - 768) & 127; return P - p + ret_dim(p); }
    return P;
}
__device__ __forceinline__ int up_col(int P) { const int pn = P >> 8, q = P & 255; return q < 128 ? pn * 128 + q : DFF + pn * 128 + (q - 128); }

namespace pg8 {
constexpr int BM = 256, BK = 64, HALF = 128, HTB = HALF * BK * 2, STAGE_BYTES = 8 * HTB, NXCD = 8, WGM = 8;
__device__ __forceinline__ int lds_byte(int r, int c) { const int st = (r >> 4) * 2 + (c >> 5), rr = r & 15, cc = c & 31, ob = rr * 64 + cc * 2; return st * 1024 + (ob ^ (((ob >> 9) & 1) << 5)); }
__device__ __forceinline__ void stage_rc(int b, int& R, int& C) { const int st = b / 1024, sb = b % 1024, swz = sb ^ (((sb >> 9) & 1) << 5); R = (st >> 1) * 16 + swz / 64; C = (st & 1) * 32 + (swz % 64) / 2; }
__device__ __forceinline__ int perm32(int rho) { const int n = rho >> 4, i = rho & 15; return 8 * (i >> 2) + 4 * n + (i & 3); }
struct Unit { int pm, pn; };
struct Gemm { const bf16_t* A; const bf16_t* Bt; int M, N, K; };
struct StaticOrder {
    int nM, nN, nwg, G, c;
    __device__ void init(int M, int N, int G_, int c_) { nM = M / BM; nN = N / BM; nwg = nM * nN; G = G_; c = c_; }
    __device__ bool next(int i, Unit& u) const {
        const long L = (long)i * G + c; if (L >= nwg) return false;
        int wgid = (int)L; { const int q = nwg / NXCD, r = nwg % NXCD, xcd = wgid % NXCD, off = wgid / NXCD; wgid = (xcd < r ? xcd * (q + 1) : r * (q + 1) + (xcd - r) * q) + off; }
        const int nig = WGM * nN, gid = wgid / nig, fm = gid * WGM, gsz = (nM - fm) < WGM ? (nM - fm) : WGM;
        u.pm = fm + ((wgid % nig) % gsz); u.pn = (wgid % nig) / gsz; return true;
    }
};

template <class Epi, class Sched>
__device__ __forceinline__ void gemm_phase(LAS unsigned char* lds, const Gemm g, const Sched& S, const Epi& E) {
    const int tid = threadIdx.x, wid = __builtin_amdgcn_readfirstlane(tid >> 6), lane = tid & 63, wr = wid >> 2, wc = wid & 3, fr = lane & 15, fq = lane >> 4;
    const int K = g.K, nt = K / BK;
    unsigned voffA[2], voffB[2];
#pragma unroll
    for (int i = 0; i < 2; ++i) { int R, C; stage_rc(tid * 16 + i * 8192, R, C); const int Rb = Epi::PERM ? ((R & ~31) + perm32(R & 31)) : R;
        voffA[i] = (unsigned)(R * K + C) * 2u; voffB[i] = (unsigned)(Rb * K + C) * 2u; }
    const size_t kstep = (size_t)(BK * 2);
    const size_t hstep = (size_t)HALF * K * 2;
    const size_t tstep = 2 * hstep;
    const unsigned ldsw = (unsigned)wid * 1024u;
    const int aoff = lds_byte(wr * 64 + fr, fq * 8), boff = lds_byte(wc * 32 + fr, fq * 8);
#define PG8_SA(b, h) (((b) * 2 + (h)) * HTB)
#define PG8_SB(b, h) ((4 + (b) * 2 + (h)) * HTB)
#define PG8_STAGE(bufoff, gbase, voff) do { _Pragma("unroll") for (int _i = 0; _i < 2; ++_i) \
        __builtin_amdgcn_global_load_lds((const unsigned*)((const char*)(gbase) + (voff)[_i]), (LAS unsigned*)(lds + (bufoff) + ldsw + _i * 8192), 16, 0, 0); } while (0)
#define PG8_LDA(dst, b, h) do { _Pragma("unroll") for (int m = 0; m < 4; ++m) _Pragma("unroll") for (int k = 0; k < 2; ++k) dst[m][k] = *(const LAS bf16x8*)(lds + PG8_SA(b, h) + aoff + m * 2048 + k * 1024); } while (0)
#define PG8_LDB(dst, b, h) do { _Pragma("unroll") for (int n = 0; n < 2; ++n) _Pragma("unroll") for (int k = 0; k < 2; ++k) dst[n][k] = *(const LAS bf16x8*)(lds + PG8_SB(b, h) + boff + n * 2048 + k * 1024); } while (0)
#define PG8_MMA(ai, bj, At, Bt) do { __builtin_amdgcn_s_setprio(1); _Pragma("unroll") for (int m = 0; m < 4; ++m) _Pragma("unroll") for (int n = 0; n < 2; ++n) _Pragma("unroll") for (int k = 0; k < 2; ++k) \
        acc[ai][bj][m][n] = __builtin_amdgcn_mfma_f32_16x16x32_bf16(Bt[n][k], At[m][k], acc[ai][bj][m][n], 0, 0, 0); __builtin_amdgcn_s_setprio(0); } while (0)
#define PG8_WAIT_V(n) asm volatile("s_waitcnt vmcnt(" #n ")" ::: "memory")
#define PG8_WAIT_L(n) asm volatile("s_waitcnt lgkmcnt(" #n ")" ::: "memory")
#define PG8_BAR __builtin_amdgcn_s_barrier()
#define PG8_SCHED __builtin_amdgcn_sched_barrier(0)
    Unit cur, nxt; int ui = 0;
    if (!S.next(0, cur)) return;
    f32x4 acc[2][2][4][2];
#pragma unroll
    for (int a = 0; a < 2; ++a)
#pragma unroll
        for (int b = 0; b < 2; ++b)
#pragma unroll
            for (int m = 0; m < 4; ++m)
#pragma unroll
                for (int n = 0; n < 2; ++n) acc[a][b][m][n] = (f32x4){0.f, 0.f, 0.f, 0.f};
    bf16x8 At[4][2], B0[2][2], B1[2][2];
    const char* cA = (const char*)g.A + (size_t)cur.pm * tstep; const char* cB = (const char*)g.Bt + (size_t)cur.pn * tstep;
    PG8_STAGE(PG8_SB(0, 0), cB, voffB); PG8_STAGE(PG8_SA(0, 0), cA, voffA); PG8_STAGE(PG8_SB(0, 1), cB + hstep, voffB); PG8_STAGE(PG8_SA(0, 1), cA + hstep, voffA);
    if (wr == 1) PG8_BAR;
    PG8_WAIT_V(4); PG8_BAR;
    PG8_STAGE(PG8_SB(1, 0), cB + kstep, voffB); PG8_STAGE(PG8_SA(1, 0), cA + kstep, voffA); PG8_STAGE(PG8_SB(1, 1), cB + hstep + kstep, voffB);
    PG8_WAIT_V(6); PG8_BAR;
    for (;;) {
        const bool has_next = S.next(ui + 1, nxt);
        const char* nA = has_next ? (const char*)g.A + (size_t)nxt.pm * tstep : cA; const char* nB = has_next ? (const char*)g.Bt + (size_t)nxt.pn * tstep : cB;
        for (int t = 0; t < nt; t += 2) {
            const bool last = (t == nt - 2);
            const char* a1 = cA + (size_t)(t + 1) * kstep;
            const char* a2 = last ? nA : cA + (size_t)(t + 2) * kstep; const char* b2 = last ? nB : cB + (size_t)(t + 2) * kstep;
            const char* a3 = a2 + kstep; const char* b3 = b2 + kstep;
            PG8_LDB(B0, 0, 0); PG8_SCHED; PG8_LDA(At, 0, 0); PG8_STAGE(PG8_SA(1, 1), a1 + hstep, voffA);
            PG8_WAIT_L(8); PG8_BAR; PG8_WAIT_L(0); PG8_MMA(0, 0, At, B0); PG8_BAR; PG8_SCHED;
            PG8_LDB(B1, 0, 1); PG8_STAGE(PG8_SB(0, 0), b2, voffB);
            PG8_BAR; PG8_WAIT_L(0); PG8_MMA(0, 1, At, B1); PG8_BAR;
            PG8_LDA(At, 0, 1); PG8_STAGE(PG8_SA(0, 0), a2, voffA);
            PG8_BAR; PG8_WAIT_L(0); PG8_MMA(1, 0, At, B0); PG8_BAR; PG8_SCHED;
            PG8_STAGE(PG8_SB(0, 1), b2 + hstep, voffB);
            PG8_WAIT_V(6); PG8_BAR; PG8_MMA(1, 1, At, B1); PG8_BAR;
            PG8_LDB(B0, 1, 0); PG8_SCHED; PG8_LDA(At, 1, 0); PG8_STAGE(PG8_SA(0, 1), a2 + hstep, voffA);
            PG8_WAIT_L(8); PG8_BAR; PG8_WAIT_L(0); PG8_MMA(0, 0, At, B0); PG8_BAR; PG8_SCHED;
            PG8_LDB(B1, 1, 1); PG8_STAGE(PG8_SB(1, 0), b3, voffB);
            PG8_BAR; PG8_WAIT_L(0); PG8_MMA(0, 1, At, B1); PG8_BAR;
            PG8_LDA(At, 1, 1); PG8_STAGE(PG8_SA(1, 0), a3, voffA);
            PG8_BAR; PG8_WAIT_L(0); PG8_MMA(1, 0, At, B0); PG8_BAR; PG8_SCHED;
            PG8_STAGE(PG8_SB(1, 1), b3 + hstep, voffB);
            PG8_WAIT_V(6); PG8_BAR; PG8_MMA(1, 1, At, B1); PG8_BAR;
        }
        if constexpr (Epi::ALIGNED) { if (wr == 0) PG8_BAR; }
        E(acc, cur, wr, wc, fr, fq);
        if (!has_next) break;
#pragma unroll
        for (int a = 0; a < 2; ++a)
#pragma unroll
            for (int b = 0; b < 2; ++b)
#pragma unroll
                for (int m = 0; m < 4; ++m)
#pragma unroll
                    for (int n = 0; n < 2; ++n) acc[a][b][m][n] = (f32x4){0.f, 0.f, 0.f, 0.f};
        cur = nxt; cA = nA; cB = nB; ++ui;
        if constexpr (Epi::ALIGNED) { if (wr == 1) PG8_BAR; }
    }
    PG8_WAIT_V(0);
    if constexpr (!Epi::ALIGNED) { if (wr == 0) PG8_BAR; }
    PG8_BAR;
#undef PG8_SA
#undef PG8_SB
#undef PG8_STAGE
#undef PG8_LDA
#undef PG8_LDB
#undef PG8_MMA
#undef PG8_WAIT_V
#undef PG8_WAIT_L
#undef PG8_BAR
#undef PG8_SCHED
}
}
using pg8::Unit;

struct EpiAda {
    static constexpr bool PERM = false, ALIGNED = false;
    float* mod; const float* b_mix; const float* b_ffn;
    __device__ __forceinline__ void operator()(const f32x4 (&acc)[2][2][4][2], const Unit& u, int wr, int wc, int fr, int fq) const {
#pragma unroll
        for (int ai = 0; ai < 2; ++ai)
#pragma unroll
            for (int m = 0; m < 4; ++m) {
                const int r = u.pm * 256 + ai * 128 + wr * 64 + m * 16 + fr;
#pragma unroll
                for (int bj = 0; bj < 2; ++bj)
#pragma unroll
                    for (int n = 0; n < 2; ++n) {
                        const int c = u.pn * 256 + bj * 128 + wc * 32 + n * 16 + fq * 4;
                        const f32x4 bv = c < 3072 ? *(const f32x4*)(b_mix + c) : *(const f32x4*)(b_ffn + c - 3072);
                        *(f32x4*)(mod + (size_t)r * 6144 + c) = acc[ai][bj][m][n] + bv;
                    }
            }
    }
};

struct EpiIn {
    static constexpr bool PERM = true, ALIGNED = true;
    bf16_t* Z; const float* ropeA; const float* ropeR; float* out;
    __device__ __forceinline__ void operator()(const f32x4 (&acc)[2][2][4][2], const Unit& u, int wr, int wc, int fr, int fq) const {
#pragma unroll
        for (int bj = 0; bj < 2; ++bj) {
            const int cb128 = u.pn * 256 + bj * 128;
            const int cb = cb128 + wc * 32 + fq * 8;
            const int region = cb128 < 512 ? 0 : (cb128 < 640 ? 1 : (cb128 < 768 ? 2 : (cb128 < 1280 ? 3 : (cb128 < 1792 ? 4 : 5))));
#pragma unroll
            for (int ai = 0; ai < 2; ++ai)
#pragma unroll
                for (int m = 0; m < 4; ++m) {
                    const int r0 = u.pm * 256 + ai * 128 + wr * 64 + m * 16;
                    if (r0 >= TV) continue;
                    const int r = r0 + fr;
                    const int pos = r < TP ? (r & 4095) : 4096;
                    f32x4 v0 = acc[ai][bj][m][0], v1 = acc[ai][bj][m][1];
                    if (region <= 1) {
                        const int p = cb & 63;
                        if (p < 16) {
                            const int grp = p >> 3;
                            const f32x4 cs = *(const f32x4*)(ropeA + pos * 16 + 4 * grp), sn = *(const f32x4*)(ropeA + pos * 16 + 8 + 4 * grp);
                            const f32x4 a = v0 * cs - v1 * sn, b = v1 * cs + v0 * sn; v0 = a; v1 = b;
                        }
                    } else if (region == 3 || region == 4) {
                        const int g = (cb & 127) >> 3;
                        const f32x4 cs = *(const f32x4*)(ropeR + pos * 128 + 4 * g), sn = *(const f32x4*)(ropeR + pos * 128 + 64 + 4 * g);
                        f32x4 a = v0 * cs - v1 * sn, b = v1 * cs + v0 * sn;
                        if (region == 4) { a *= RK_SCALE; b *= RK_SCALE; }
                        v0 = a; v1 = b;
                    }
                    u32x4 pk; pk[0] = cvt_pk_bf16(v0[0], v0[1]); pk[1] = cvt_pk_bf16(v0[2], v0[3]); pk[2] = cvt_pk_bf16(v1[0], v1[1]); pk[3] = cvt_pk_bf16(v1[2], v1[3]);
                    *(u32x4*)(Z + (size_t)r * INW + cb) = pk;
                    if (region == 1 || region == 2) {
                        const int kvh = (cb >> 6) & 1, p = cb & 63;
                        int d0 = p, d1 = p + 4;
                        if (region == 1 && p < 16) { const int grp = p >> 3; d0 = 4 * grp; d1 = 8 + 4 * grp; }
                        float* dst = nullptr;
                        if (r < TP) { if (pos >= SEQ - 128) dst = out + (region == 1 ? O_KP : O_VP) + ((size_t)((r >> 12) * 128 + (pos - (SEQ - 128))) * 2 + kvh) * 64; }
                        else dst = out + (region == 1 ? O_KS : O_VS) + ((size_t)((r - TP) * 128 + 127) * 2 + kvh) * 64;
                        if (dst) { *(f32x4*)(dst + d0) = v0; *(f32x4*)(dst + d1) = v1; }
                    }
                }
        }
    }
};

__device__ __forceinline__ void wait_ge(unsigned* pc, unsigned target, unsigned* tmo) {
    unsigned sp = 0;
    while (__hip_atomic_load(pc, __ATOMIC_RELAXED, __HIP_MEMORY_SCOPE_AGENT) < target) {
        __builtin_amdgcn_s_sleep(1);
        if ((++sp & 1023u) == 0u) { if (__hip_atomic_load(tmo, __ATOMIC_RELAXED, __HIP_MEMORY_SCOPE_AGENT) != 0u) break;
                                    if (sp > (1u << 21)) { __hip_atomic_store(tmo, 1u, __ATOMIC_RELAXED, __HIP_MEMORY_SCOPE_AGENT); break; } }
    }
}
template <bool BASE_BF16, bool OUT_BF16>
struct EpiLn {
    static constexpr bool PERM = false, ALIGNED = true;
    const void* base; void* Y; const float* mod; int gate_off; float* stat; unsigned* cnt; const float* lw; const float* lb; bf16_t* H; int h_off; unsigned* tmo;
    __device__ __forceinline__ void operator()(f32x4 (&acc)[2][2][4][2], const Unit& u, int wr, int wc, int fr, int fq) const {
        const float* mrow = mod + (size_t)(128 + (u.pm >> 4)) * 6144 + u.pn * 256;
        const size_t torg = (size_t)u.pm * 256 * DM + u.pn * 256;
        const float* tbf = (const float*)base + torg; const bf16_t* tbh = (const bf16_t*)base + torg; float* tyf = (float*)Y + torg; bf16_t* tyh = (bf16_t*)Y + torg; float* ts = stat + (size_t)u.pm * 512;
        const unsigned lo = (unsigned)((wr * 64 + fr) * DM + wc * 32 + fq * 4), lc = (unsigned)(wc * 32 + fq * 4), lrw = (unsigned)(wr * 64 + fr);
        f32x4 gv[2][2];
#pragma unroll
        for (int bj = 0; bj < 2; ++bj)
#pragma unroll
            for (int n = 0; n < 2; ++n) gv[bj][n] = 1.f + *(const f32x4*)(mrow + gate_off + lc + (bj * 128 + n * 16));
        float sv[8], ssv[8];
        unsigned lod[2] = {lo, lo};
#pragma unroll
        for (int k = 0; k < 8; ++k) {
            const int ai = k >> 2, m = k & 3;
            const unsigned lk = lod[k & 1];
            float s = 0.f, ss = 0.f;
#pragma unroll
            for (int bj = 0; bj < 2; ++bj)
#pragma unroll
                for (int n = 0; n < 2; ++n) {
                    f32x4 xv;
                    if constexpr (BASE_BF16) { const u32x2 xb = *(const u32x2*)(tbh + lk + ((ai * 128 + m * 16) * DM + bj * 128 + n * 16)); xv = (f32x4){bflo(xb[0]), bfhi(xb[0]), bflo(xb[1]), bfhi(xb[1])}; }
                    else xv = *(const f32x4*)(tbf + lk + ((ai * 128 + m * 16) * DM + bj * 128 + n * 16));
                    const f32x4 res = ALPHA * xv + gv[bj][n] * acc[ai][bj][m][n];
                    acc[ai][bj][m][n] = res;
                    s += res[0] + res[1] + res[2] + res[3];
                    ss += res[0] * res[0] + res[1] * res[1] + res[2] * res[2] + res[3] * res[3];
                }
            sv[k] = s; ssv[k] = ss;
            asm volatile("" : "+v"(lod[k & 1]) : "v"(s));
        }
#pragma unroll
        for (int k = 0; k < 8; ++k) {
            float s = sv[k], ss = ssv[k];
            s += __shfl_xor(s, 16); ss += __shfl_xor(ss, 16);
            s += __shfl_xor(s, 32); ss += __shfl_xor(ss, 32);
            if (fq == 0) { float* sp = ts + 2 * (lrw + (k >> 2) * 128 + (k & 3) * 16); __hip_atomic_fetch_add(sp, s, __ATOMIC_RELAXED, __HIP_MEMORY_SCOPE_AGENT); __hip_atomic_fetch_add(sp + 1, ss, __ATOMIC_RELAXED, __HIP_MEMORY_SCOPE_AGENT); }
        }
        asm volatile("s_waitcnt vmcnt(0)" ::: "memory");
        unsigned* pc = cnt + (u.pm * 2 + wr) * 16;
        if (fr + fq == 0) __hip_atomic_fetch_add(pc, 1u, __ATOMIC_RELAXED, __HIP_MEMORY_SCOPE_AGENT);
        wait_ge(pc, 16u, tmo);
        asm volatile("" ::: "memory");
        float sa8[8], sb8[8];
#pragma unroll
        for (int k = 0; k < 8; ++k) { const float* sp = ts + 2 * (lrw + (k >> 2) * 128 + (k & 3) * 16);
            sa8[k] = __hip_atomic_load(sp, __ATOMIC_RELAXED, __HIP_MEMORY_SCOPE_AGENT); sb8[k] = __hip_atomic_load(sp + 1, __ATOMIC_RELAXED, __HIP_MEMORY_SCOPE_AGENT); }
#pragma unroll
        for (int ai = 0; ai < 2; ++ai)
#pragma unroll
            for (int m = 0; m < 4; ++m) {
                const float sa = sa8[ai * 4 + m], sb = sb8[ai * 4 + m];
                const float mu = sa * (1.f / 1024.f), var = sb * (1.f / 1024.f) - mu * mu, rstd = rsqrtf(fmaxf(var, 0.f) + 1e-5f);
#pragma unroll
                for (int bj = 0; bj < 2; ++bj)
#pragma unroll
                    for (int n = 0; n < 2; ++n) {
                        const int co = bj * 128 + n * 16;
                        const f32x4 y = (acc[ai][bj][m][n] - mu) * rstd * *(const f32x4*)(lw + u.pn * 256 + lc + co) + *(const f32x4*)(lb + u.pn * 256 + lc + co);
                        if constexpr (OUT_BF16) { u32x2 yo; yo[0] = cvt_pk_bf16(y[0], y[1]); yo[1] = cvt_pk_bf16(y[2], y[3]); *(u32x2*)(tyh + lo + ((ai * 128 + m * 16) * DM + co)) = yo; }
                        else *(f32x4*)(tyf + lo + ((ai * 128 + m * 16) * DM + co)) = y;
                        if (H) { const f32x4 hv = y * (1.f + *(const f32x4*)(mrow + h_off + 1024 + lc + co)) + *(const f32x4*)(mrow + h_off + lc + co);
                                 u32x2 o; o[0] = cvt_pk_bf16(hv[0], hv[1]); o[1] = cvt_pk_bf16(hv[2], hv[3]); *(u32x2*)(H + torg + lo + ((ai * 128 + m * 16) * DM + co)) = o; }
                    }
            }
    }
};

struct EpiUp {
    static constexpr bool PERM = true, ALIGNED = true;
    bf16_t* F;
    __device__ __forceinline__ void operator()(const f32x4 (&acc)[2][2][4][2], const Unit& u, int wr, int wc, int fr, int fq) const {
#pragma unroll
        for (int ai = 0; ai < 2; ++ai)
#pragma unroll
            for (int m = 0; m < 4; ++m) {
                const int r0 = u.pm * 256 + ai * 128 + wr * 64 + m * 16;
                if (r0 >= TV) continue;
                const int r = r0 + fr;
                float f[8];
#pragma unroll
                for (int n = 0; n < 2; ++n)
#pragma unroll
                    for (int i = 0; i < 4; ++i) { const float g = acc[ai][0][m][n][i]; f[n * 4 + i] = silu_f(g) * acc[ai][1][m][n][i]; }
                u32x4 pk; pk[0] = cvt_pk_bf16(f[0], f[1]); pk[1] = cvt_pk_bf16(f[2], f[3]); pk[2] = cvt_pk_bf16(f[4], f[5]); pk[3] = cvt_pk_bf16(f[6], f[7]);
                *(u32x4*)(F + (size_t)r * DFF + u.pn * 128 + wc * 32 + fq * 8) = pk;
            }
    }
};

__device__ __forceinline__ void prep_tiles(const Params& p, unsigned char* shm, int tt0, int tt1, int stride) {
    const int tid = threadIdx.x;
    bf16_t* tile = (bf16_t*)shm;
    for (int tt = tt0; tt < tt1; tt += stride) {
        const float* src; bf16_t* dst; int ld, K, mode, t;
        if (tt < 176) { t = tt; src = p.w_in; ld = INW; K = DM; dst = (bf16_t*)(p.ws + WS_WIN); mode = 1; }
        else if (tt < 240) { t = tt - 176; src = p.w_out; ld = DM; K = DM; dst = (bf16_t*)(p.ws + WS_WOUT); mode = 0; }
        else if (tt < 592) { t = tt - 240; src = p.w_up; ld = 2 * DFF; K = DM; dst = (bf16_t*)(p.ws + WS_WUP); mode = 2; }
        else if (tt < 768) { t = tt - 592; src = p.w_down; ld = DM; K = DFF; dst = (bf16_t*)(p.ws + WS_WDOWN); mode = 0; }
        else if (tt < 960) { t = tt - 768; src = p.w_ada_mix; ld = 3072; K = DM; dst = (bf16_t*)(p.ws + WS_WADA); mode = 0; }
        else { t = tt - 960; src = p.w_ada_ffn; ld = 3072; K = DM; dst = (bf16_t*)(p.ws + WS_WADA) + (size_t)3072 * DM; mode = 0; }
        const int nkt = K / 256, rt = t / nkt, kt = t % nkt;
        const int P = rt * 64 + (tid & 63);
        const int L = mode == 1 ? in_col(P) : (mode == 2 ? up_col(P) : P);
        const float* sp = src + (size_t)(kt * 256 + (tid >> 6)) * ld + L;
#pragma unroll
        for (int i = 0; i < 32; ++i) tile[(tid & 63) * 264 + (tid >> 6) + 8 * i] = f2bf(sp[(size_t)(8 * i) * ld]);
        __syncthreads();
        { const int pr = tid >> 3, kc = tid & 7;
#pragma unroll
          for (int j = 0; j < 4; ++j) *(u32x4*)(dst + (size_t)(rt * 64 + pr) * K + kt * 256 + (kc + 8 * j) * 8) = *(const u32x4*)(tile + pr * 264 + (kc + 8 * j) * 8); }
        __syncthreads();
    }
}
__device__ __forceinline__ void prep_misc(const Params& p) {
    const int tid = threadIdx.x;
    const int gt = blockIdx.x * 512 + tid, gs = gridDim.x * 512;
    bf16_t* sc = (bf16_t*)(p.ws + WS_SC);
    for (int i = gt; i < 256 * DM; i += gs) { const int r = i >> 10, k = i & 1023; float v = 0.f; if (r < 128) v = silu_f(p.c_sample[r * DM + k]); else if (r < 136) v = silu_f(p.c_prompt[(r - 128) * DM + k]); sc[i] = f2bf(v); }
    float* st = (float*)(p.ws + WS_STAT1);
    for (int i = gt; i < TPAD * 4; i += gs) st[i] = 0.f;
    for (int i = gt; i < 528 * 16; i += gs) ((unsigned*)(p.ws + WS_CNT))[i] = 0u;
    float* ra = (float*)(p.ws + WS_ROPEA); float* rr = (float*)(p.ws + WS_ROPER);
    for (int i = gt; i < 4097 * 72; i += gs) {
        const int pos = i / 72, f = i % 72;
        const double pv = pos < 4096 ? (double)pos : (double)PAST;
        const double inv = f < 8 ? exp(-13.122363377404328 * (double)f / 8.0) : exp(-9.210340371976184 * (double)(f - 8) / 64.0);
        const double ang = pv * inv;
        const double kk = rint(ang * 0.15915494309189535);
        const float red = (float)(ang - kk * 6.283185307179586);
        const float cs = cosf(red), sn = sinf(red);
        if (f < 8) { ra[pos * 16 + f] = cs; ra[pos * 16 + 8 + f] = sn; } else { rr[pos * 128 + (f - 8)] = cs; rr[pos * 128 + 64 + (f - 8)] = sn; }
    }
}

__device__ __forceinline__ void phase_modulate(const Params& p) {
    const float* mod = (const float*)(p.ws + WS_MOD); bf16_t* H = (bf16_t*)(p.ws + WS_H);
    const int gt = blockIdx.x * 512 + threadIdx.x, gs = gridDim.x * 512;
    constexpr int NCH = TV * 128;
    for (int i0 = gt; i0 < NCH; i0 += 4 * gs) {
        f32x4 x0[4], x1[4];
#pragma unroll
        for (int u = 0; u < 4; ++u) { const int i = i0 + u * gs; if (i < NCH) { const int r = i >> 7, c = (i & 127) * 8;
            const float* xr = r < TP ? p.x_prompt + (size_t)r * DM : p.x_sample + (size_t)(r - TP) * DM;
            x0[u] = __builtin_nontemporal_load((const f32x4*)(xr + c)); x1[u] = __builtin_nontemporal_load((const f32x4*)(xr + c + 4)); } }
#pragma unroll
        for (int u = 0; u < 4; ++u) { const int i = i0 + u * gs; if (i < NCH) { const int r = i >> 7, c = (i & 127) * 8;
            const int mrow = r < TP ? 128 + (r >> 12) : r - TP;
            const float* sh = mod + (size_t)mrow * 6144; const float* scl = sh + 1024;
            const f32x4 h0 = x0[u] * (1.f + *(const f32x4*)(scl + c)) + *(const f32x4*)(sh + c), h1 = x1[u] * (1.f + *(const f32x4*)(scl + c + 4)) + *(const f32x4*)(sh + c + 4);
            u32x4 pk; pk[0] = cvt_pk_bf16(h0[0], h0[1]); pk[1] = cvt_pk_bf16(h0[2], h0[3]); pk[2] = cvt_pk_bf16(h1[0], h1[1]); pk[3] = cvt_pk_bf16(h1[2], h1[3]);
            *(u32x4*)(H + (size_t)r * DM + c) = pk; } }
    }
}

__device__ __forceinline__ void attn_item(const Params& p, unsigned char* shm, int item) {
    const int tid = threadIdx.x, wid = tid >> 6, lane = tid & 63, lr = lane & 15, g = lane >> 4;
    const int b = item >> 6, kvh = (item >> 5) & 1, n = item & 31;
    const bf16_t* Z = (const bf16_t*)(p.ws + WS_Z); bf16_t* MIX = (bf16_t*)(p.ws + WS_MIX);
    bf16_t* Ks = (bf16_t*)shm;
    bf16_t* VT = Ks + 256 * 72;
    {
        const int key = tid >> 1, hf = tid & 1;
        const bool valid = (n > 0) || (key >= 128);
        const size_t row = (size_t)b * SEQ + (size_t)(n - 1) * 128 + key;
        const bf16_t* kp = Z + row * INW + 512 + kvh * 64 + hf * 32; const bf16_t* vp = Z + row * INW + 640 + kvh * 64 + hf * 32;
#pragma unroll
        for (int c = 0; c < 4; ++c) {
            u32x4 kv = (u32x4){0u, 0u, 0u, 0u}, vv = (u32x4){0u, 0u, 0u, 0u};
            if (valid) { kv = *(const u32x4*)(kp + c * 8); vv = *(const u32x4*)(vp + c * 8); }
            *(u32x4*)(Ks + key * 72 + hf * 32 + c * 8) = kv;
#pragma unroll
            for (int e = 0; e < 4; ++e) { const int d = hf * 32 + c * 8 + 2 * e; VT[d * 264 + key] = (bf16_t)(vv[e] & 0xffffu); VT[(d + 1) * 264 + key] = (bf16_t)(vv[e] >> 16); }
        }
    }
    __syncthreads();
    for (int qt = 0; qt < 4; ++qt) {
        const int T = wid * 4 + qt, hq = T >> 3, tq = T & 7, t0 = tq * 16, head = kvh * 4 + hq;
        const size_t qrow = (size_t)b * SEQ + (size_t)n * 128 + t0 + lr;
        bf16x8 Qf[2];
#pragma unroll
        for (int kk = 0; kk < 2; ++kk) Qf[kk] = *(const bf16x8*)(Z + qrow * INW + head * 64 + kk * 32 + g * 8);
        const int kt0 = tq < 6 ? tq : 6;
        f32x4 S[10];
#pragma unroll
        for (int jt = 0; jt < 10; ++jt) {
            S[jt] = (f32x4){0.f, 0.f, 0.f, 0.f};
#pragma unroll
            for (int kk = 0; kk < 2; ++kk) {
                const bf16x8 Kf = *(const bf16x8*)(Ks + (16 * (kt0 + jt) + lr) * 72 + kk * 32 + g * 8);
                S[jt] = __builtin_amdgcn_mfma_f32_16x16x32_bf16(Kf, Qf[kk], S[jt], 0, 0, 0);
            }
        }
        const float sink = p.att_sinks[head];
        const int t = t0 + lr;
        float mx = sink;
#pragma unroll
        for (int jt = 0; jt < 10; ++jt)
#pragma unroll
            for (int r = 0; r < 4; ++r) {
                const int i = 16 * (kt0 + jt) + 4 * g + r, dist = 128 + t - i;
                const bool ok = dist >= 0 && dist <= 128 && (n > 0 || i >= 128);
                const float s = ok ? S[jt][r] * 0.125f : -INFINITY;
                S[jt][r] = s; mx = fmaxf(mx, s);
            }
        mx = fmaxf(mx, __shfl_xor(mx, 16)); mx = fmaxf(mx, __shfl_xor(mx, 32));
        float sum = 0.f;
#pragma unroll
        for (int jt = 0; jt < 10; ++jt)
#pragma unroll
            for (int r = 0; r < 4; ++r) { const float e = __expf(S[jt][r] - mx); S[jt][r] = e; sum += e; }
        sum += __shfl_xor(sum, 16); sum += __shfl_xor(sum, 32);
        const float inv = 1.f / (sum + __expf(sink - mx));
        f32x4 O[4];
#pragma unroll
        for (int dt = 0; dt < 4; ++dt) O[dt] = (f32x4){0.f, 0.f, 0.f, 0.f};
#pragma unroll
        for (int jp = 0; jp < 5; ++jp) {
            u32x4 pu; pu[0] = cvt_pk_bf16(S[2 * jp][0] * inv, S[2 * jp][1] * inv); pu[1] = cvt_pk_bf16(S[2 * jp][2] * inv, S[2 * jp][3] * inv);
            pu[2] = cvt_pk_bf16(S[2 * jp + 1][0] * inv, S[2 * jp + 1][1] * inv); pu[3] = cvt_pk_bf16(S[2 * jp + 1][2] * inv, S[2 * jp + 1][3] * inv);
            const bf16x8 Pf = __builtin_bit_cast(bf16x8, pu);
#pragma unroll
            for (int dt = 0; dt < 4; ++dt) {
                const bf16_t* vr = VT + (16 * dt + lr) * 264 + 16 * (kt0 + 2 * jp) + 4 * g;
                const u32x2 a0 = *(const u32x2*)vr, a1 = *(const u32x2*)(vr + 16);
                u32x4 au; au[0] = a0[0]; au[1] = a0[1]; au[2] = a1[0]; au[3] = a1[1];
                O[dt] = __builtin_amdgcn_mfma_f32_16x16x32_bf16(__builtin_bit_cast(bf16x8, au), Pf, O[dt], 0, 0, 0);
            }
        }
#pragma unroll
        for (int dt = 0; dt < 4; ++dt) {
            u32x2 o; o[0] = cvt_pk_bf16(O[dt][0], O[dt][1]); o[1] = cvt_pk_bf16(O[dt][2], O[dt][3]);
            *(u32x2*)(MIX + qrow * DM + head * 64 + 16 * dt + 4 * g) = o;
        }
    }
    __syncthreads();
}

__device__ __forceinline__ void retu_item(const Params& p, unsigned char* shm, int item) {
    const int tid = threadIdx.x, wid = tid >> 6, lane = tid & 63, lr = lane & 15, g = lane >> 4;
    const int b = item >> 7, h = (item >> 5) & 3, c = item & 31;
    const bf16_t* Z = (const bf16_t*)(p.ws + WS_Z); float* UT = (float*)(p.ws + WS_H);
    bf16_t* KT = (bf16_t*)shm;
    bf16_t* VT = KT + 128 * 136;
    const float lg = log_gamma(h);
    {
        const int j = tid >> 2, q = tid & 3;
        const size_t row = (size_t)b * SEQ + (size_t)c * 128 + j;
        const float dec = __expf(lg * (float)(127 - j));
        const bf16_t* kp = Z + row * INW + 1280 + h * 128 + q * 32; const bf16_t* vp = Z + row * INW + 1792 + h * 128 + q * 32;
#pragma unroll
        for (int cc = 0; cc < 4; ++cc) {
            const u32x4 kv = *(const u32x4*)(kp + cc * 8), vv = *(const u32x4*)(vp + cc * 8);
#pragma unroll
            for (int e = 0; e < 4; ++e) {
                const int d = q * 32 + cc * 8 + 2 * e;
                KT[d * 136 + j] = f2bf(bflo(kv[e]) * dec); KT[(d + 1) * 136 + j] = f2bf(bfhi(kv[e]) * dec);
                VT[d * 136 + j] = (bf16_t)(vv[e] & 0xffffu); VT[(d + 1) * 136 + j] = (bf16_t)(vv[e] >> 16);
            }
        }
    }
    __syncthreads();
    f32x4 acc[8];
#pragma unroll
    for (int dt = 0; dt < 8; ++dt) acc[dt] = (f32x4){0.f, 0.f, 0.f, 0.f};
#pragma unroll
    for (int kk = 0; kk < 4; ++kk) {
        const bf16x8 Bf = *(const bf16x8*)(VT + (16 * wid + lr) * 136 + kk * 32 + g * 8);
#pragma unroll
        for (int dt = 0; dt < 8; ++dt) {
            const bf16x8 Af = *(const bf16x8*)(KT + (16 * dt + lr) * 136 + kk * 32 + g * 8);
            acc[dt] = __builtin_amdgcn_mfma_f32_16x16x32_bf16(Af, Bf, acc[dt], 0, 0, 0);
        }
    }
    float* up = UT + (size_t)item * 16384 + (size_t)(16 * wid + lr) * 128;
#pragma unroll
    for (int dt = 0; dt < 8; ++dt) *(f32x4*)(up + 16 * dt + 4 * g) = acc[dt];
    __syncthreads();
}

__device__ __forceinline__ void phase_scan(const Params& p) {
    const float* UT = (const float*)(p.ws + WS_H); bf16_t* SST = (bf16_t*)(p.ws + WS_SST);
    const int gt = blockIdx.x * 512 + threadIdx.x, gs = gridDim.x * 512;
    for (int i = gt; i < 32 * 4096; i += gs) {
        const int bh = i >> 12, ed = (i & 4095) * 4, e = ed >> 7, d = ed & 127, h = bh & 3;
        const float gL = __expf(log_gamma(h) * 128.f);
        f32x4 s = (f32x4){0.f, 0.f, 0.f, 0.f};
        const float* up = UT + (size_t)bh * 32 * 16384 + ed; bf16_t* sp = SST + (size_t)bh * 32 * 16384 + ed;
#pragma unroll
        for (int c0 = 0; c0 < 32; c0 += 16) {
            f32x4 uv[16];
#pragma unroll
            for (int c = 0; c < 16; ++c) uv[c] = __builtin_nontemporal_load((const f32x4*)(up + (size_t)(c0 + c) * 16384));
#pragma unroll
            for (int c = 0; c < 16; ++c) { u32x2 o; o[0] = cvt_pk_bf16(s[0], s[1]); o[1] = cvt_pk_bf16(s[2], s[3]); *(u32x2*)(sp + (size_t)(c0 + c) * 16384) = o; s = gL * s + uv[c]; }
        }
#pragma unroll
        for (int k = 0; k < 4; ++k) p.out[O_RP + ((size_t)bh * 128 + ret_dim(d + k)) * 128 + e] = s[k];
    }
}

__device__ __forceinline__ void reto_item(const Params& p, unsigned char* shm, int item) {
    const int tid = threadIdx.x, wid = tid >> 6, lane = tid & 63, lr = lane & 15, g = lane >> 4;
    const int b = item >> 7, h = (item >> 5) & 3, c = item & 31;
    const bf16_t* Z = (const bf16_t*)(p.ws + WS_Z); const bf16_t* SST = (const bf16_t*)(p.ws + WS_SST); bf16_t* MIX = (bf16_t*)(p.ws + WS_MIX);
    bf16_t* Ks = (bf16_t*)shm;
    bf16_t* VT = Ks + 128 * 136;
    bf16_t* Ss = VT + 128 * 136;
    const float lg = log_gamma(h);
    const size_t row0 = (size_t)b * SEQ + (size_t)c * 128;
    {
        const int j = tid >> 2, q = tid & 3;
        const bf16_t* kp = Z + (row0 + j) * INW + 1280 + h * 128 + q * 32; const bf16_t* vp = Z + (row0 + j) * INW + 1792 + h * 128 + q * 32;
        const bf16_t* sp = SST + (size_t)item * 16384 + j * 128 + q * 32;
#pragma unroll
        for (int cc = 0; cc < 4; ++cc) {
            const u32x4 kv = *(const u32x4*)(kp + cc * 8), vv = *(const u32x4*)(vp + cc * 8), sv = *(const u32x4*)(sp + cc * 8);
            *(u32x4*)(Ks + j * 136 + q * 32 + cc * 8) = kv;
            *(u32x4*)(Ss + j * 136 + q * 32 + cc * 8) = sv;
#pragma unroll
            for (int e = 0; e < 4; ++e) { const int d = q * 32 + cc * 8 + 2 * e; VT[d * 136 + j] = (bf16_t)(vv[e] & 0xffffu); VT[(d + 1) * 136 + j] = (bf16_t)(vv[e] >> 16); }
        }
    }
    __syncthreads();
    const size_t qrow = row0 + 16 * wid + lr;
    bf16x8 Qf[4];
#pragma unroll
    for (int kk = 0; kk < 4; ++kk) Qf[kk] = *(const bf16x8*)(Z + qrow * INW + 768 + h * 128 + kk * 32 + g * 8);
    f32x4 S[8];
#pragma unroll
    for (int jt = 0; jt < 8; ++jt) {
        S[jt] = (f32x4){0.f, 0.f, 0.f, 0.f};
        if (jt <= wid) {
#pragma unroll
            for (int kk = 0; kk < 4; ++kk) {
                const bf16x8 Kf = *(const bf16x8*)(Ks + (16 * jt + lr) * 136 + kk * 32 + g * 8);
                S[jt] = __builtin_amdgcn_mfma_f32_16x16x32_bf16(Kf, Qf[kk], S[jt], 0, 0, 0);
            }
        }
    }
    const int it = 16 * wid + lr;
#pragma unroll
    for (int jt = 0; jt < 8; ++jt)
#pragma unroll
        for (int r = 0; r < 4; ++r) { const int j = 16 * jt + 4 * g + r; S[jt][r] = (j <= it) ? S[jt][r] * __expf(lg * (float)(it - j)) : 0.f; }
    f32x4 O1[8], O2[8];
#pragma unroll
    for (int et = 0; et < 8; ++et) { O1[et] = (f32x4){0.f, 0.f, 0.f, 0.f}; O2[et] = (f32x4){0.f, 0.f, 0.f, 0.f}; }
#pragma unroll
    for (int jp = 0; jp < 4; ++jp) {
        if (2 * jp <= wid) {
            u32x4 pu; pu[0] = cvt_pk_bf16(S[2 * jp][0], S[2 * jp][1]); pu[1] = cvt_pk_bf16(S[2 * jp][2], S[2 * jp][3]);
            pu[2] = cvt_pk_bf16(S[2 * jp + 1][0], S[2 * jp + 1][1]); pu[3] = cvt_pk_bf16(S[2 * jp + 1][2], S[2 * jp + 1][3]);
            const bf16x8 Pf = __builtin_bit_cast(bf16x8, pu);
#pragma unroll
            for (int et = 0; et < 8; ++et) {
                const bf16_t* vr = VT + (16 * et + lr) * 136 + 32 * jp + 4 * g;
                const u32x2 a0 = *(const u32x2*)vr, a1 = *(const u32x2*)(vr + 16);
                u32x4 au; au[0] = a0[0]; au[1] = a0[1]; au[2] = a1[0]; au[3] = a1[1];
                O1[et] = __builtin_amdgcn_mfma_f32_16x16x32_bf16(__builtin_bit_cast(bf16x8, au), Pf, O1[et], 0, 0, 0);
            }
        }
    }
#pragma unroll
    for (int kk = 0; kk < 4; ++kk)
#pragma unroll
        for (int et = 0; et < 8; ++et) {
            const bf16x8 Sf = *(const bf16x8*)(Ss + (16 * et + lr) * 136 + kk * 32 + g * 8);
            O2[et] = __builtin_amdgcn_mfma_f32_16x16x32_bf16(Sf, Qf[kk], O2[et], 0, 0, 0);
        }
    const float qd = __expf(lg * (float)(it + 1));
    float sum = 0.f;
#pragma unroll
    for (int et = 0; et < 8; ++et)
#pragma unroll
        for (int r = 0; r < 4; ++r) { const float o = O1[et][r] + qd * O2[et][r]; O1[et][r] = o; sum += o; }
    sum += __shfl_xor(sum, 16); sum += __shfl_xor(sum, 32);
    const float mu = sum * (1.f / 128.f);
    float vs = 0.f;
#pragma unroll
    for (int et = 0; et < 8; ++et)
#pragma unroll
        for (int r = 0; r < 4; ++r) { const float dlt = O1[et][r] - mu; vs += dlt * dlt; }
    vs += __shfl_xor(vs, 16); vs += __shfl_xor(vs, 32);
    const float rstd = rsqrtf(vs * (1.f / 128.f) + 1e-6f);
#pragma unroll
    for (int et = 0; et < 8; ++et) {
        const int e = 16 * et + 4 * g;
        const u32x2 gz = *(const u32x2*)(Z + qrow * INW + 2304 + h * 128 + e);
        const f32x4 gw = *(const f32x4*)(p.ret_gn_w + h * 128 + e);
        const float r0 = (O1[et][0] - mu) * rstd * gw[0] * silu_f(bflo(gz[0])), r1 = (O1[et][1] - mu) * rstd * gw[1] * silu_f(bfhi(gz[0]));
        const float r2 = (O1[et][2] - mu) * rstd * gw[2] * silu_f(bflo(gz[1])), r3 = (O1[et][3] - mu) * rstd * gw[3] * silu_f(bfhi(gz[1]));
        u32x2 o; o[0] = cvt_pk_bf16(r0, r1); o[1] = cvt_pk_bf16(r2, r3);
        *(u32x2*)(MIX + qrow * DM + 512 + h * 128 + e) = o;
    }
    __syncthreads();
}

__device__ __forceinline__ void sample_att(const Params& p, unsigned char* shm, int b) {
    const int tid = threadIdx.x, wid = tid >> 6, lane = tid & 63;
    const bf16_t* zrow = (const bf16_t*)(p.ws + WS_Z) + (size_t)(TP + b) * INW; bf16_t* mixrow = (bf16_t*)(p.ws + WS_MIX) + (size_t)(TP + b) * DM;
    float* sm = (float*)shm;
    float* qn = sm;
    float* kn = qn + 512;
    float* vn = kn + 128;
    float* scs = vn + 128;
    { const int hh = tid >> 6, pp = tid & 63; qn[hh * 64 + att_dim(pp)] = bf2f(zrow[tid]); }
    if (tid < 128) { const int hh = tid >> 6, pp = tid & 63; kn[hh * 64 + att_dim(pp)] = bf2f(zrow[512 + tid]); vn[tid] = bf2f(zrow[640 + tid]); }
    __syncthreads();
    const float* ck = p.cache_k + (size_t)b * 128 * 128; const float* cv = p.cache_v + (size_t)b * 128 * 128;
#pragma unroll
    for (int itr = 0; itr < 2; ++itr) {
        const int idx = tid + 512 * itr, hd = idx >> 7, w = idx & 127, kvh = hd >> 2;
        const float* kr = ck + (w * 2 + kvh) * 64; const float* qr = qn + hd * 64;
        float s = 0.f;
#pragma unroll
        for (int d = 0; d < 64; d += 4) { const f32x4 kv = *(const f32x4*)(kr + d); s += qr[d] * kv[0] + qr[d + 1] * kv[1] + qr[d + 2] * kv[2] + qr[d + 3] * kv[3]; }
        scs[hd * 132 + w] = s * 0.125f;
    }
    if (tid < 8) { const int kvh = tid >> 2; float s = 0.f; for (int d = 0; d < 64; ++d) s += qn[tid * 64 + d] * kn[kvh * 64 + d]; scs[tid * 132 + 128] = s * 0.125f; }
    __syncthreads();
    {
        const float sink = p.att_sinks[wid];
        const float s0 = scs[wid * 132 + lane], s1 = scs[wid * 132 + 64 + lane], s2 = lane == 0 ? scs[wid * 132 + 128] : -INFINITY;
        float mx = fmaxf(fmaxf(s0, s1), fmaxf(s2, sink));
#pragma unroll
        for (int o = 32; o >= 1; o >>= 1) mx = fmaxf(mx, __shfl_xor(mx, o));
        const float e0 = __expf(s0 - mx), e1 = __expf(s1 - mx), e2 = lane == 0 ? __expf(s2 - mx) : 0.f;
        float sum = e0 + e1 + e2;
#pragma unroll
        for (int o = 32; o >= 1; o >>= 1) sum += __shfl_xor(sum, o);
        const float inv = 1.f / (sum + __expf(sink - mx));
        scs[wid * 132 + lane] = e0 * inv; scs[wid * 132 + 64 + lane] = e1 * inv; if (lane == 0) scs[wid * 132 + 128] = e2 * inv;
    }
    __syncthreads();
    {
        const int hd = tid >> 6, d = tid & 63, kvh = hd >> 2;
        float o = scs[hd * 132 + 128] * vn[kvh * 64 + d];
#pragma unroll 16
        for (int w = 0; w < 128; ++w) o += scs[hd * 132 + w] * cv[(w * 2 + kvh) * 64 + d];
        mixrow[hd * 64 + d] = f2bf(o);
    }
    for (int i = tid; i < 127 * 32; i += 512) {
        *(f32x4*)(p.out + O_KS + (size_t)b * 16384 + i * 4) = *(const f32x4*)(ck + 128 + i * 4);
        *(f32x4*)(p.out + O_VS + (size_t)b * 16384 + i * 4) = *(const f32x4*)(cv + 128 + i * 4);
    }
    __syncthreads();
}
__device__ __forceinline__ void sample_ret(const Params& p, unsigned char* shm, int item) {
    const int tid = threadIdx.x, b = item >> 2, h = item & 3;
    const bf16_t* zrow = (const bf16_t*)(p.ws + WS_Z) + (size_t)(TP + b) * INW; bf16_t* mixrow = (bf16_t*)(p.ws + WS_MIX) + (size_t)(TP + b) * DM;
    float* sm = (float*)shm;
    float* rqn = sm;
    float* rkn = rqn + 128;
    float* red = rkn + 128;
    float* qkp = red + 512;
    float* ov = qkp + 4;
    if (tid < 128) { const int dn = ret_dim(tid); rqn[dn] = bf2f(zrow[768 + h * 128 + tid]); rkn[dn] = bf2f(zrow[1280 + h * 128 + tid]); }
    __syncthreads();
    const float gm = __expf(log_gamma(h));
    const int e = tid & 127, dq = tid >> 7;
    const float* sp = p.state_ret + ((size_t)(b * 4 + h) * 128 + dq * 32) * 128 + e;
    float* so = p.out + O_RS + ((size_t)(b * 4 + h) * 128 + dq * 32) * 128 + e;
    const float ve = bf2f(zrow[1792 + h * 128 + e]);
    float sv[32];
#pragma unroll
    for (int d = 0; d < 32; ++d) sv[d] = sp[d * 128];
    float part = 0.f, qk = 0.f;
#pragma unroll
    for (int d = 0; d < 32; ++d) { const float qd = rqn[dq * 32 + d], kd = rkn[dq * 32 + d]; part += qd * sv[d]; qk += qd * kd; so[d * 128] = gm * sv[d] + kd * ve; }
    red[dq * 128 + e] = part; if (e == 0) qkp[dq] = qk;
    __syncthreads();
    if (tid < 128) ov[tid] = (qkp[0] + qkp[1] + qkp[2] + qkp[3]) * ve + gm * (red[e] + red[128 + e] + red[256 + e] + red[384 + e]);
    __syncthreads();
    if (tid < 64) {
        const float o0 = ov[tid], o1 = ov[tid + 64];
        float sum = o0 + o1;
#pragma unroll
        for (int o = 32; o >= 1; o >>= 1) sum += __shfl_xor(sum, o);
        const float mu = sum * (1.f / 128.f);
        float vs = (o0 - mu) * (o0 - mu) + (o1 - mu) * (o1 - mu);
#pragma unroll
        for (int o = 32; o >= 1; o >>= 1) vs += __shfl_xor(vs, o);
        const float rstd = rsqrtf(vs * (1.f / 128.f) + 1e-6f);
#pragma unroll
        for (int k = 0; k < 2; ++k) { const int ee = tid + 64 * k; const float gz = bf2f(zrow[2304 + h * 128 + ee]);
            mixrow[512 + h * 128 + ee] = f2bf(((k ? o1 : o0) - mu) * rstd * p.ret_gn_w[h * 128 + ee] * silu_f(gz)); }
    }
    __syncthreads();
}

template <int NB>
__device__ __forceinline__ void sg_mma(const bf16_t* arow, const bf16_t* b0, const bf16_t* b1, int K, f32x4& acc0, f32x4& acc1) {
#pragma unroll 8
    for (int k = 0; k < K; k += 32) {
        const bf16x8 a = *(const bf16x8*)(arow + k);
        const bf16x8 w0 = *(const bf16x8*)(b0 + k);
        acc0 = __builtin_amdgcn_mfma_f32_16x16x32_bf16(w0, a, acc0, 0, 0, 0);
        if (NB == 2) { const bf16x8 w1 = *(const bf16x8*)(b1 + k); acc1 = __builtin_amdgcn_mfma_f32_16x16x32_bf16(w1, a, acc1, 0, 0, 0); }
    }
}
__device__ __forceinline__ void sg_ln(const Params& p, int item, const bf16_t* A, const bf16_t* Bt, int K, const float* base, int gate_off, float* stat, unsigned* cnt,
                                      const float* lw, const float* lb, bf16_t* H, int h_off) {
    const int tid = threadIdx.x, wid = tid >> 6, lane = tid & 63, lr = lane & 15, g = lane >> 4;
    const int n0 = item * 16, m = 16 * wid + lr;
    f32x4 acc = (f32x4){0.f, 0.f, 0.f, 0.f}, dummy = acc;
    sg_mma<1>(A + (size_t)(TP + m) * K + 8 * g, Bt + (size_t)(n0 + lr) * K + 8 * g, nullptr, K, acc, dummy);
    const int c = n0 + 4 * g;
    const float* mrow = (const float*)(p.ws + WS_MOD) + (size_t)m * 6144;
    const f32x4 xv = *(const f32x4*)(base + (size_t)m * DM + c), gv = *(const f32x4*)(mrow + gate_off + c);
    const f32x4 res = ALPHA * xv + (1.f + gv) * acc;
    float s = res[0] + res[1] + res[2] + res[3], ss = res[0] * res[0] + res[1] * res[1] + res[2] * res[2] + res[3] * res[3];
    s += __shfl_xor(s, 16); ss += __shfl_xor(ss, 16); s += __shfl_xor(s, 32); ss += __shfl_xor(ss, 32);
    if (g == 0) { __hip_atomic_fetch_add(stat + 2 * (TP + m), s, __ATOMIC_RELAXED, __HIP_MEMORY_SCOPE_AGENT); __hip_atomic_fetch_add(stat + 2 * (TP + m) + 1, ss, __ATOMIC_RELAXED, __HIP_MEMORY_SCOPE_AGENT); }
    asm volatile("s_waitcnt vmcnt(0)" ::: "memory");
    unsigned* pc = cnt + wid * 16;
    if (lane == 0) __hip_atomic_fetch_add(pc, 1u, __ATOMIC_RELAXED, __HIP_MEMORY_SCOPE_AGENT);
    wait_ge(pc, 64u, (unsigned*)(p.ws + WS_CNT) + 527 * 16 + 8);
    asm volatile("" ::: "memory");
    const float sa = __hip_atomic_load(stat + 2 * (TP + m), __ATOMIC_RELAXED, __HIP_MEMORY_SCOPE_AGENT), sb = __hip_atomic_load(stat + 2 * (TP + m) + 1, __ATOMIC_RELAXED, __HIP_MEMORY_SCOPE_AGENT);
    const float mu = sa * (1.f / 1024.f), var = sb * (1.f / 1024.f) - mu * mu, rstd = rsqrtf(fmaxf(var, 0.f) + 1e-5f);
    const f32x4 y = (res - mu) * rstd * *(const f32x4*)(lw + c) + *(const f32x4*)(lb + c);
    *(f32x4*)(p.out + O_YS + (size_t)m * DM + c) = y;
    if (H) { const f32x4 hv = y * (1.f + *(const f32x4*)(mrow + h_off + 1024 + c)) + *(const f32x4*)(mrow + h_off + c);
             u32x2 o; o[0] = cvt_pk_bf16(hv[0], hv[1]); o[1] = cvt_pk_bf16(hv[2], hv[3]); *(u32x2*)(H + (size_t)(TP + m) * DM + c) = o; }
}
__device__ __forceinline__ void sg_up(const Params& p, int item) {
    const int tid = threadIdx.x, wid = tid >> 6, lane = tid & 63, lr = lane & 15, g = lane >> 4;
    const int n0 = item * 16, m = 16 * wid + lr, pn = n0 >> 7, off = n0 & 127;
    const bf16_t* A = (const bf16_t*)(p.ws + WS_H); const bf16_t* Bt = (const bf16_t*)(p.ws + WS_WUP);
    f32x4 ag = (f32x4){0.f, 0.f, 0.f, 0.f}, au = ag;
    sg_mma<2>(A + (size_t)(TP + m) * DM + 8 * g, Bt + (size_t)(256 * pn + off + lr) * DM + 8 * g, Bt + (size_t)(256 * pn + 128 + off + lr) * DM + 8 * g, DM, ag, au);
    u32x2 o; o[0] = cvt_pk_bf16(silu_f(ag[0]) * au[0], silu_f(ag[1]) * au[1]); o[1] = cvt_pk_bf16(silu_f(ag[2]) * au[2], silu_f(ag[3]) * au[3]);
    *(u32x2*)((bf16_t*)(p.ws + WS_Z) + (size_t)(TP + m) * DFF + n0 + 4 * g) = o;
}

#define XB_TMO      128
#define XB_XCNT(j)  (256  + 64 * (j))
#define XB_XSUB(j)  (1280 + 64 * (j))
#define XB_XGEN(j)  (2304 + 64 * (j))
#define XB_TOP      3328
#define XB_TOPGEN   3392
#define XCD_BAR_WORDS 3456
#define XB_SPIN_CAP (1u << 18)
__device__ __forceinline__ unsigned xb_ld(unsigned* p)              { return __hip_atomic_load(p, __ATOMIC_RELAXED, __HIP_MEMORY_SCOPE_AGENT); }
__device__ __forceinline__ unsigned xb_add(unsigned* p, unsigned v) { return __hip_atomic_fetch_add(p, v, __ATOMIC_RELAXED, __HIP_MEMORY_SCOPE_AGENT); }
__device__ __forceinline__ unsigned xb_xcc_id() { return (unsigned)__builtin_amdgcn_s_getreg((3 << 11) | 20) & 0xFu; }
#define XB_SPIN(cond, bar) do { unsigned _sp = 0; while (cond) { __builtin_amdgcn_s_sleep(1); \
    if ((++_sp & 255u) == 0u) { if (xb_ld(&(bar)[XB_TMO])) break; if (_sp > XB_SPIN_CAP) { atomicAdd(&(bar)[XB_TMO], 1u); break; } } } } while (0)
struct XcdBarrier { unsigned* bar; unsigned x; volatile LAS unsigned* st; };
__device__ __forceinline__ XcdBarrier xcd_barrier_post(unsigned* bar, volatile LAS unsigned* st) {
    XcdBarrier b; b.bar = bar; b.x = xb_xcc_id(); b.st = st;
    if (threadIdx.x == 0) (void)xb_add(&bar[XB_XCNT(b.x)], 1u);
    return b;
}
__device__ __forceinline__ void xcd_barrier_complete(unsigned* bar, unsigned x, unsigned& nloc, unsigned& nx) {
    const unsigned G = gridDim.x * gridDim.y * gridDim.z;
    unsigned sum, cnt, mine, sp = 0u;
    for (;;) {
        sum = 0u; cnt = 0u; mine = 0u;
#pragma unroll
        for (unsigned j = 0; j < 16; ++j) { const unsigned c = xb_ld(&bar[XB_XCNT(j)]); sum += c; cnt += (c > 0u) ? 1u : 0u; mine = (j == x) ? c : mine; }
        if (sum == G) break;
        __builtin_amdgcn_s_sleep(1);
        if ((++sp & 255u) == 0u) { if (xb_ld(&bar[XB_TMO])) break; if (sp > XB_SPIN_CAP) { atomicAdd(&bar[XB_TMO], 1u); break; } }
    }
    nloc = mine > 0u ? mine : 1u; nx = cnt > 0u ? cnt : 1u;
}
__device__ __forceinline__ void xcd_barrier(const XcdBarrier& b) {
    asm volatile("s_waitcnt vmcnt(0)" ::: "memory");
    __syncthreads();
    if (threadIdx.x == 0) {
        unsigned* bar = b.bar;
        __builtin_amdgcn_s_waitcnt(0);
        unsigned nloc = b.st[0], nx = b.st[1];
        if (nloc == 0u) { xcd_barrier_complete(bar, b.x, nloc, nx); b.st[0] = nloc; b.st[1] = nx; }
        const unsigned old = xb_add(&bar[XB_XSUB(b.x)], 1u);
        const unsigned gen = old / nloc;
        if (old + 1u == (gen + 1u) * nloc) {
            __builtin_amdgcn_fence(__ATOMIC_RELEASE, "agent");
            asm volatile("s_waitcnt vmcnt(0)" ::: "memory");
            const unsigned og = xb_add(&bar[XB_TOP], 1u);
            const unsigned tg = og / nx;
            if (og + 1u == (tg + 1u) * nx) xb_add(&bar[XB_TOPGEN], 1u);
            else XB_SPIN(xb_ld(&bar[XB_TOPGEN]) == tg, bar);
            __builtin_amdgcn_fence(__ATOMIC_ACQUIRE, "agent");
            xb_add(&bar[XB_XGEN(b.x)], 1u);
            asm volatile("s_waitcnt vmcnt(0)" ::: "memory");
        } else {
            XB_SPIN(xb_ld(&bar[XB_XGEN(b.x)]) == gen, bar);
            __builtin_amdgcn_fence(__ATOMIC_ACQUIRE, "agent");
            asm volatile("s_waitcnt vmcnt(0)" ::: "memory");
        }
    }
    __syncthreads();
}

typedef __attribute__((address_space(4))) const unsigned char* kptr_t;
__device__ __forceinline__ Params load_params() {
#if defined(__HIP_DEVICE_COMPILE__)
    kptr_t k = (kptr_t)__builtin_amdgcn_kernarg_segment_ptr();
    asm volatile("" : "+s"(k));
    Params r;
    __builtin_memcpy(&r, (const __attribute__((address_space(4))) void*)k, sizeof(Params));
    return r;
#else
    return Params{};
#endif
}
__global__ void __launch_bounds__(512, 2) fwd(Params p_arg, int ph_lo, int ph_hi, int coop) {
    extern __shared__ __attribute__((aligned(16))) unsigned char shm[];
    cg::grid_group grid = cg::this_grid();
    LAS unsigned char* lds = (LAS unsigned char*)shm;
    const int G = gridDim.x, bid = blockIdx.x;
    volatile LAS unsigned* bst = (volatile LAS unsigned*)(lds + 131072);
    if (threadIdx.x < 4) bst[threadIdx.x] = 0u;
    __syncthreads();
    (void)xcd_barrier_post((unsigned*)(p_arg.ws + WS_BAR), bst);
    if (coop > 1) grid.sync();
#define GSYNC() do { XcdBarrier xb_; xb_.bar = (unsigned*)(load_params().ws + WS_BAR); xb_.x = xb_xcc_id(); xb_.st = (volatile LAS unsigned*)((LAS unsigned char*)shm + 131072); xcd_barrier(xb_); } while (0)
#ifndef ONLY
#define ONLY -1
#endif
#ifndef REP_PH
#define REP_PH -1
#endif
#ifndef REP_SYNC
#define REP_SYNC 0
#endif
#define PH_BEGIN(n) if ((ONLY < 0 || ONLY == n) && ph_lo <= n && n < ph_hi) { if (n > ph_lo && coop) GSYNC(); for (int rep_ = 0; rep_ < (REP_PH == n ? 2 : 1); ++rep_) { if (rep_) GSYNC(); const Params p = load_params();
#define PH_END } }
    for (int i_ = 0; i_ < REP_SYNC; ++i_) GSYNC();
    PH_BEGIN(0) { prep_tiles(p, shm, 768 + bid, 1152, G); prep_misc(p); } PH_END
    PH_BEGIN(1) { if (bid >= 24) prep_tiles(p, shm, bid - 24, 768, G - 24);
                  pg8::Gemm g{(const bf16_t*)(p.ws + WS_SC), (const bf16_t*)(p.ws + WS_WADA), 256, 6144, DM}; pg8::StaticOrder S; S.init(g.M, g.N, G, bid);
                  EpiAda E{(float*)(p.ws + WS_MOD), p.b_ada_mix, p.b_ada_ffn}; pg8::gemm_phase(lds, g, S, E); } PH_END
    PH_BEGIN(2) phase_modulate(p); PH_END
    PH_BEGIN(3) { pg8::Gemm g{(const bf16_t*)(p.ws + WS_H), (const bf16_t*)(p.ws + WS_WIN), TPAD, INW, DM}; pg8::StaticOrder S; S.init(g.M, g.N, G, bid);
                  EpiIn E{(bf16_t*)(p.ws + WS_Z), (const float*)(p.ws + WS_ROPEA), (const float*)(p.ws + WS_ROPER), p.out}; pg8::gemm_phase(lds, g, S, E); } PH_END
    PH_BEGIN(4) { for (int it = bid; it < 1024; it += G) retu_item(p, shm, it); for (int it = bid; it < 512; it += G) attn_item(p, shm, it); for (int it = G - 1 - bid; it < 512; it += G) sample_ret(p, shm, it); for (int it = bid; it < 128; it += G) sample_att(p, shm, it); } PH_END
    PH_BEGIN(5) phase_scan(p); PH_END
    PH_BEGIN(6) for (int it = bid; it < 1024; it += G) reto_item(p, shm, it); PH_END
    PH_BEGIN(7) { for (int it = G - 1 - bid; it < 64; it += G) sg_ln(p, it, (const bf16_t*)(p.ws + WS_MIX), (const bf16_t*)(p.ws + WS_WOUT), DM, p.x_sample, 2048, (float*)(p.ws + WS_STAT1),
                                                                       (unsigned*)(p.ws + WS_CNT) + 512 * 16, p.ln1_w, p.ln1_b, (bf16_t*)(p.ws + WS_H), 3072);
                  pg8::Gemm g{(const bf16_t*)(p.ws + WS_MIX), (const bf16_t*)(p.ws + WS_WOUT), TP, DM, DM}; pg8::StaticOrder S; S.init(g.M, g.N, G, bid);
                  EpiLn<false, true> E{p.x_prompt, p.ws + WS_MIX, (const float*)(p.ws + WS_MOD), 2048, (float*)(p.ws + WS_STAT1), (unsigned*)(p.ws + WS_CNT), p.ln1_w, p.ln1_b, (bf16_t*)(p.ws + WS_H), 3072, (unsigned*)(p.ws + WS_CNT) + 527 * 16 + 8};
                  pg8::gemm_phase(lds, g, S, E); } PH_END
    PH_BEGIN(9) { for (int it = G - 1 - bid; it < 176; it += G) sg_up(p, it);
                  pg8::Gemm g{(const bf16_t*)(p.ws + WS_H), (const bf16_t*)(p.ws + WS_WUP), TP, 2 * DFF, DM}; pg8::StaticOrder S; S.init(g.M, g.N, G, bid);
                  EpiUp E{(bf16_t*)(p.ws + WS_Z)}; pg8::gemm_phase(lds, g, S, E); } PH_END
    PH_BEGIN(10) { for (int it = G - 1 - bid; it < 64; it += G) sg_ln(p, it, (const bf16_t*)(p.ws + WS_Z), (const bf16_t*)(p.ws + WS_WDOWN), DFF, p.out + O_YS, 3072 + 2048, (float*)(p.ws + WS_STAT2),
                                                                        (unsigned*)(p.ws + WS_CNT) + 520 * 16, p.ln2_w, p.ln2_b, nullptr, 0);
                   pg8::Gemm g{(const bf16_t*)(p.ws + WS_Z), (const bf16_t*)(p.ws + WS_WDOWN), TP, DM, DFF}; pg8::StaticOrder S; S.init(g.M, g.N, G, bid);
                   EpiLn<true, false> E{p.ws + WS_MIX, p.out, (const float*)(p.ws + WS_MOD), 3072 + 2048, (float*)(p.ws + WS_STAT2), (unsigned*)(p.ws + WS_CNT) + 256 * 16, p.ln2_w, p.ln2_b, nullptr, 0, (unsigned*)(p.ws + WS_CNT) + 527 * 16 + 8};
                   pg8::gemm_phase(lds, g, S, E); } PH_END
}

extern "C" void kernel_launch(void* const* d_in, const int* in_sizes, int n_in, void* d_out, int out_size, void* d_ws, size_t ws_size, hipStream_t stream) {
    constexpr int LDS_BYTES = 131072 + 64;
    static int grid = 0;
    if (!grid) {
        int dev = 0, cus = 0, per_cu = 0;
        (void)hipGetDevice(&dev);
        (void)hipDeviceGetAttribute(&cus, hipDeviceAttributeMultiprocessorCount, dev);
        (void)hipFuncSetAttribute((const void*)fwd, hipFuncAttributeMaxDynamicSharedMemorySize, LDS_BYTES);
        (void)hipOccupancyMaxActiveBlocksPerMultiprocessor(&per_cu, (const void*)fwd, 512, LDS_BYTES);
        grid = cus > 0 ? cus : 256;
        if (ws_size < WS_END) fprintf(stderr, "kernel_launch: workspace too small: %zu < %zu\n", ws_size, (size_t)WS_END);
        fprintf(stderr, "kernel_launch: cus %d per_cu %d grid %d ws %zu need %zu\n", cus, per_cu, grid, ws_size, (size_t)WS_END);
    }
    Params p{};
    const float** f = (const float**)&p;
    for (int i = 0; i < 21; ++i) f[i] = (const float*)d_in[i];
    p.out = (float*)d_out; p.ws = (unsigned char*)d_ws;
#ifndef MULTI_LAUNCH
    (void)hipMemsetAsync((unsigned char*)d_ws + WS_BAR, 0, 16384, stream);
    int lo = 0, hi = 12, coop = 1;
    void* args[] = {&p, &lo, &hi, &coop};
    hipError_t e = hipLaunchCooperativeKernel((const void*)fwd, dim3(grid), dim3(512), args, LDS_BYTES, stream);
    if (e != hipSuccess) fprintf(stderr, "cooperative launch failed: %s (grid %d)\n", hipGetErrorString(e), grid);
#else
    for (int ph = 0; ph < 12; ++ph) hipLaunchKernelGGL(fwd, dim3(grid), dim3(512), LDS_BYTES, stream, p, ph, ph + 1, 0);
#endif
}
```

```cpp
#include <hip/hip_runtime.h>
#include <hip/hip_cooperative_groups.h>
#include <cstdio>
namespace cg = cooperative_groups;

#define LAS __attribute__((address_space(3)))
typedef unsigned short bf16_t;
typedef short bf16x8 __attribute__((ext_vector_type(8)));
typedef float f32x4 __attribute__((ext_vector_type(4)));
typedef unsigned u32x4 __attribute__((ext_vector_type(4)));
typedef unsigned u32x2 __attribute__((ext_vector_type(2)));

constexpr int DM = 1024, SEQ = 4096, NBATCH = 8, TP = NBATCH * SEQ  , NS = 128, TV = TP + NS  , TPAD = TP + 256  ;
constexpr int INW = 2816, DFF = 2816, PAST = 16384;
constexpr float ALPHA = 1.189207115002721f;
constexpr float RK_SCALE = 0.08838834764831845f;
constexpr size_t O_YP = 0, O_YS = (size_t)TP * DM, O_KP = O_YS + (size_t)NS * DM, O_VP = O_KP + 131072, O_RP = O_VP + 131072,
                 O_KS = O_RP + 524288, O_VS = O_KS + 2097152, O_RS = O_VS + 2097152;
constexpr size_t al256(size_t x) { return (x + 255) & ~(size_t)255; }
constexpr size_t WS_WIN = 0;
constexpr size_t WS_WOUT = WS_WIN + (size_t)INW * DM * 2;
constexpr size_t WS_WUP = WS_WOUT + (size_t)DM * DM * 2;
constexpr size_t WS_WDOWN = WS_WUP + (size_t)2 * DFF * DM * 2;
constexpr size_t WS_WADA = WS_WDOWN + (size_t)DM * DFF * 2;
constexpr size_t WS_SC = WS_WADA + (size_t)6144 * DM * 2;
constexpr size_t WS_MOD = WS_SC + (size_t)256 * DM * 2;
constexpr size_t WS_ROPEA = WS_MOD + (size_t)256 * 6144 * 4;
constexpr size_t WS_ROPER = al256(WS_ROPEA + (size_t)4097 * 16 * 4);
constexpr size_t WS_STAT1 = al256(WS_ROPER + (size_t)4097 * 128 * 4);
constexpr size_t WS_STAT2 = WS_STAT1 + (size_t)TPAD * 2 * 4;
constexpr size_t WS_H = al256(WS_STAT2 + (size_t)TPAD * 2 * 4);
constexpr size_t WS_Z = WS_H + (size_t)TPAD * DM * 2;
constexpr size_t WS_MIX = WS_Z + (size_t)TPAD * INW * 2;
constexpr size_t WS_SST = WS_MIX + (size_t)TPAD * DM * 2;
constexpr size_t WS_BAR = WS_SST + (size_t)1024 * 16384 * 2;
constexpr size_t WS_CNT = WS_BAR + 16384;
constexpr size_t WS_END = WS_CNT + 528 * 64;

struct Params {
    const float *x_prompt, *x_sample, *c_prompt, *c_sample, *cache_k, *cache_v, *state_ret, *w_ada_mix, *b_ada_mix, *w_in, *att_sinks, *ret_gn_w, *w_out,
        *ln1_w, *ln1_b, *w_ada_ffn, *b_ada_ffn, *w_up, *w_down, *ln2_w, *ln2_b;
    float* out; unsigned char* ws;
};

__device__ __forceinline__ unsigned cvt_pk_bf16(float lo, float hi) { unsigned r; asm volatile("v_cvt_pk_bf16_f32 %0, %1, %2" : "=v"(r) : "v"(lo), "v"(hi)); return r; }
__device__ __forceinline__ float bf2f(bf16_t b) { return __uint_as_float(((unsigned)b) << 16); }
__device__ __forceinline__ bf16_t f2bf(float f) { return (bf16_t)(cvt_pk_bf16(f, 0.f) & 0xffffu); }
__device__ __forceinline__ float bflo(unsigned u) { return __uint_as_float(u << 16); }
__device__ __forceinline__ float bfhi(unsigned u) { return __uint_as_float(u & 0xffff0000u); }
__device__ __forceinline__ float silu_f(float v) { return v * __builtin_amdgcn_rcpf(1.f + __expf(-v)); }
__device__ __forceinline__ float log_gamma(int h) {
    return h == 0 ? -0.0317486983145803f : (h == 1 ? -0.012479111952334388f : (h == 2 ? -0.004933717393740471f : -0.0019550348358033506f));
}
__device__ __forceinline__ int att_dim(int p) { if (p >= 16) return p; const int g = p >> 3, j = p & 7; return j < 4 ? 4 * g + j : 8 + 4 * g + (j - 4); }
__device__ __forceinline__ int ret_dim(int p) { const int g = p >> 3, j = p & 7; return j < 4 ? 4 * g + j : 64 + 4 * g + (j - 4); }
__device__ __forceinline__ int in_col(int P) {
    if (P < 640) return (P & ~63) + att_dim(P & 63);
    if (P >= 768 && P < 1792) { const int p = (P - 768) & 127; return P - p + ret_dim(p); }
    return P;
}
__device__ __forceinline__ int up_col(int P) { const int pn = P >> 8, q = P & 255; return q < 128 ? pn * 128 + q : DFF + pn * 128 + (q - 128); }

namespace pg8 {
constexpr int BM = 256, BK = 64, HALF = 128, HTB = HALF * BK * 2, STAGE_BYTES = 8 * HTB, NXCD = 8, WGM = 8;
__device__ __forceinline__ int lds_byte(int r, int c) { const int st = (r >> 4) * 2 + (c >> 5), rr = r & 15, cc = c & 31, ob = rr * 64 + cc * 2; return st * 1024 + (ob ^ (((ob >> 9) & 1) << 5)); }
__device__ __forceinline__ void stage_rc(int b, int& R, int& C) { const int st = b / 1024, sb = b % 1024, swz = sb ^ (((sb >> 9) & 1) << 5); R = (st >> 1) * 16 + swz / 64; C = (st & 1) * 32 + (swz % 64) / 2; }
__device__ __forceinline__ int perm32(int rho) { const int n = rho >> 4, i = rho & 15; return 8 * (i >> 2) + 4 * n + (i & 3); }
struct Unit { int pm, pn; };
struct Gemm { const bf16_t* A; const bf16_t* Bt; int M, N, K; };
struct StaticOrder {
    int nM, nN, nwg, G, c;
    __device__ void init(int M, int N, int G_, int c_) { nM = M / BM; nN = N / BM; nwg = nM * nN; G = G_; c = c_; }
    __device__ bool next(int i, Unit& u) const {
        const long L = (long)i * G + c; if (L >= nwg) return false;
        int wgid = (int)L; { const int q = nwg / NXCD, r = nwg % NXCD, xcd = wgid % NXCD, off = wgid / NXCD; wgid = (xcd < r ? xcd * (q + 1) : r * (q + 1) + (xcd - r) * q) + off; }
        const int nig = WGM * nN, gid = wgid / nig, fm = gid * WGM, gsz = (nM - fm) < WGM ? (nM - fm) : WGM;
        u.pm = fm + ((wgid % nig) % gsz); u.pn = (wgid % nig) / gsz; return true;
    }
};

template <class Epi, class Sched>
__device__ __forceinline__ void gemm_phase(LAS unsigned char* lds, const Gemm g, const Sched& S, const Epi& E) {
    const int tid = threadIdx.x, wid = __builtin_amdgcn_readfirstlane(tid >> 6), lane = tid & 63, wr = wid >> 2, wc = wid & 3, fr = lane & 15, fq = lane >> 4;
    const int K = g.K, nt = K / BK;
    unsigned voffA[2], voffB[2];
#pragma unroll
    for (int i = 0; i < 2; ++i) { int R, C; stage_rc(tid * 16 + i * 8192, R, C); const int Rb = Epi::PERM ? ((R & ~31) + perm32(R & 31)) : R;
        voffA[i] = (unsigned)(R * K + C) * 2u; voffB[i] = (unsigned)(Rb * K + C) * 2u; }
    const size_t kstep = (size_t)(BK * 2);
    const size_t hstep = (size_t)HALF * K * 2;
    const size_t tstep = 2 * hstep;
    const unsigned ldsw = (unsigned)wid * 1024u;
    const int aoff = lds_byte(wr * 64 + fr, fq * 8), boff = lds_byte(wc * 32 + fr, fq * 8);
#define PG8_SA(b, h) (((b) * 2 + (h)) * HTB)
#define PG8_SB(b, h) ((4 + (b) * 2 + (h)) * HTB)
#define PG8_STAGE(bufoff, gbase, voff) do { _Pragma("unroll") for (int _i = 0; _i < 2; ++_i) \
        __builtin_amdgcn_global_load_lds((const unsigned*)((const char*)(gbase) + (voff)[_i]), (LAS unsigned*)(lds + (bufoff) + ldsw + _i * 8192), 16, 0, 0); } while (0)
#define PG8_LDA(dst, b, h) do { _Pragma("unroll") for (int m = 0; m < 4; ++m) _Pragma("unroll") for (int k = 0; k < 2; ++k) dst[m][k] = *(const LAS bf16x8*)(lds + PG8_SA(b, h) + aoff + m * 2048 + k * 1024); } while (0)
#define PG8_LDB(dst, b, h) do { _Pragma("unroll") for (int n = 0; n < 2; ++n) _Pragma("unroll") for (int k = 0; k < 2; ++k) dst[n][k] = *(const LAS bf16x8*)(lds + PG8_SB(b, h) + boff + n * 2048 + k * 1024); } while (0)
#define PG8_MMA(ai, bj, At, Bt) do { __builtin_amdgcn_s_setprio(1); _Pragma("unroll") for (int m = 0; m < 4; ++m) _Pragma("unroll") for (int n = 0; n < 2; ++n) _Pragma("unroll") for (int k = 0; k < 2; ++k) \
        acc[ai][bj][m][n] = __builtin_amdgcn_mfma_f32_16x16x32_bf16(Bt[n][k], At[m][k], acc[ai][bj][m][n], 0, 0, 0); __builtin_amdgcn_s_setprio(0); } while (0)
#define PG8_WAIT_V(n) asm volatile("s_waitcnt vmcnt(" #n ")" ::: "memory")
#define PG8_WAIT_L(n) asm volatile("s_waitcnt lgkmcnt(" #n ")" ::: "memory")
#define PG8_BAR __builtin_amdgcn_s_barrier()
#define PG8_SCHED __builtin_amdgcn_sched_barrier(0)
    Unit cur, nxt; int ui = 0;
    if (!S.next(0, cur)) return;
    f32x4 acc[2][2][4][2];
#pragma unroll
    for (int a = 0; a < 2; ++a)
#pragma unroll
        for (int b = 0; b < 2; ++b)
#pragma unroll
            for (int m = 0; m < 4; ++m)
#pragma unroll
                for (int n = 0; n < 2; ++n) acc[a][b][m][n] = (f32x4){0.f, 0.f, 0.f, 0.f};
    bf16x8 At[4][2], B0[2][2], B1[2][2];
    const char* cA = (const char*)g.A + (size_t)cur.pm * tstep; const char* cB = (const char*)g.Bt + (size_t)cur.pn * tstep;
    PG8_STAGE(PG8_SB(0, 0), cB, voffB); PG8_STAGE(PG8_SA(0, 0), cA, voffA); PG8_STAGE(PG8_SB(0, 1), cB + hstep, voffB); PG8_STAGE(PG8_SA(0, 1), cA + hstep, voffA);
    if (wr == 1) PG8_BAR;
    PG8_WAIT_V(4); PG8_BAR;
    PG8_STAGE(PG8_SB(1, 0), cB + kstep, voffB); PG8_STAGE(PG8_SA(1, 0), cA + kstep, voffA); PG8_STAGE(PG8_SB(1, 1), cB + hstep + kstep, voffB);
    PG8_WAIT_V(6); PG8_BAR;
    for (;;) {
        const bool has_next = S.next(ui + 1, nxt);
        const char* nA = has_next ? (const char*)g.A + (size_t)nxt.pm * tstep : cA; const char* nB = has_next ? (const char*)g.Bt + (size_t)nxt.pn * tstep : cB;
        for (int t = 0; t < nt; t += 2) {
            const bool last = (t == nt - 2);
            const char* a1 = cA + (size_t)(t + 1) * kstep;
            const char* a2 = last ? nA : cA + (size_t)(t + 2) * kstep; const char* b2 = last ? nB : cB + (size_t)(t + 2) * kstep;
            const char* a3 = a2 + kstep; const char* b3 = b2 + kstep;
            PG8_LDB(B0, 0, 0); PG8_SCHED; PG8_LDA(At, 0, 0); PG8_STAGE(PG8_SA(1, 1), a1 + hstep, voffA);
            PG8_WAIT_L(8); PG8_BAR; PG8_WAIT_L(0); PG8_MMA(0, 0, At, B0); PG8_BAR; PG8_SCHED;
            PG8_LDB(B1, 0, 1); PG8_STAGE(PG8_SB(0, 0), b2, voffB);
            PG8_BAR; PG8_WAIT_L(0); PG8_MMA(0, 1, At, B1); PG8_BAR;
            PG8_LDA(At, 0, 1); PG8_STAGE(PG8_SA(0, 0), a2, voffA);
            PG8_BAR; PG8_WAIT_L(0); PG8_MMA(1, 0, At, B0); PG8_BAR; PG8_SCHED;
            PG8_STAGE(PG8_SB(0, 1), b2 + hstep, voffB);
            PG8_WAIT_V(6); PG8_BAR; PG8_MMA(1, 1, At, B1); PG8_BAR;
            PG8_LDB(B0, 1, 0); PG8_SCHED; PG8_LDA(At, 1, 0); PG8_STAGE(PG8_SA(0, 1), a2 + hstep, voffA);
            PG8_WAIT_L(8); PG8_BAR; PG8_WAIT_L(0); PG8_MMA(0, 0, At, B0); PG8_BAR; PG8_SCHED;
            PG8_LDB(B1, 1, 1); PG8_STAGE(PG8_SB(1, 0), b3, voffB);
            PG8_BAR; PG8_WAIT_L(0); PG8_MMA(0, 1, At, B1); PG8_BAR;
            PG8_LDA(At, 1, 1); PG8_STAGE(PG8_SA(1, 0), a3, voffA);
            PG8_BAR; PG8_WAIT_L(0); PG8_MMA(1, 0, At, B0); PG8_BAR; PG8_SCHED;
            PG8_STAGE(PG8_SB(1, 1), b3 + hstep, voffB);
            PG8_WAIT_V(6); PG8_BAR; PG8_MMA(1, 1, At, B1); PG8_BAR;
        }
        if constexpr (Epi::ALIGNED) { if (wr == 0) PG8_BAR; }
        E(acc, cur, wr, wc, fr, fq);
        if (!has_next) break;
#pragma unroll
        for (int a = 0; a < 2; ++a)
#pragma unroll
            for (int b = 0; b < 2; ++b)
#pragma unroll
                for (int m = 0; m < 4; ++m)
#pragma unroll
                    for (int n = 0; n < 2; ++n) acc[a][b][m][n] = (f32x4){0.f, 0.f, 0.f, 0.f};
        cur = nxt; cA = nA; cB = nB; ++ui;
        if constexpr (Epi::ALIGNED) { if (wr == 1) PG8_BAR; }
    }
    PG8_WAIT_V(0);
    if constexpr (!Epi::ALIGNED) { if (wr == 0) PG8_BAR; }
    PG8_BAR;
#undef PG8_SA
#undef PG8_SB
#undef PG8_STAGE
#undef PG8_LDA
#undef PG8_LDB
#undef PG8_MMA
#undef PG8_WAIT_V
#undef PG8_WAIT_L
#undef PG8_BAR
#undef PG8_SCHED
}
}
using pg8::Unit;

struct EpiAda {
    static constexpr bool PERM = false, ALIGNED = false;
    float* mod; const float* b_mix; const float* b_ffn;
    __device__ __forceinline__ void operator()(const f32x4 (&acc)[2][2][4][2], const Unit& u, int wr, int wc, int fr, int fq) const {
#pragma unroll
        for (int ai = 0; ai < 2; ++ai)
#pragma unroll
            for (int m = 0; m < 4; ++m) {
                const int r = u.pm * 256 + ai * 128 + wr * 64 + m * 16 + fr;
#pragma unroll
                for (int bj = 0; bj < 2; ++bj)
#pragma unroll
                    for (int n = 0; n < 2; ++n) {
                        const int c = u.pn * 256 + bj * 128 + wc * 32 + n * 16 + fq * 4;
                        const f32x4 bv = c < 3072 ? *(const f32x4*)(b_mix + c) : *(const f32x4*)(b_ffn + c - 3072);
                        *(f32x4*)(mod + (size_t)r * 6144 + c) = acc[ai][bj][m][n] + bv;
                    }
            }
    }
};

struct EpiIn {
    static constexpr bool PERM = true, ALIGNED = true;
    bf16_t* Z; const float* ropeA; const float* ropeR; float* out;
    __device__ __forceinline__ void operator()(const f32x4 (&acc)[2][2][4][2], const Unit& u, int wr, int wc, int fr, int fq) const {
        int region[2], cbv[2]; const float* tab[2]; int tstride[2], toff[2]; bool rot[2];
#pragma unroll
        for (int bj = 0; bj < 2; ++bj) {
            const int cb128 = u.pn * 256 + bj * 128;
            const int cb = cb128 + wc * 32 + fq * 8; cbv[bj] = cb;
            region[bj] = cb128 < 512 ? 0 : (cb128 < 640 ? 1 : (cb128 < 768 ? 2 : (cb128 < 1280 ? 3 : (cb128 < 1792 ? 4 : 5))));
            if (region[bj] <= 1) { const int p = cb & 63; rot[bj] = p < 16; tab[bj] = ropeA; tstride[bj] = 16; toff[bj] = 4 * (p >> 3); }
            else if (region[bj] == 3 || region[bj] == 4) { rot[bj] = true; tab[bj] = ropeR; tstride[bj] = 128; toff[bj] = 4 * ((cb & 127) >> 3); }
            else { rot[bj] = false; tab[bj] = ropeR; tstride[bj] = 128; toff[bj] = 0; }
        }
        f32x4 csn[2], snn[2];
        auto load_tab = [&](int k) {
            const int r0 = u.pm * 256 + (k >> 2) * 128 + wr * 64 + (k & 3) * 16;
            const int r = r0 + fr, pos = r < TP ? (r & 4095) : 4096;
#pragma unroll
            for (int bj = 0; bj < 2; ++bj) if (rot[bj] && r0 < TV) { const float* t = tab[bj] + pos * tstride[bj] + toff[bj]; csn[bj] = *(const f32x4*)t; snn[bj] = *(const f32x4*)(t + (tstride[bj] >> 1)); }
        };
        load_tab(0);
#pragma unroll
        for (int k = 0; k < 8; ++k) {
            const int ai = k >> 2, m = k & 3;
            const int r0 = u.pm * 256 + ai * 128 + wr * 64 + m * 16;
            const f32x4 cs0 = csn[0], cs1 = csn[1], sn0 = snn[0], sn1 = snn[1];
            if (k < 7) load_tab(k + 1);
            if (r0 >= TV) continue;
            const int r = r0 + fr;
            const int pos = r < TP ? (r & 4095) : 4096;
#pragma unroll
            for (int bj = 0; bj < 2; ++bj) {
                const int cb = cbv[bj];
                f32x4 v0 = acc[ai][bj][m][0], v1 = acc[ai][bj][m][1];
                if (rot[bj]) {
                    const f32x4 cs = bj ? cs1 : cs0, sn = bj ? sn1 : sn0;
                    f32x4 a = v0 * cs - v1 * sn, b = v1 * cs + v0 * sn;
                    if (region[bj] == 4) { a *= RK_SCALE; b *= RK_SCALE; }
                    v0 = a; v1 = b;
                }
                u32x4 pk; pk[0] = cvt_pk_bf16(v0[0], v0[1]); pk[1] = cvt_pk_bf16(v0[2], v0[3]); pk[2] = cvt_pk_bf16(v1[0], v1[1]); pk[3] = cvt_pk_bf16(v1[2], v1[3]);
                *(u32x4*)(Z + (size_t)r * INW + cb) = pk;
                if (region[bj] == 1 || region[bj] == 2) {
                    const int kvh = (cb >> 6) & 1, p = cb & 63;
                    int d0 = p, d1 = p + 4;
                    if (region[bj] == 1 && p < 16) { const int grp = p >> 3; d0 = 4 * grp; d1 = 8 + 4 * grp; }
                    float* dst = nullptr;
                    if (r < TP) { if (pos >= SEQ - 128) dst = out + (region[bj] == 1 ? O_KP : O_VP) + ((size_t)((r >> 12) * 128 + (pos - (SEQ - 128))) * 2 + kvh) * 64; }
                    else dst = out + (region[bj] == 1 ? O_KS : O_VS) + ((size_t)((r - TP) * 128 + 127) * 2 + kvh) * 64;
                    if (dst) { *(f32x4*)(dst + d0) = v0; *(f32x4*)(dst + d1) = v1; }
                }
            }
        }
    }
};

__device__ __forceinline__ void wait_ge(unsigned* pc, unsigned target, unsigned* tmo) {
    unsigned sp = 0;
    while (__hip_atomic_load(pc, __ATOMIC_RELAXED, __HIP_MEMORY_SCOPE_AGENT) < target) {
        __builtin_amdgcn_s_sleep(1);
        if ((++sp & 1023u) == 0u) { if (__hip_atomic_load(tmo, __ATOMIC_RELAXED, __HIP_MEMORY_SCOPE_AGENT) != 0u) break;
                                    if (sp > (1u << 21)) { __hip_atomic_store(tmo, 1u, __ATOMIC_RELAXED, __HIP_MEMORY_SCOPE_AGENT); break; } }
    }
}
template <bool BASE_BF16, bool OUT_BF16>
struct EpiLn {
    static constexpr bool PERM = false, ALIGNED = true;
    const void* base; void* Y; const float* mod; int gate_off; float* stat; unsigned* cnt; const float* lw; const float* lb; bf16_t* H; int h_off; unsigned* tmo;
    __device__ __forceinline__ void operator()(f32x4 (&acc)[2][2][4][2], const Unit& u, int wr, int wc, int fr, int fq) const {
        const float* mrow = mod + (size_t)(128 + (u.pm >> 4)) * 6144 + u.pn * 256;
        const size_t torg = (size_t)u.pm * 256 * DM + u.pn * 256;
        const float* tbf = (const float*)base + torg; const bf16_t* tbh = (const bf16_t*)base + torg; float* tyf = (float*)Y + torg; bf16_t* tyh = (bf16_t*)Y + torg; float* ts = stat + (size_t)u.pm * 512;
        const unsigned lo = (unsigned)((wr * 64 + fr) * DM + wc * 32 + fq * 4), lc = (unsigned)(wc * 32 + fq * 4), lrw = (unsigned)(wr * 64 + fr);
        f32x4 gv[2][2];
#pragma unroll
        for (int bj = 0; bj < 2; ++bj)
#pragma unroll
            for (int n = 0; n < 2; ++n) gv[bj][n] = 1.f + *(const f32x4*)(mrow + gate_off + lc + (bj * 128 + n * 16));
        float sv[8], ssv[8];
        unsigned lod[2] = {lo, lo};
#pragma unroll
        for (int k = 0; k < 8; ++k) {
            const int ai = k >> 2, m = k & 3;
            const unsigned lk = lod[k & 1];
            float s = 0.f, ss = 0.f;
#pragma unroll
            for (int bj = 0; bj < 2; ++bj)
#pragma unroll
                for (int n = 0; n < 2; ++n) {
                    f32x4 xv;
                    if constexpr (BASE_BF16) { const u32x2 xb = *(const u32x2*)(tbh + lk + ((ai * 128 + m * 16) * DM + bj * 128 + n * 16)); xv = (f32x4){bflo(xb[0]), bfhi(xb[0]), bflo(xb[1]), bfhi(xb[1])}; }
                    else xv = *(const f32x4*)(tbf + lk + ((ai * 128 + m * 16) * DM + bj * 128 + n * 16));
                    const f32x4 res = ALPHA * xv + gv[bj][n] * acc[ai][bj][m][n];
                    acc[ai][bj][m][n] = res;
                    s += res[0] + res[1] + res[2] + res[3];
                    ss += res[0] * res[0] + res[1] * res[1] + res[2] * res[2] + res[3] * res[3];
                }
            sv[k] = s; ssv[k] = ss;
            asm volatile("" : "+v"(lod[k & 1]) : "v"(s));
        }
#pragma unroll
        for (int k = 0; k < 8; ++k) {
            float s = sv[k], ss = ssv[k];
            s += __shfl_xor(s, 16); ss += __shfl_xor(ss, 16);
            s += __shfl_xor(s, 32); ss += __shfl_xor(ss, 32);
            if (fq == 0) { float* sp = ts + 2 * (lrw + (k >> 2) * 128 + (k & 3) * 16); __hip_atomic_fetch_add(sp, s, __ATOMIC_RELAXED, __HIP_MEMORY_SCOPE_AGENT); __hip_atomic_fetch_add(sp + 1, ss, __ATOMIC_RELAXED, __HIP_MEMORY_SCOPE_AGENT); }
        }
        asm volatile("s_waitcnt vmcnt(0)" ::: "memory");
        unsigned* pc = cnt + (u.pm * 2 + wr) * 16;
        if (fr + fq == 0) __hip_atomic_fetch_add(pc, 1u, __ATOMIC_RELAXED, __HIP_MEMORY_SCOPE_AGENT);
        wait_ge(pc, 16u, tmo);
        asm volatile("" ::: "memory");
        float sa8[8], sb8[8];
#pragma unroll
        for (int k = 0; k < 8; ++k) { const float* sp = ts + 2 * (lrw + (k >> 2) * 128 + (k & 3) * 16);
            sa8[k] = __hip_atomic_load(sp, __ATOMIC_RELAXED, __HIP_MEMORY_SCOPE_AGENT); sb8[k] = __hip_atomic_load(sp + 1, __ATOMIC_RELAXED, __HIP_MEMORY_SCOPE_AGENT); }
#pragma unroll
        for (int ai = 0; ai < 2; ++ai)
#pragma unroll
            for (int m = 0; m < 4; ++m) {
                const float sa = sa8[ai * 4 + m], sb = sb8[ai * 4 + m];
                const float mu = sa * (1.f / 1024.f), var = sb * (1.f / 1024.f) - mu * mu, rstd = rsqrtf(fmaxf(var, 0.f) + 1e-5f);
#pragma unroll
                for (int bj = 0; bj < 2; ++bj)
#pragma unroll
                    for (int n = 0; n < 2; ++n) {
                        const int co = bj * 128 + n * 16;
                        const f32x4 y = (acc[ai][bj][m][n] - mu) * rstd * *(const f32x4*)(lw + u.pn * 256 + lc + co) + *(const f32x4*)(lb + u.pn * 256 + lc + co);
                        if constexpr (OUT_BF16) { u32x2 yo; yo[0] = cvt_pk_bf16(y[0], y[1]); yo[1] = cvt_pk_bf16(y[2], y[3]); *(u32x2*)(tyh + lo + ((ai * 128 + m * 16) * DM + co)) = yo; }
                        else *(f32x4*)(tyf + lo + ((ai * 128 + m * 16) * DM + co)) = y;
                        if (H) { const f32x4 hv = y * (1.f + *(const f32x4*)(mrow + h_off + 1024 + lc + co)) + *(const f32x4*)(mrow + h_off + lc + co);
                                 u32x2 o; o[0] = cvt_pk_bf16(hv[0], hv[1]); o[1] = cvt_pk_bf16(hv[2], hv[3]); *(u32x2*)(H + torg + lo + ((ai * 128 + m * 16) * DM + co)) = o; }
                    }
            }
    }
};

struct EpiUp {
    static constexpr bool PERM = true, ALIGNED = true;
    bf16_t* F;
    __device__ __forceinline__ void operator()(const f32x4 (&acc)[2][2][4][2], const Unit& u, int wr, int wc, int fr, int fq) const {
#pragma unroll
        for (int ai = 0; ai < 2; ++ai)
#pragma unroll
            for (int m = 0; m < 4; ++m) {
                const int r0 = u.pm * 256 + ai * 128 + wr * 64 + m * 16;
                if (r0 >= TV) continue;
                const int r = r0 + fr;
                float f[8];
#pragma unroll
                for (int n = 0; n < 2; ++n)
#pragma unroll
                    for (int i = 0; i < 4; ++i) { const float g = acc[ai][0][m][n][i]; f[n * 4 + i] = silu_f(g) * acc[ai][1][m][n][i]; }
                u32x4 pk; pk[0] = cvt_pk_bf16(f[0], f[1]); pk[1] = cvt_pk_bf16(f[2], f[3]); pk[2] = cvt_pk_bf16(f[4], f[5]); pk[3] = cvt_pk_bf16(f[6], f[7]);
                *(u32x4*)(F + (size_t)r * DFF + u.pn * 128 + wc * 32 + fq * 8) = pk;
            }
    }
};

__device__ __forceinline__ void prep_tiles(const Params& p, unsigned char* shm, int tt0, int tt1, int stride) {
    const int tid = threadIdx.x;
    bf16_t* tile = (bf16_t*)shm;
    for (int tt = tt0; tt < tt1; tt += stride) {
        const float* src; bf16_t* dst; int ld, K, mode, t;
        if (tt < 176) { t = tt; src = p.w_in; ld = INW; K = DM; dst = (bf16_t*)(p.ws + WS_WIN); mode = 1; }
        else if (tt < 240) { t = tt - 176; src = p.w_out; ld = DM; K = DM; dst = (bf16_t*)(p.ws + WS_WOUT); mode = 0; }
        else if (tt < 592) { t = tt - 240; src = p.w_up; ld = 2 * DFF; K = DM; dst = (bf16_t*)(p.ws + WS_WUP); mode = 2; }
        else if (tt < 768) { t = tt - 592; src = p.w_down; ld = DM; K = DFF; dst = (bf16_t*)(p.ws + WS_WDOWN); mode = 0; }
        else if (tt < 960) { t = tt - 768; src = p.w_ada_mix; ld = 3072; K = DM; dst = (bf16_t*)(p.ws + WS_WADA); mode = 0; }
        else { t = tt - 960; src = p.w_ada_ffn; ld = 3072; K = DM; dst = (bf16_t*)(p.ws + WS_WADA) + (size_t)3072 * DM; mode = 0; }
        const int nkt = K / 256, rt = t / nkt, kt = t % nkt;
        const int P = rt * 64 + (tid & 63);
        const int L = mode == 1 ? in_col(P) : (mode == 2 ? up_col(P) : P);
        const float* sp = src + (size_t)(kt * 256 + (tid >> 6)) * ld + L;
#pragma unroll
        for (int i = 0; i < 32; ++i) tile[(tid & 63) * 264 + (tid >> 6) + 8 * i] = f2bf(sp[(size_t)(8 * i) * ld]);
        __syncthreads();
        { const int pr = tid >> 3, kc = tid & 7;
#pragma unroll
          for (int j = 0; j < 4; ++j) *(u32x4*)(dst + (size_t)(rt * 64 + pr) * K + kt * 256 + (kc + 8 * j) * 8) = *(const u32x4*)(tile + pr * 264 + (kc + 8 * j) * 8); }
        __syncthreads();
    }
}
__device__ __forceinline__ void prep_misc(const Params& p) {
    const int tid = threadIdx.x;
    const int gt = blockIdx.x * 512 + tid, gs = gridDim.x * 512;
    bf16_t* sc = (bf16_t*)(p.ws + WS_SC);
    for (int i = gt; i < 256 * DM; i += gs) { const int r = i >> 10, k = i & 1023; float v = 0.f; if (r < 128) v = silu_f(p.c_sample[r * DM + k]); else if (r < 136) v = silu_f(p.c_prompt[(r - 128) * DM + k]); sc[i] = f2bf(v); }
    float* st = (float*)(p.ws + WS_STAT1);
    for (int i = gt; i < TPAD * 4; i += gs) st[i] = 0.f;
    for (int i = gt; i < 528 * 16; i += gs) ((unsigned*)(p.ws + WS_CNT))[i] = 0u;
    float* ra = (float*)(p.ws + WS_ROPEA); float* rr = (float*)(p.ws + WS_ROPER);
    for (int i = gt; i < 4097 * 72; i += gs) {
        const int pos = i / 72, f = i % 72;
        const double pv = pos < 4096 ? (double)pos : (double)PAST;
        const double inv = f < 8 ? exp(-13.122363377404328 * (double)f / 8.0) : exp(-9.210340371976184 * (double)(f - 8) / 64.0);
        const double ang = pv * inv;
        const double kk = rint(ang * 0.15915494309189535);
        const float red = (float)(ang - kk * 6.283185307179586);
        const float cs = cosf(red), sn = sinf(red);
        if (f < 8) { ra[pos * 16 + f] = cs; ra[pos * 16 + 8 + f] = sn; } else { rr[pos * 128 + (f - 8)] = cs; rr[pos * 128 + 64 + (f - 8)] = sn; }
    }
}

__device__ __forceinline__ void phase_modulate(const Params& p) {
    const float* mod = (const float*)(p.ws + WS_MOD); bf16_t* H = (bf16_t*)(p.ws + WS_H);
    const int gt = blockIdx.x * 512 + threadIdx.x, gs = gridDim.x * 512;
    constexpr int NCH = TV * 128;
    for (int i0 = gt; i0 < NCH; i0 += 4 * gs) {
        f32x4 x0[4], x1[4];
#pragma unroll
        for (int u = 0; u < 4; ++u) { const int i = i0 + u * gs; if (i < NCH) { const int r = i >> 7, c = (i & 127) * 8;
            const float* xr = r < TP ? p.x_prompt + (size_t)r * DM : p.x_sample + (size_t)(r - TP) * DM;
            x0[u] = __builtin_nontemporal_load((const f32x4*)(xr + c)); x1[u] = __builtin_nontemporal_load((const f32x4*)(xr + c + 4)); } }
#pragma unroll
        for (int u = 0; u < 4; ++u) { const int i = i0 + u * gs; if (i < NCH) { const int r = i >> 7, c = (i & 127) * 8;
            const int mrow = r < TP ? 128 + (r >> 12) : r - TP;
            const float* sh = mod + (size_t)mrow * 6144; const float* scl = sh + 1024;
            const f32x4 h0 = x0[u] * (1.f + *(const f32x4*)(scl + c)) + *(const f32x4*)(sh + c), h1 = x1[u] * (1.f + *(const f32x4*)(scl + c + 4)) + *(const f32x4*)(sh + c + 4);
            u32x4 pk; pk[0] = cvt_pk_bf16(h0[0], h0[1]); pk[1] = cvt_pk_bf16(h0[2], h0[3]); pk[2] = cvt_pk_bf16(h1[0], h1[1]); pk[3] = cvt_pk_bf16(h1[2], h1[3]);
            *(u32x4*)(H + (size_t)r * DM + c) = pk; } }
    }
}

__device__ __forceinline__ void attn_item(const Params& p, unsigned char* shm, int item) {
    const int tid = threadIdx.x, wid = tid >> 6, lane = tid & 63, lr = lane & 15, g = lane >> 4;
    const int b = item >> 6, kvh = (item >> 5) & 1, n = item & 31;
    const bf16_t* Z = (const bf16_t*)(p.ws + WS_Z); bf16_t* MIX = (bf16_t*)(p.ws + WS_MIX);
    bf16_t* Ks = (bf16_t*)shm;
    bf16_t* VT = Ks + 256 * 72;
    {
        const int key = tid >> 1, hf = tid & 1;
        const bool valid = (n > 0) || (key >= 128);
        const size_t row = (size_t)b * SEQ + (size_t)(n - 1) * 128 + key;
        const bf16_t* kp = Z + row * INW + 512 + kvh * 64 + hf * 32; const bf16_t* vp = Z + row * INW + 640 + kvh * 64 + hf * 32;
#pragma unroll
        for (int c = 0; c < 4; ++c) {
            u32x4 kv = (u32x4){0u, 0u, 0u, 0u}, vv = (u32x4){0u, 0u, 0u, 0u};
            if (valid) { kv = *(const u32x4*)(kp + c * 8); vv = *(const u32x4*)(vp + c * 8); }
            *(u32x4*)(Ks + key * 72 + hf * 32 + c * 8) = kv;
#pragma unroll
            for (int e = 0; e < 4; ++e) { const int d = hf * 32 + c * 8 + 2 * e; VT[d * 264 + key] = (bf16_t)(vv[e] & 0xffffu); VT[(d + 1) * 264 + key] = (bf16_t)(vv[e] >> 16); }
        }
    }
    __syncthreads();
    for (int qt = 0; qt < 4; ++qt) {
        const int T = wid * 4 + qt, hq = T >> 3, tq = T & 7, t0 = tq * 16, head = kvh * 4 + hq;
        const size_t qrow = (size_t)b * SEQ + (size_t)n * 128 + t0 + lr;
        bf16x8 Qf[2];
#pragma unroll
        for (int kk = 0; kk < 2; ++kk) Qf[kk] = *(const bf16x8*)(Z + qrow * INW + head * 64 + kk * 32 + g * 8);
        const int kt0 = tq < 6 ? tq : 6;
        f32x4 S[10];
#pragma unroll
        for (int jt = 0; jt < 10; ++jt) {
            S[jt] = (f32x4){0.f, 0.f, 0.f, 0.f};
#pragma unroll
            for (int kk = 0; kk < 2; ++kk) {
                const bf16x8 Kf = *(const bf16x8*)(Ks + (16 * (kt0 + jt) + lr) * 72 + kk * 32 + g * 8);
                S[jt] = __builtin_amdgcn_mfma_f32_16x16x32_bf16(Kf, Qf[kk], S[jt], 0, 0, 0);
            }
        }
        const float sink = p.att_sinks[head];
        const int t = t0 + lr;
        float mx = sink;
#pragma unroll
        for (int jt = 0; jt < 10; ++jt)
#pragma unroll
            for (int r = 0; r < 4; ++r) {
                const int i = 16 * (kt0 + jt) + 4 * g + r, dist = 128 + t - i;
                const bool ok = dist >= 0 && dist <= 128 && (n > 0 || i >= 128);
                const float s = ok ? S[jt][r] * 0.125f : -INFINITY;
                S[jt][r] = s; mx = fmaxf(mx, s);
            }
        mx = fmaxf(mx, __shfl_xor(mx, 16)); mx = fmaxf(mx, __shfl_xor(mx, 32));
        float sum = 0.f;
#pragma unroll
        for (int jt = 0; jt < 10; ++jt)
#pragma unroll
            for (int r = 0; r < 4; ++r) { const float e = __expf(S[jt][r] - mx); S[jt][r] = e; sum += e; }
        sum += __shfl_xor(sum, 16); sum += __shfl_xor(sum, 32);
        const float inv = 1.f / (sum + __expf(sink - mx));
        f32x4 O[4];
#pragma unroll
        for (int dt = 0; dt < 4; ++dt) O[dt] = (f32x4){0.f, 0.f, 0.f, 0.f};
#pragma unroll
        for (int jp = 0; jp < 5; ++jp) {
            u32x4 pu; pu[0] = cvt_pk_bf16(S[2 * jp][0] * inv, S[2 * jp][1] * inv); pu[1] = cvt_pk_bf16(S[2 * jp][2] * inv, S[2 * jp][3] * inv);
            pu[2] = cvt_pk_bf16(S[2 * jp + 1][0] * inv, S[2 * jp + 1][1] * inv); pu[3] = cvt_pk_bf16(S[2 * jp + 1][2] * inv, S[2 * jp + 1][3] * inv);
            const bf16x8 Pf = __builtin_bit_cast(bf16x8, pu);
#pragma unroll
            for (int dt = 0; dt < 4; ++dt) {
                const bf16_t* vr = VT + (16 * dt + lr) * 264 + 16 * (kt0 + 2 * jp) + 4 * g;
                const u32x2 a0 = *(const u32x2*)vr, a1 = *(const u32x2*)(vr + 16);
                u32x4 au; au[0] = a0[0]; au[1] = a0[1]; au[2] = a1[0]; au[3] = a1[1];
                O[dt] = __builtin_amdgcn_mfma_f32_16x16x32_bf16(__builtin_bit_cast(bf16x8, au), Pf, O[dt], 0, 0, 0);
            }
        }
#pragma unroll
        for (int dt = 0; dt < 4; ++dt) {
            u32x2 o; o[0] = cvt_pk_bf16(O[dt][0], O[dt][1]); o[1] = cvt_pk_bf16(O[dt][2], O[dt][3]);
            *(u32x2*)(MIX + qrow * DM + head * 64 + 16 * dt + 4 * g) = o;
        }
    }
    __syncthreads();
}

__device__ __forceinline__ void retu_item(const Params& p, unsigned char* shm, int item) {
    const int tid = threadIdx.x, wid = tid >> 6, lane = tid & 63, lr = lane & 15, g = lane >> 4;
    const int b = item >> 7, h = (item >> 5) & 3, c = item & 31;
    const bf16_t* Z = (const bf16_t*)(p.ws + WS_Z); float* UT = (float*)(p.ws + WS_H);
    bf16_t* KT = (bf16_t*)shm;
    bf16_t* VT = KT + 128 * 136;
    const float lg = log_gamma(h);
    {
        const int j = tid >> 2, q = tid & 3;
        const size_t row = (size_t)b * SEQ + (size_t)c * 128 + j;
        const float dec = __expf(lg * (float)(127 - j));
        const bf16_t* kp = Z + row * INW + 1280 + h * 128 + q * 32; const bf16_t* vp = Z + row * INW + 1792 + h * 128 + q * 32;
#pragma unroll
        for (int cc = 0; cc < 4; ++cc) {
            const u32x4 kv = *(const u32x4*)(kp + cc * 8), vv = *(const u32x4*)(vp + cc * 8);
#pragma unroll
            for (int e = 0; e < 4; ++e) {
                const int d = q * 32 + cc * 8 + 2 * e;
                KT[d * 136 + j] = f2bf(bflo(kv[e]) * dec); KT[(d + 1) * 136 + j] = f2bf(bfhi(kv[e]) * dec);
                VT[d * 136 + j] = (bf16_t)(vv[e] & 0xffffu); VT[(d + 1) * 136 + j] = (bf16_t)(vv[e] >> 16);
            }
        }
    }
    __syncthreads();
    f32x4 acc[8];
#pragma unroll
    for (int dt = 0; dt < 8; ++dt) acc[dt] = (f32x4){0.f, 0.f, 0.f, 0.f};
#pragma unroll
    for (int kk = 0; kk < 4; ++kk) {
        const bf16x8 Bf = *(const bf16x8*)(VT + (16 * wid + lr) * 136 + kk * 32 + g * 8);
#pragma unroll
        for (int dt = 0; dt < 8; ++dt) {
            const bf16x8 Af = *(const bf16x8*)(KT + (16 * dt + lr) * 136 + kk * 32 + g * 8);
            acc[dt] = __builtin_amdgcn_mfma_f32_16x16x32_bf16(Af, Bf, acc[dt], 0, 0, 0);
        }
    }
    float* up = UT + (size_t)item * 16384 + (size_t)(16 * wid + lr) * 128;
#pragma unroll
    for (int dt = 0; dt < 8; ++dt) *(f32x4*)(up + 16 * dt + 4 * g) = acc[dt];
    __syncthreads();
}

__device__ __forceinline__ void phase_scan(const Params& p) {
    const float* UT = (const float*)(p.ws + WS_H); bf16_t* SST = (bf16_t*)(p.ws + WS_SST);
    const int gt = blockIdx.x * 512 + threadIdx.x, gs = gridDim.x * 512;
    for (int i = gt; i < 32 * 4096; i += gs) {
        const int bh = i >> 12, ed = (i & 4095) * 4, e = ed >> 7, d = ed & 127, h = bh & 3;
        const float gL = __expf(log_gamma(h) * 128.f);
        f32x4 s = (f32x4){0.f, 0.f, 0.f, 0.f};
        const float* up = UT + (size_t)bh * 32 * 16384 + ed; bf16_t* sp = SST + (size_t)bh * 32 * 16384 + ed;
#pragma unroll
        for (int c0 = 0; c0 < 32; c0 += 16) {
            f32x4 uv[16];
#pragma unroll
            for (int c = 0; c < 16; ++c) uv[c] = __builtin_nontemporal_load((const f32x4*)(up + (size_t)(c0 + c) * 16384));
#pragma unroll
            for (int c = 0; c < 16; ++c) { u32x2 o; o[0] = cvt_pk_bf16(s[0], s[1]); o[1] = cvt_pk_bf16(s[2], s[3]); *(u32x2*)(sp + (size_t)(c0 + c) * 16384) = o; s = gL * s + uv[c]; }
        }
#pragma unroll
        for (int k = 0; k < 4; ++k) p.out[O_RP + ((size_t)bh * 128 + ret_dim(d + k)) * 128 + e] = s[k];
    }
}

__device__ __forceinline__ void reto_item(const Params& p, unsigned char* shm, int item) {
    const int tid = threadIdx.x, wid = tid >> 6, lane = tid & 63, lr = lane & 15, g = lane >> 4;
    const int b = item >> 7, h = (item >> 5) & 3, c = item & 31;
    const bf16_t* Z = (const bf16_t*)(p.ws + WS_Z); const bf16_t* SST = (const bf16_t*)(p.ws + WS_SST); bf16_t* MIX = (bf16_t*)(p.ws + WS_MIX);
    bf16_t* Ks = (bf16_t*)shm;
    bf16_t* VT = Ks + 128 * 136;
    bf16_t* Ss = VT + 128 * 136;
    const float lg = log_gamma(h);
    const size_t row0 = (size_t)b * SEQ + (size_t)c * 128;
    {
        const int j = tid >> 2, q = tid & 3;
        const bf16_t* kp = Z + (row0 + j) * INW + 1280 + h * 128 + q * 32; const bf16_t* vp = Z + (row0 + j) * INW + 1792 + h * 128 + q * 32;
        const bf16_t* sp = SST + (size_t)item * 16384 + j * 128 + q * 32;
#pragma unroll
        for (int cc = 0; cc < 4; ++cc) {
            const u32x4 kv = *(const u32x4*)(kp + cc * 8), vv = *(const u32x4*)(vp + cc * 8), sv = *(const u32x4*)(sp + cc * 8);
            *(u32x4*)(Ks + j * 136 + q * 32 + cc * 8) = kv;
            *(u32x4*)(Ss + j * 136 + q * 32 + cc * 8) = sv;
#pragma unroll
            for (int e = 0; e < 4; ++e) { const int d = q * 32 + cc * 8 + 2 * e; VT[d * 136 + j] = (bf16_t)(vv[e] & 0xffffu); VT[(d + 1) * 136 + j] = (bf16_t)(vv[e] >> 16); }
        }
    }
    __syncthreads();
    const size_t qrow = row0 + 16 * wid + lr;
    bf16x8 Qf[4];
#pragma unroll
    for (int kk = 0; kk < 4; ++kk) Qf[kk] = *(const bf16x8*)(Z + qrow * INW + 768 + h * 128 + kk * 32 + g * 8);
    f32x4 S[8];
#pragma unroll
    for (int jt = 0; jt < 8; ++jt) {
        S[jt] = (f32x4){0.f, 0.f, 0.f, 0.f};
        if (jt <= wid) {
#pragma unroll
            for (int kk = 0; kk < 4; ++kk) {
                const bf16x8 Kf = *(const bf16x8*)(Ks + (16 * jt + lr) * 136 + kk * 32 + g * 8);
                S[jt] = __builtin_amdgcn_mfma_f32_16x16x32_bf16(Kf, Qf[kk], S[jt], 0, 0, 0);
            }
        }
    }
    const int it = 16 * wid + lr;
#pragma unroll
    for (int jt = 0; jt < 8; ++jt)
#pragma unroll
        for (int r = 0; r < 4; ++r) { const int j = 16 * jt + 4 * g + r; S[jt][r] = (j <= it) ? S[jt][r] * __expf(lg * (float)(it - j)) : 0.f; }
    f32x4 O1[8], O2[8];
#pragma unroll
    for (int et = 0; et < 8; ++et) { O1[et] = (f32x4){0.f, 0.f, 0.f, 0.f}; O2[et] = (f32x4){0.f, 0.f, 0.f, 0.f}; }
#pragma unroll
    for (int jp = 0; jp < 4; ++jp) {
        if (2 * jp <= wid) {
            u32x4 pu; pu[0] = cvt_pk_bf16(S[2 * jp][0], S[2 * jp][1]); pu[1] = cvt_pk_bf16(S[2 * jp][2], S[2 * jp][3]);
            pu[2] = cvt_pk_bf16(S[2 * jp + 1][0], S[2 * jp + 1][1]); pu[3] = cvt_pk_bf16(S[2 * jp + 1][2], S[2 * jp + 1][3]);
            const bf16x8 Pf = __builtin_bit_cast(bf16x8, pu);
#pragma unroll
            for (int et = 0; et < 8; ++et) {
                const bf16_t* vr = VT + (16 * et + lr) * 136 + 32 * jp + 4 * g;
                const u32x2 a0 = *(const u32x2*)vr, a1 = *(const u32x2*)(vr + 16);
                u32x4 au; au[0] = a0[0]; au[1] = a0[1]; au[2] = a1[0]; au[3] = a1[1];
                O1[et] = __builtin_amdgcn_mfma_f32_16x16x32_bf16(__builtin_bit_cast(bf16x8, au), Pf, O1[et], 0, 0, 0);
            }
        }
    }
#pragma unroll
    for (int kk = 0; kk < 4; ++kk)
#pragma unroll
        for (int et = 0; et < 8; ++et) {
            const bf16x8 Sf = *(const bf16x8*)(Ss + (16 * et + lr) * 136 + kk * 32 + g * 8);
            O2[et] = __builtin_amdgcn_mfma_f32_16x16x32_bf16(Sf, Qf[kk], O2[et], 0, 0, 0);
        }
    const float qd = __expf(lg * (float)(it + 1));
    float sum = 0.f;
#pragma unroll
    for (int et = 0; et < 8; ++et)
#pragma unroll
        for (int r = 0; r < 4; ++r) { const float o = O1[et][r] + qd * O2[et][r]; O1[et][r] = o; sum += o; }
    sum += __shfl_xor(sum, 16); sum += __shfl_xor(sum, 32);
    const float mu = sum * (1.f / 128.f);
    float vs = 0.f;
#pragma unroll
    for (int et = 0; et < 8; ++et)
#pragma unroll
        for (int r = 0; r < 4; ++r) { const float dlt = O1[et][r] - mu; vs += dlt * dlt; }
    vs += __shfl_xor(vs, 16); vs += __shfl_xor(vs, 32);
    const float rstd = rsqrtf(vs * (1.f / 128.f) + 1e-6f);
#pragma unroll
    for (int et = 0; et < 8; ++et) {
        const int e = 16 * et + 4 * g;
        const u32x2 gz = *(const u32x2*)(Z + qrow * INW + 2304 + h * 128 + e);
        const f32x4 gw = *(const f32x4*)(p.ret_gn_w + h * 128 + e);
        const float r0 = (O1[et][0] - mu) * rstd * gw[0] * silu_f(bflo(gz[0])), r1 = (O1[et][1] - mu) * rstd * gw[1] * silu_f(bfhi(gz[0]));
        const float r2 = (O1[et][2] - mu) * rstd * gw[2] * silu_f(bflo(gz[1])), r3 = (O1[et][3] - mu) * rstd * gw[3] * silu_f(bfhi(gz[1]));
        u32x2 o; o[0] = cvt_pk_bf16(r0, r1); o[1] = cvt_pk_bf16(r2, r3);
        *(u32x2*)(MIX + qrow * DM + 512 + h * 128 + e) = o;
    }
    __syncthreads();
}

__device__ __forceinline__ void sample_att(const Params& p, unsigned char* shm, int b) {
    const int tid = threadIdx.x, wid = tid >> 6, lane = tid & 63;
    const bf16_t* zrow = (const bf16_t*)(p.ws + WS_Z) + (size_t)(TP + b) * INW; bf16_t* mixrow = (bf16_t*)(p.ws + WS_MIX) + (size_t)(TP + b) * DM;
    float* sm = (float*)shm;
    float* qn = sm;
    float* kn = qn + 512;
    float* vn = kn + 128;
    float* scs = vn + 128;
    { const int hh = tid >> 6, pp = tid & 63; qn[hh * 64 + att_dim(pp)] = bf2f(zrow[tid]); }
    if (tid < 128) { const int hh = tid >> 6, pp = tid & 63; kn[hh * 64 + att_dim(pp)] = bf2f(zrow[512 + tid]); vn[tid] = bf2f(zrow[640 + tid]); }
    __syncthreads();
    const float* ck = p.cache_k + (size_t)b * 128 * 128; const float* cv = p.cache_v + (size_t)b * 128 * 128;
#pragma unroll
    for (int itr = 0; itr < 2; ++itr) {
        const int idx = tid + 512 * itr, hd = idx >> 7, w = idx & 127, kvh = hd >> 2;
        const float* kr = ck + (w * 2 + kvh) * 64; const float* qr = qn + hd * 64;
        float s = 0.f;
#pragma unroll
        for (int d = 0; d < 64; d += 4) { const f32x4 kv = *(const f32x4*)(kr + d); s += qr[d] * kv[0] + qr[d + 1] * kv[1] + qr[d + 2] * kv[2] + qr[d + 3] * kv[3]; }
        scs[hd * 132 + w] = s * 0.125f;
    }
    if (tid < 8) { const int kvh = tid >> 2; float s = 0.f; for (int d = 0; d < 64; ++d) s += qn[tid * 64 + d] * kn[kvh * 64 + d]; scs[tid * 132 + 128] = s * 0.125f; }
    __syncthreads();
    {
        const float sink = p.att_sinks[wid];
        const float s0 = scs[wid * 132 + lane], s1 = scs[wid * 132 + 64 + lane], s2 = lane == 0 ? scs[wid * 132 + 128] : -INFINITY;
        float mx = fmaxf(fmaxf(s0, s1), fmaxf(s2, sink));
#pragma unroll
        for (int o = 32; o >= 1; o >>= 1) mx = fmaxf(mx, __shfl_xor(mx, o));
        const float e0 = __expf(s0 - mx), e1 = __expf(s1 - mx), e2 = lane == 0 ? __expf(s2 - mx) : 0.f;
        float sum = e0 + e1 + e2;
#pragma unroll
        for (int o = 32; o >= 1; o >>= 1) sum += __shfl_xor(sum, o);
        const float inv = 1.f / (sum + __expf(sink - mx));
        scs[wid * 132 + lane] = e0 * inv; scs[wid * 132 + 64 + lane] = e1 * inv; if (lane == 0) scs[wid * 132 + 128] = e2 * inv;
    }
    __syncthreads();
    {
        const int hd = tid >> 6, d = tid & 63, kvh = hd >> 2;
        float o = scs[hd * 132 + 128] * vn[kvh * 64 + d];
#pragma unroll 16
        for (int w = 0; w < 128; ++w) o += scs[hd * 132 + w] * cv[(w * 2 + kvh) * 64 + d];
        mixrow[hd * 64 + d] = f2bf(o);
    }
    for (int i = tid; i < 127 * 32; i += 512) {
        *(f32x4*)(p.out + O_KS + (size_t)b * 16384 + i * 4) = *(const f32x4*)(ck + 128 + i * 4);
        *(f32x4*)(p.out + O_VS + (size_t)b * 16384 + i * 4) = *(const f32x4*)(cv + 128 + i * 4);
    }
    __syncthreads();
}
__device__ __forceinline__ void sample_ret(const Params& p, unsigned char* shm, int item) {
    const int tid = threadIdx.x, b = item >> 2, h = item & 3;
    const bf16_t* zrow = (const bf16_t*)(p.ws + WS_Z) + (size_t)(TP + b) * INW; bf16_t* mixrow = (bf16_t*)(p.ws + WS_MIX) + (size_t)(TP + b) * DM;
    float* sm = (float*)shm;
    float* rqn = sm;
    float* rkn = rqn + 128;
    float* red = rkn + 128;
    float* qkp = red + 512;
    float* ov = qkp + 4;
    if (tid < 128) { const int dn = ret_dim(tid); rqn[dn] = bf2f(zrow[768 + h * 128 + tid]); rkn[dn] = bf2f(zrow[1280 + h * 128 + tid]); }
    __syncthreads();
    const float gm = __expf(log_gamma(h));
    const int e = tid & 127, dq = tid >> 7;
    const float* sp = p.state_ret + ((size_t)(b * 4 + h) * 128 + dq * 32) * 128 + e;
    float* so = p.out + O_RS + ((size_t)(b * 4 + h) * 128 + dq * 32) * 128 + e;
    const float ve = bf2f(zrow[1792 + h * 128 + e]);
    float sv[32];
#pragma unroll
    for (int d = 0; d < 32; ++d) sv[d] = sp[d * 128];
    float part = 0.f, qk = 0.f;
#pragma unroll
    for (int d = 0; d < 32; ++d) { const float qd = rqn[dq * 32 + d], kd = rkn[dq * 32 + d]; part += qd * sv[d]; qk += qd * kd; so[d * 128] = gm * sv[d] + kd * ve; }
    red[dq * 128 + e] = part; if (e == 0) qkp[dq] = qk;
    __syncthreads();
    if (tid < 128) ov[tid] = (qkp[0] + qkp[1] + qkp[2] + qkp[3]) * ve + gm * (red[e] + red[128 + e] + red[256 + e] + red[384 + e]);
    __syncthreads();
    if (tid < 64) {
        const float o0 = ov[tid], o1 = ov[tid + 64];
        float sum = o0 + o1;
#pragma unroll
        for (int o = 32; o >= 1; o >>= 1) sum += __shfl_xor(sum, o);
        const float mu = sum * (1.f / 128.f);
        float vs = (o0 - mu) * (o0 - mu) + (o1 - mu) * (o1 - mu);
#pragma unroll
        for (int o = 32; o >= 1; o >>= 1) vs += __shfl_xor(vs, o);
        const float rstd = rsqrtf(vs * (1.f / 128.f) + 1e-6f);
#pragma unroll
        for (int k = 0; k < 2; ++k) { const int ee = tid + 64 * k; const float gz = bf2f(zrow[2304 + h * 128 + ee]);
            mixrow[512 + h * 128 + ee] = f2bf(((k ? o1 : o0) - mu) * rstd * p.ret_gn_w[h * 128 + ee] * silu_f(gz)); }
    }
    __syncthreads();
}

template <int NB>
__device__ __forceinline__ void sg_mma(unsigned char* shm, const bf16_t* A, const bf16_t* b0, const bf16_t* b1, int K, f32x4& out0, f32x4& out1) {
    const int tid = threadIdx.x, wid = tid >> 6, lane = tid & 63, lr = lane & 15, g = lane >> 4;
    const int ks = K >> 3;
    const bf16_t* ap = A + (size_t)(TP + lr) * K + 8 * g + wid * ks;
    b0 += wid * ks; if (NB == 2) b1 += wid * ks;
    f32x4 acc[8][NB];
#pragma unroll
    for (int rg = 0; rg < 8; ++rg)
#pragma unroll
        for (int nb = 0; nb < NB; ++nb) acc[rg][nb] = (f32x4){0.f, 0.f, 0.f, 0.f};
    for (int k = 0; k < ks; k += 32) {
        const bf16x8 w0 = *(const bf16x8*)(b0 + k);
        bf16x8 w1 = w0; if (NB == 2) w1 = *(const bf16x8*)(b1 + k);
        bf16x8 a[8];
#pragma unroll
        for (int rg = 0; rg < 8; ++rg) a[rg] = *(const bf16x8*)(ap + (size_t)(16 * rg) * K + k);
#pragma unroll
        for (int rg = 0; rg < 8; ++rg) {
            acc[rg][0] = __builtin_amdgcn_mfma_f32_16x16x32_bf16(w0, a[rg], acc[rg][0], 0, 0, 0);
            if (NB == 2) acc[rg][NB - 1] = __builtin_amdgcn_mfma_f32_16x16x32_bf16(w1, a[rg], acc[rg][NB - 1], 0, 0, 0);
        }
    }
    f32x4* red = (f32x4*)shm;
#pragma unroll
    for (int nb = 0; nb < NB; ++nb) {
        __syncthreads();
#pragma unroll
        for (int rg = 0; rg < 8; ++rg) red[(wid * 8 + rg) * 64 + lane] = acc[rg][nb];
        __syncthreads();
        f32x4 sum = red[(0 * 8 + wid) * 64 + lane];
#pragma unroll
        for (int w = 1; w < 8; ++w) sum += red[(w * 8 + wid) * 64 + lane];
        if (nb == 0) out0 = sum; else out1 = sum;
    }
    __syncthreads();
}
__device__ __forceinline__ void sg_ln(const Params& p, unsigned char* shm, int item, const bf16_t* A, const bf16_t* Bt, int K, const float* base, int gate_off, float* stat, unsigned* cnt,
                                      const float* lw, const float* lb, bf16_t* H, int h_off) {
    const int tid = threadIdx.x, wid = tid >> 6, lane = tid & 63, lr = lane & 15, g = lane >> 4;
    const int n0 = item * 16, m = 16 * wid + lr;
    f32x4 acc = (f32x4){0.f, 0.f, 0.f, 0.f}, dummy = acc;
    sg_mma<1>(shm, A, Bt + (size_t)(n0 + lr) * K + 8 * g, nullptr, K, acc, dummy);
    const int c = n0 + 4 * g;
    const float* mrow = (const float*)(p.ws + WS_MOD) + (size_t)m * 6144;
    const f32x4 xv = *(const f32x4*)(base + (size_t)m * DM + c), gv = *(const f32x4*)(mrow + gate_off + c);
    const f32x4 res = ALPHA * xv + (1.f + gv) * acc;
    float s = res[0] + res[1] + res[2] + res[3], ss = res[0] * res[0] + res[1] * res[1] + res[2] * res[2] + res[3] * res[3];
    s += __shfl_xor(s, 16); ss += __shfl_xor(ss, 16); s += __shfl_xor(s, 32); ss += __shfl_xor(ss, 32);
    if (g == 0) { __hip_atomic_fetch_add(stat + 2 * (TP + m), s, __ATOMIC_RELAXED, __HIP_MEMORY_SCOPE_AGENT); __hip_atomic_fetch_add(stat + 2 * (TP + m) + 1, ss, __ATOMIC_RELAXED, __HIP_MEMORY_SCOPE_AGENT); }
    asm volatile("s_waitcnt vmcnt(0)" ::: "memory");
    unsigned* pc = cnt + wid * 16;
    if (lane == 0) __hip_atomic_fetch_add(pc, 1u, __ATOMIC_RELAXED, __HIP_MEMORY_SCOPE_AGENT);
    wait_ge(pc, 64u, (unsigned*)(p.ws + WS_CNT) + 527 * 16 + 8);
    asm volatile("" ::: "memory");
    const float sa = __hip_atomic_load(stat + 2 * (TP + m), __ATOMIC_RELAXED, __HIP_MEMORY_SCOPE_AGENT), sb = __hip_atomic_load(stat + 2 * (TP + m) + 1, __ATOMIC_RELAXED, __HIP_MEMORY_SCOPE_AGENT);
    const float mu = sa * (1.f / 1024.f), var = sb * (1.f / 1024.f) - mu * mu, rstd = rsqrtf(fmaxf(var, 0.f) + 1e-5f);
    const f32x4 y = (res - mu) * rstd * *(const f32x4*)(lw + c) + *(const f32x4*)(lb + c);
    *(f32x4*)(p.out + O_YS + (size_t)m * DM + c) = y;
    if (H) { const f32x4 hv = y * (1.f + *(const f32x4*)(mrow + h_off + 1024 + c)) + *(const f32x4*)(mrow + h_off + c);
             u32x2 o; o[0] = cvt_pk_bf16(hv[0], hv[1]); o[1] = cvt_pk_bf16(hv[2], hv[3]); *(u32x2*)(H + (size_t)(TP + m) * DM + c) = o; }
}
__device__ __forceinline__ void sg_up(const Params& p, unsigned char* shm, int item) {
    const int tid = threadIdx.x, wid = tid >> 6, lane = tid & 63, lr = lane & 15, g = lane >> 4;
    const int n0 = item * 16, m = 16 * wid + lr, pn = n0 >> 7, off = n0 & 127;
    const bf16_t* A = (const bf16_t*)(p.ws + WS_H); const bf16_t* Bt = (const bf16_t*)(p.ws + WS_WUP);
    f32x4 ag = (f32x4){0.f, 0.f, 0.f, 0.f}, au = ag;
    sg_mma<2>(shm, A, Bt + (size_t)(256 * pn + off + lr) * DM + 8 * g, Bt + (size_t)(256 * pn + 128 + off + lr) * DM + 8 * g, DM, ag, au);
    u32x2 o; o[0] = cvt_pk_bf16(silu_f(ag[0]) * au[0], silu_f(ag[1]) * au[1]); o[1] = cvt_pk_bf16(silu_f(ag[2]) * au[2], silu_f(ag[3]) * au[3]);
    *(u32x2*)((bf16_t*)(p.ws + WS_Z) + (size_t)(TP + m) * DFF + n0 + 4 * g) = o;
}

#define XB_TMO      128
#define XB_XCNT(j)  (256  + 64 * (j))
#define XB_XSUB(j)  (1280 + 64 * (j))
#define XB_XGEN(j)  (2304 + 64 * (j))
#define XB_TOP      3328
#define XB_TOPGEN   3392
#define XCD_BAR_WORDS 3456
#define XB_SPIN_CAP (1u << 18)
__device__ __forceinline__ unsigned xb_ld(unsigned* p)              { return __hip_atomic_load(p, __ATOMIC_RELAXED, __HIP_MEMORY_SCOPE_AGENT); }
__device__ __forceinline__ unsigned xb_add(unsigned* p, unsigned v) { return __hip_atomic_fetch_add(p, v, __ATOMIC_RELAXED, __HIP_MEMORY_SCOPE_AGENT); }
__device__ __forceinline__ unsigned xb_xcc_id() { return (unsigned)__builtin_amdgcn_s_getreg((3 << 11) | 20) & 0xFu; }
#define XB_SPIN(cond, bar) do { unsigned _sp = 0; while (cond) { __builtin_amdgcn_s_sleep(1); \
    if ((++_sp & 255u) == 0u) { if (xb_ld(&(bar)[XB_TMO])) break; if (_sp > XB_SPIN_CAP) { atomicAdd(&(bar)[XB_TMO], 1u); break; } } } } while (0)
struct XcdBarrier { unsigned* bar; unsigned x; volatile LAS unsigned* st; };
__device__ __forceinline__ XcdBarrier xcd_barrier_post(unsigned* bar, volatile LAS unsigned* st) {
    XcdBarrier b; b.bar = bar; b.x = xb_xcc_id(); b.st = st;
    if (threadIdx.x == 0) (void)xb_add(&bar[XB_XCNT(b.x)], 1u);
    return b;
}
__device__ __forceinline__ void xcd_barrier_complete(unsigned* bar, unsigned x, unsigned& nloc, unsigned& nx) {
    const unsigned G = gridDim.x * gridDim.y * gridDim.z;
    unsigned sum, cnt, mine, sp = 0u;
    for (;;) {
        sum = 0u; cnt = 0u; mine = 0u;
#pragma unroll
        for (unsigned j = 0; j < 16; ++j) { const unsigned c = xb_ld(&bar[XB_XCNT(j)]); sum += c; cnt += (c > 0u) ? 1u : 0u; mine = (j == x) ? c : mine; }
        if (sum == G) break;
        __builtin_amdgcn_s_sleep(1);
        if ((++sp & 255u) == 0u) { if (xb_ld(&bar[XB_TMO])) break; if (sp > XB_SPIN_CAP) { atomicAdd(&bar[XB_TMO], 1u); break; } }
    }
    nloc = mine > 0u ? mine : 1u; nx = cnt > 0u ? cnt : 1u;
}
__device__ __forceinline__ void xcd_barrier(const XcdBarrier& b) {
    asm volatile("s_waitcnt vmcnt(0)" ::: "memory");
    __syncthreads();
    if (threadIdx.x == 0) {
        unsigned* bar = b.bar;
        __builtin_amdgcn_s_waitcnt(0);
        unsigned nloc = b.st[0], nx = b.st[1];
        if (nloc == 0u) { xcd_barrier_complete(bar, b.x, nloc, nx); b.st[0] = nloc; b.st[1] = nx; }
        const unsigned old = xb_add(&bar[XB_XSUB(b.x)], 1u);
        const unsigned gen = old / nloc;
        if (old + 1u == (gen + 1u) * nloc) {
            __builtin_amdgcn_fence(__ATOMIC_RELEASE, "agent");
            asm volatile("s_waitcnt vmcnt(0)" ::: "memory");
            const unsigned og = xb_add(&bar[XB_TOP], 1u);
            const unsigned tg = og / nx;
            if (og + 1u == (tg + 1u) * nx) xb_add(&bar[XB_TOPGEN], 1u);
            else XB_SPIN(xb_ld(&bar[XB_TOPGEN]) == tg, bar);
            __builtin_amdgcn_fence(__ATOMIC_ACQUIRE, "agent");
            xb_add(&bar[XB_XGEN(b.x)], 1u);
            asm volatile("s_waitcnt vmcnt(0)" ::: "memory");
        } else {
            XB_SPIN(xb_ld(&bar[XB_XGEN(b.x)]) == gen, bar);
            __builtin_amdgcn_fence(__ATOMIC_ACQUIRE, "agent");
            asm volatile("s_waitcnt vmcnt(0)" ::: "memory");
        }
    }
    __syncthreads();
}

typedef __attribute__((address_space(4))) const unsigned char* kptr_t;
__device__ __forceinline__ Params load_params() {
#if defined(__HIP_DEVICE_COMPILE__)
    kptr_t k = (kptr_t)__builtin_amdgcn_kernarg_segment_ptr();
    asm volatile("" : "+s"(k));
    Params r;
    __builtin_memcpy(&r, (const __attribute__((address_space(4))) void*)k, sizeof(Params));
    return r;
#else
    return Params{};
#endif
}
__global__ void __launch_bounds__(512, 2) fwd(Params p_arg, int ph_lo, int ph_hi, int coop) {
    extern __shared__ __attribute__((aligned(16))) unsigned char shm[];
    cg::grid_group grid = cg::this_grid();
    LAS unsigned char* lds = (LAS unsigned char*)shm;
    const int G = gridDim.x, bid = blockIdx.x;
    volatile LAS unsigned* bst = (volatile LAS unsigned*)(lds + 131072);
    if (threadIdx.x < 4) bst[threadIdx.x] = 0u;
    __syncthreads();
    (void)xcd_barrier_post((unsigned*)(p_arg.ws + WS_BAR), bst);
    if (coop > 1) grid.sync();
#define GSYNC() do { XcdBarrier xb_; xb_.bar = (unsigned*)(load_params().ws + WS_BAR); xb_.x = xb_xcc_id(); xb_.st = (volatile LAS unsigned*)((LAS unsigned char*)shm + 131072); xcd_barrier(xb_); } while (0)
#ifndef ONLY
#define ONLY -1
#endif
#ifndef REP_PH
#define REP_PH -1
#endif
#ifndef REP_SYNC
#define REP_SYNC 0
#endif
#define PH_BEGIN(n) if ((ONLY < 0 || ONLY == n) && ph_lo <= n && n < ph_hi) { if (n > ph_lo && coop) GSYNC(); for (int rep_ = 0; rep_ < (REP_PH == n ? 2 : 1); ++rep_) { if (rep_) GSYNC(); const Params p = load_params();
#define PH_END } }
    for (int i_ = 0; i_ < REP_SYNC; ++i_) GSYNC();
    PH_BEGIN(0) { prep_tiles(p, shm, 768 + bid, 1152, G); prep_misc(p); } PH_END
    PH_BEGIN(1) { if (bid >= 24) prep_tiles(p, shm, bid - 24, 768, G - 24);
                  pg8::Gemm g{(const bf16_t*)(p.ws + WS_SC), (const bf16_t*)(p.ws + WS_WADA), 256, 6144, DM}; pg8::StaticOrder S; S.init(g.M, g.N, G, bid);
                  EpiAda E{(float*)(p.ws + WS_MOD), p.b_ada_mix, p.b_ada_ffn}; pg8::gemm_phase(lds, g, S, E); } PH_END
    PH_BEGIN(2) phase_modulate(p); PH_END
    PH_BEGIN(3) { pg8::Gemm g{(const bf16_t*)(p.ws + WS_H), (const bf16_t*)(p.ws + WS_WIN), TPAD, INW, DM}; pg8::StaticOrder S; S.init(g.M, g.N, G, bid);
                  EpiIn E{(bf16_t*)(p.ws + WS_Z), (const float*)(p.ws + WS_ROPEA), (const float*)(p.ws + WS_ROPER), p.out}; pg8::gemm_phase(lds, g, S, E); } PH_END
    PH_BEGIN(4) { for (int it = bid; it < 1024; it += G) retu_item(p, shm, it); for (int it = bid; it < 512; it += G) attn_item(p, shm, it); for (int it = G - 1 - bid; it < 512; it += G) sample_ret(p, shm, it); for (int it = bid; it < 128; it += G) sample_att(p, shm, it); } PH_END
    PH_BEGIN(5) phase_scan(p); PH_END
    PH_BEGIN(6) for (int it = bid; it < 1024; it += G) reto_item(p, shm, it); PH_END
    PH_BEGIN(7) { for (int it = G - 1 - bid; it < 64; it += G) sg_ln(p, shm, it, (const bf16_t*)(p.ws + WS_MIX), (const bf16_t*)(p.ws + WS_WOUT), DM, p.x_sample, 2048, (float*)(p.ws + WS_STAT1),
                                                                       (unsigned*)(p.ws + WS_CNT) + 512 * 16, p.ln1_w, p.ln1_b, (bf16_t*)(p.ws + WS_H), 3072);
                  pg8::Gemm g{(const bf16_t*)(p.ws + WS_MIX), (const bf16_t*)(p.ws + WS_WOUT), TP, DM, DM}; pg8::StaticOrder S; S.init(g.M, g.N, G, bid);
                  EpiLn<false, true> E{p.x_prompt, p.ws + WS_MIX, (const float*)(p.ws + WS_MOD), 2048, (float*)(p.ws + WS_STAT1), (unsigned*)(p.ws + WS_CNT), p.ln1_w, p.ln1_b, (bf16_t*)(p.ws + WS_H), 3072, (unsigned*)(p.ws + WS_CNT) + 527 * 16 + 8};
                  pg8::gemm_phase(lds, g, S, E); } PH_END
    PH_BEGIN(9) { for (int it = G - 1 - bid; it < 176; it += G) sg_up(p, shm, it);
                  pg8::Gemm g{(const bf16_t*)(p.ws + WS_H), (const bf16_t*)(p.ws + WS_WUP), TP, 2 * DFF, DM}; pg8::StaticOrder S; S.init(g.M, g.N, G, bid);
                  EpiUp E{(bf16_t*)(p.ws + WS_Z)}; pg8::gemm_phase(lds, g, S, E); } PH_END
    PH_BEGIN(10) { for (int it = G - 1 - bid; it < 64; it += G) sg_ln(p, shm, it, (const bf16_t*)(p.ws + WS_Z), (const bf16_t*)(p.ws + WS_WDOWN), DFF, p.out + O_YS, 3072 + 2048, (float*)(p.ws + WS_STAT2),
                                                                        (unsigned*)(p.ws + WS_CNT) + 520 * 16, p.ln2_w, p.ln2_b, nullptr, 0);
                   pg8::Gemm g{(const bf16_t*)(p.ws + WS_Z), (const bf16_t*)(p.ws + WS_WDOWN), TP, DM, DFF}; pg8::StaticOrder S; S.init(g.M, g.N, G, bid);
                   EpiLn<true, false> E{p.ws + WS_MIX, p.out, (const float*)(p.ws + WS_MOD), 3072 + 2048, (float*)(p.ws + WS_STAT2), (unsigned*)(p.ws + WS_CNT) + 256 * 16, p.ln2_w, p.ln2_b, nullptr, 0, (unsigned*)(p.ws + WS_CNT) + 527 * 16 + 8};
                   pg8::gemm_phase(lds, g, S, E); } PH_END
}

extern "C" void kernel_launch(void* const* d_in, const int* in_sizes, int n_in, void* d_out, int out_size, void* d_ws, size_t ws_size, hipStream_t stream) {
    constexpr int LDS_BYTES = 131072 + 64;
    static int grid = 0;
    if (!grid) {
        int dev = 0, cus = 0, per_cu = 0;
        (void)hipGetDevice(&dev);
        (void)hipDeviceGetAttribute(&cus, hipDeviceAttributeMultiprocessorCount, dev);
        (void)hipFuncSetAttribute((const void*)fwd, hipFuncAttributeMaxDynamicSharedMemorySize, LDS_BYTES);
        (void)hipOccupancyMaxActiveBlocksPerMultiprocessor(&per_cu, (const void*)fwd, 512, LDS_BYTES);
        grid = cus > 0 ? cus : 256;
        if (ws_size < WS_END) fprintf(stderr, "kernel_launch: workspace too small: %zu < %zu\n", ws_size, (size_t)WS_END);
        fprintf(stderr, "kernel_launch: cus %d per_cu %d grid %d ws %zu need %zu\n", cus, per_cu, grid, ws_size, (size_t)WS_END);
    }
    Params p{};
    const float** f = (const float**)&p;
    for (int i = 0; i < 21; ++i) f[i] = (const float*)d_in[i];
    p.out = (float*)d_out; p.ws = (unsigned char*)d_ws;
#ifndef MULTI_LAUNCH
    (void)hipMemsetAsync((unsigned char*)d_ws + WS_BAR, 0, 16384, stream);
    int lo = 0, hi = 12, coop = 1;
    void* args[] = {&p, &lo, &hi, &coop};
    hipError_t e = hipLaunchCooperativeKernel((const void*)fwd, dim3(grid), dim3(512), args, LDS_BYTES, stream);
    if (e != hipSuccess) fprintf(stderr, "cooperative launch failed: %s (grid %d)\n", hipGetErrorString(e), grid);
#else
    for (int ph = 0; ph < 12; ++ph) hipLaunchKernelGGL(fwd, dim3(grid), dim3(512), LDS_BYTES, stream, p, ph, ph + 1, 0);
#endif
}
```

```cpp
#include <hip/hip_runtime.h>
#include <hip/hip_cooperative_groups.h>
#include <cstdio>
namespace cg = cooperative_groups;

#define LAS __attribute__((address_space(3)))
typedef unsigned short bf16_t;
typedef short bf16x8 __attribute__((ext_vector_type(8)));
typedef float f32x4 __attribute__((ext_vector_type(4)));
typedef unsigned u32x4 __attribute__((ext_vector_type(4)));
typedef unsigned u32x2 __attribute__((ext_vector_type(2)));

constexpr int DM = 1024, SEQ = 4096, NBATCH = 8, TP = NBATCH * SEQ  , NS = 128, TV = TP + NS  , TPAD = TP + 256  ;
constexpr int INW = 2816, DFF = 2816, PAST = 16384;
constexpr float ALPHA = 1.189207115002721f;
constexpr float RK_SCALE = 0.08838834764831845f;
constexpr size_t O_YP = 0, O_YS = (size_t)TP * DM, O_KP = O_YS + (size_t)NS * DM, O_VP = O_KP + 131072, O_RP = O_VP + 131072,
                 O_KS = O_RP + 524288, O_VS = O_KS + 2097152, O_RS = O_VS + 2097152;
constexpr size_t al256(size_t x) { return (x + 255) & ~(size_t)255; }
constexpr size_t WS_WIN = 0;
constexpr size_t WS_WOUT = WS_WIN + (size_t)INW * DM * 2;
constexpr size_t WS_WUP = WS_WOUT + (size_t)DM * DM * 2;
constexpr size_t WS_WDOWN = WS_WUP + (size_t)2 * DFF * DM * 2;
constexpr size_t WS_WADA = WS_WDOWN + (size_t)DM * DFF * 2;
constexpr size_t WS_SC = WS_WADA + (size_t)6144 * DM * 2;
constexpr size_t WS_MOD = WS_SC + (size_t)256 * DM * 2;
constexpr size_t WS_ROPEA = WS_MOD + (size_t)256 * 6144 * 4;
constexpr size_t WS_ROPER = al256(WS_ROPEA + (size_t)4097 * 16 * 4);
constexpr size_t WS_STAT1 = al256(WS_ROPER + (size_t)4097 * 128 * 4);
constexpr size_t WS_STAT2 = WS_STAT1 + (size_t)TPAD * 2 * 4;
constexpr size_t WS_H = al256(WS_STAT2 + (size_t)TPAD * 2 * 4);
constexpr size_t WS_Z = WS_H + (size_t)TPAD * DM * 2;
constexpr size_t WS_MIX = WS_Z + (size_t)TPAD * INW * 2;
constexpr size_t WS_SST = WS_MIX + (size_t)TPAD * DM * 2;
constexpr size_t WS_BAR = WS_SST + (size_t)1024 * 16384 * 2;
constexpr size_t WS_CNT = WS_BAR + 16384;
constexpr size_t WS_END = WS_CNT + 528 * 64;

struct Params {
    const float *x_prompt, *x_sample, *c_prompt, *c_sample, *cache_k, *cache_v, *state_ret, *w_ada_mix, *b_ada_mix, *w_in, *att_sinks, *ret_gn_w, *w_out,
        *ln1_w, *ln1_b, *w_ada_ffn, *b_ada_ffn, *w_up, *w_down, *ln2_w, *ln2_b;
    float* out; unsigned char* ws;
};

__device__ __forceinline__ unsigned cvt_pk_bf16(float lo, float hi) { unsigned r; asm volatile("v_cvt_pk_bf16_f32 %0, %1, %2" : "=v"(r) : "v"(lo), "v"(hi)); return r; }
__device__ __forceinline__ float bf2f(bf16_t b) { return __uint_as_float(((unsigned)b) << 16); }
__device__ __forceinline__ bf16_t f2bf(float f) { return (bf16_t)(cvt_pk_bf16(f, 0.f) & 0xffffu); }
__device__ __forceinline__ float bflo(unsigned u) { return __uint_as_float(u << 16); }
__device__ __forceinline__ float bfhi(unsigned u) { return __uint_as_float(u & 0xffff0000u); }
__device__ __forceinline__ float silu_f(float v) { return v * __builtin_amdgcn_rcpf(1.f + __expf(-v)); }
__device__ __forceinline__ float log_gamma(int h) {
    return h == 0 ? -0.0317486983145803f : (h == 1 ? -0.012479111952334388f : (h == 2 ? -0.004933717393740471f : -0.0019550348358033506f));
}
__device__ __forceinline__ int att_dim(int p) { if (p >= 16) return p; const int g = p >> 3, j = p & 7; return j < 4 ? 4 * g + j : 8 + 4 * g + (j - 4); }
__device__ __forceinline__ int ret_dim(int p) { const int g = p >> 3, j = p & 7; return j < 4 ? 4 * g + j : 64 + 4 * g + (j - 4); }
__device__ __forceinline__ int in_col(int P) {
    if (P < 640) return (P & ~63) + att_dim(P & 63);
    if (P >= 768 && P < 1792) { const int p = (P - 768) & 127; return P - p + ret_dim(p); }
    return P;
}
__device__ __forceinline__ int up_col(int P) { const int pn = P >> 8, q = P & 255; return q < 128 ? pn * 128 + q : DFF + pn * 128 + (q - 128); }

namespace pg8 {
constexpr int BM = 256, BK = 64, HALF = 128, HTB = HALF * BK * 2, STAGE_BYTES = 8 * HTB, NXCD = 8, WGM = 8;
__device__ __forceinline__ int lds_byte(int r, int c) { const int st = (r >> 4) * 2 + (c >> 5), rr = r & 15, cc = c & 31, ob = rr * 64 + cc * 2; return st * 1024 + (ob ^ (((ob >> 9) & 1) << 5)); }
__device__ __forceinline__ void stage_rc(int b, int& R, int& C) { const int st = b / 1024, sb = b % 1024, swz = sb ^ (((sb >> 9) & 1) << 5); R = (st >> 1) * 16 + swz / 64; C = (st & 1) * 32 + (swz % 64) / 2; }
__device__ __forceinline__ int perm32(int rho) { const int n = rho >> 4, i = rho & 15; return 8 * (i >> 2) + 4 * n + (i & 3); }
struct Unit { int pm, pn; };
struct Gemm { const bf16_t* A; const bf16_t* Bt; int M, N, K; };
struct StaticOrder {
    int nM, nN, nwg, G, c;
    __device__ void init(int M, int N, int G_, int c_) { nM = M / BM; nN = N / BM; nwg = nM * nN; G = G_; c = c_; }
    __device__ bool next(int i, Unit& u) const {
        const long L = (long)i * G + c; if (L >= nwg) return false;
        int wgid = (int)L; { const int q = nwg / NXCD, r = nwg % NXCD, xcd = wgid % NXCD, off = wgid / NXCD; wgid = (xcd < r ? xcd * (q + 1) : r * (q + 1) + (xcd - r) * q) + off; }
        const int nig = WGM * nN, gid = wgid / nig, fm = gid * WGM, gsz = (nM - fm) < WGM ? (nM - fm) : WGM;
        u.pm = fm + ((wgid % nig) % gsz); u.pn = (wgid % nig) / gsz; return true;
    }
};

template <class Epi, class Sched>
__device__ __forceinline__ void gemm_phase(LAS unsigned char* lds, const Gemm g, const Sched& S, const Epi& E) {
    const int tid = threadIdx.x, wid = __builtin_amdgcn_readfirstlane(tid >> 6), lane = tid & 63, wr = wid >> 2, wc = wid & 3, fr = lane & 15, fq = lane >> 4;
    const int K = g.K, nt = K / BK;
    unsigned voffA[2], voffB[2];
#pragma unroll
    for (int i = 0; i < 2; ++i) { int R, C; stage_rc(tid * 16 + i * 8192, R, C); const int Rb = Epi::PERM ? ((R & ~31) + perm32(R & 31)) : R;
        voffA[i] = (unsigned)(R * K + C) * 2u; voffB[i] = (unsigned)(Rb * K + C) * 2u; }
    const size_t kstep = (size_t)(BK * 2);
    const size_t hstep = (size_t)HALF * K * 2;
    const size_t tstep = 2 * hstep;
    const unsigned ldsw = (unsigned)wid * 1024u;
    const int aoff = lds_byte(wr * 64 + fr, fq * 8), boff = lds_byte(wc * 32 + fr, fq * 8);
#define PG8_SA(b, h) (((b) * 2 + (h)) * HTB)
#define PG8_SB(b, h) ((4 + (b) * 2 + (h)) * HTB)
#define PG8_STAGE(bufoff, gbase, voff) do { _Pragma("unroll") for (int _i = 0; _i < 2; ++_i) \
        __builtin_amdgcn_global_load_lds((const unsigned*)((const char*)(gbase) + (voff)[_i]), (LAS unsigned*)(lds + (bufoff) + ldsw + _i * 8192), 16, 0, 0); } while (0)
#define PG8_LDA(dst, b, h) do { _Pragma("unroll") for (int m = 0; m < 4; ++m) _Pragma("unroll") for (int k = 0; k < 2; ++k) dst[m][k] = *(const LAS bf16x8*)(lds + PG8_SA(b, h) + aoff + m * 2048 + k * 1024); } while (0)
#define PG8_LDB(dst, b, h) do { _Pragma("unroll") for (int n = 0; n < 2; ++n) _Pragma("unroll") for (int k = 0; k < 2; ++k) dst[n][k] = *(const LAS bf16x8*)(lds + PG8_SB(b, h) + boff + n * 2048 + k * 1024); } while (0)
#define PG8_MMA(ai, bj, At, Bt) do { __builtin_amdgcn_s_setprio(1); _Pragma("unroll") for (int m = 0; m < 4; ++m) _Pragma("unroll") for (int n = 0; n < 2; ++n) _Pragma("unroll") for (int k = 0; k < 2; ++k) \
        acc[ai][bj][m][n] = __builtin_amdgcn_mfma_f32_16x16x32_bf16(Bt[n][k], At[m][k], acc[ai][bj][m][n], 0, 0, 0); __builtin_amdgcn_s_setprio(0); } while (0)
#define PG8_WAIT_V(n) asm volatile("s_waitcnt vmcnt(" #n ")" ::: "memory")
#define PG8_WAIT_L(n) asm volatile("s_waitcnt lgkmcnt(" #n ")" ::: "memory")
#define PG8_BAR __builtin_amdgcn_s_barrier()
#define PG8_SCHED __builtin_amdgcn_sched_barrier(0)
    Unit cur, nxt; int ui = 0;
    if (!S.next(0, cur)) return;
    f32x4 acc[2][2][4][2];
#pragma unroll
    for (int a = 0; a < 2; ++a)
#pragma unroll
        for (int b = 0; b < 2; ++b)
#pragma unroll
            for (int m = 0; m < 4; ++m)
#pragma unroll
                for (int n = 0; n < 2; ++n) acc[a][b][m][n] = (f32x4){0.f, 0.f, 0.f, 0.f};
    bf16x8 At[4][2], B0[2][2], B1[2][2];
    const char* cA = (const char*)g.A + (size_t)cur.pm * tstep; const char* cB = (const char*)g.Bt + (size_t)cur.pn * tstep;
    PG8_STAGE(PG8_SB(0, 0), cB, voffB); PG8_STAGE(PG8_SA(0, 0), cA, voffA); PG8_STAGE(PG8_SB(0, 1), cB + hstep, voffB); PG8_STAGE(PG8_SA(0, 1), cA + hstep, voffA);
    if (wr == 1) PG8_BAR;
    PG8_WAIT_V(4); PG8_BAR;
    PG8_STAGE(PG8_SB(1, 0), cB + kstep, voffB); PG8_STAGE(PG8_SA(1, 0), cA + kstep, voffA); PG8_STAGE(PG8_SB(1, 1), cB + hstep + kstep, voffB);
    PG8_WAIT_V(6); PG8_BAR;
    for (;;) {
        const bool has_next = S.next(ui + 1, nxt);
        const char* nA = has_next ? (const char*)g.A + (size_t)nxt.pm * tstep : cA; const char* nB = has_next ? (const char*)g.Bt + (size_t)nxt.pn * tstep : cB;
        for (int t = 0; t < nt; t += 2) {
            const bool last = (t == nt - 2);
            const char* a1 = cA + (size_t)(t + 1) * kstep;
            const char* a2 = last ? nA : cA + (size_t)(t + 2) * kstep; const char* b2 = last ? nB : cB + (size_t)(t + 2) * kstep;
            const char* a3 = a2 + kstep; const char* b3 = b2 + kstep;
            PG8_LDB(B0, 0, 0); PG8_SCHED; PG8_LDA(At, 0, 0); PG8_STAGE(PG8_SA(1, 1), a1 + hstep, voffA);
            PG8_WAIT_L(8); PG8_BAR; PG8_WAIT_L(0); PG8_MMA(0, 0, At, B0); PG8_BAR; PG8_SCHED;
            PG8_LDB(B1, 0, 1); PG8_STAGE(PG8_SB(0, 0), b2, voffB);
            PG8_BAR; PG8_WAIT_L(0); PG8_MMA(0, 1, At, B1); PG8_BAR;
            PG8_LDA(At, 0, 1); PG8_STAGE(PG8_SA(0, 0), a2, voffA);
            PG8_BAR; PG8_WAIT_L(0); PG8_MMA(1, 0, At, B0); PG8_BAR; PG8_SCHED;
            PG8_STAGE(PG8_SB(0, 1), b2 + hstep, voffB);
            PG8_WAIT_V(6); PG8_BAR; PG8_MMA(1, 1, At, B1); PG8_BAR;
            PG8_LDB(B0, 1, 0); PG8_SCHED; PG8_LDA(At, 1, 0); PG8_STAGE(PG8_SA(0, 1), a2 + hstep, voffA);
            PG8_WAIT_L(8); PG8_BAR; PG8_WAIT_L(0); PG8_MMA(0, 0, At, B0); PG8_BAR; PG8_SCHED;
            PG8_LDB(B1, 1, 1); PG8_STAGE(PG8_SB(1, 0), b3, voffB);
            PG8_BAR; PG8_WAIT_L(0); PG8_MMA(0, 1, At, B1); PG8_BAR;
            PG8_LDA(At, 1, 1); PG8_STAGE(PG8_SA(1, 0), a3, voffA);
            PG8_BAR; PG8_WAIT_L(0); PG8_MMA(1, 0, At, B0); PG8_BAR; PG8_SCHED;
            PG8_STAGE(PG8_SB(1, 1), b3 + hstep, voffB);
            PG8_WAIT_V(6); PG8_BAR; PG8_MMA(1, 1, At, B1); PG8_BAR;
        }
        if constexpr (Epi::ALIGNED) { if (wr == 0) PG8_BAR; }
        E(acc, cur, wr, wc, fr, fq);
        if (!has_next) break;
#pragma unroll
        for (int a = 0; a < 2; ++a)
#pragma unroll
            for (int b = 0; b < 2; ++b)
#pragma unroll
                for (int m = 0; m < 4; ++m)
#pragma unroll
                    for (int n = 0; n < 2; ++n) acc[a][b][m][n] = (f32x4){0.f, 0.f, 0.f, 0.f};
        cur = nxt; cA = nA; cB = nB; ++ui;
        if constexpr (Epi::ALIGNED) { if (wr == 1) PG8_BAR; }
    }
    PG8_WAIT_V(0);
    if constexpr (!Epi::ALIGNED) { if (wr == 0) PG8_BAR; }
    PG8_BAR;
#undef PG8_SA
#undef PG8_SB
#undef PG8_STAGE
#undef PG8_LDA
#undef PG8_LDB
#undef PG8_MMA
#undef PG8_WAIT_V
#undef PG8_WAIT_L
#undef PG8_BAR
#undef PG8_SCHED
}
}
using pg8::Unit;

struct EpiAda {
    static constexpr bool PERM = false, ALIGNED = false;
    float* mod; const float* b_mix; const float* b_ffn;
    __device__ __forceinline__ void operator()(const f32x4 (&acc)[2][2][4][2], const Unit& u, int wr, int wc, int fr, int fq) const {
#pragma unroll
        for (int ai = 0; ai < 2; ++ai)
#pragma unroll
            for (int m = 0; m < 4; ++m) {
                const int r = u.pm * 256 + ai * 128 + wr * 64 + m * 16 + fr;
#pragma unroll
                for (int bj = 0; bj < 2; ++bj)
#pragma unroll
                    for (int n = 0; n < 2; ++n) {
                        const int c = u.pn * 256 + bj * 128 + wc * 32 + n * 16 + fq * 4;
                        const f32x4 bv = c < 3072 ? *(const f32x4*)(b_mix + c) : *(const f32x4*)(b_ffn + c - 3072);
                        *(f32x4*)(mod + (size_t)r * 6144 + c) = acc[ai][bj][m][n] + bv;
                    }
            }
    }
};

struct EpiIn {
    static constexpr bool PERM = true, ALIGNED = true;
    bf16_t* Z; const float* ropeA; const float* ropeR; float* out;
    __device__ __forceinline__ void operator()(const f32x4 (&acc)[2][2][4][2], const Unit& u, int wr, int wc, int fr, int fq) const {
        int region[2], cbv[2]; const float* tab[2]; int tstride[2], toff[2]; bool rot[2];
#pragma unroll
        for (int bj = 0; bj < 2; ++bj) {
            const int cb128 = u.pn * 256 + bj * 128;
            const int cb = cb128 + wc * 32 + fq * 8; cbv[bj] = cb;
            region[bj] = cb128 < 512 ? 0 : (cb128 < 640 ? 1 : (cb128 < 768 ? 2 : (cb128 < 1280 ? 3 : (cb128 < 1792 ? 4 : 5))));
            if (region[bj] <= 1) { const int p = cb & 63; rot[bj] = p < 16; tab[bj] = ropeA; tstride[bj] = 16; toff[bj] = 4 * (p >> 3); }
            else if (region[bj] == 3 || region[bj] == 4) { rot[bj] = true; tab[bj] = ropeR; tstride[bj] = 128; toff[bj] = 4 * ((cb & 127) >> 3); }
            else { rot[bj] = false; tab[bj] = ropeR; tstride[bj] = 128; toff[bj] = 0; }
        }
        f32x4 csn[2], snn[2];
        auto load_tab = [&](int k) {
            const int r0 = u.pm * 256 + (k >> 2) * 128 + wr * 64 + (k & 3) * 16;
            const int r = r0 + fr, pos = r < TP ? (r & 4095) : 4096;
#pragma unroll
            for (int bj = 0; bj < 2; ++bj) if (rot[bj] && r0 < TV) { const float* t = tab[bj] + pos * tstride[bj] + toff[bj]; csn[bj] = *(const f32x4*)t; snn[bj] = *(const f32x4*)(t + (tstride[bj] >> 1)); }
        };
        load_tab(0);
#pragma unroll
        for (int k = 0; k < 8; ++k) {
            const int ai = k >> 2, m = k & 3;
            const int r0 = u.pm * 256 + ai * 128 + wr * 64 + m * 16;
            const f32x4 cs0 = csn[0], cs1 = csn[1], sn0 = snn[0], sn1 = snn[1];
            if (k < 7) load_tab(k + 1);
            if (r0 >= TV) continue;
            const int r = r0 + fr;
            const int pos = r < TP ? (r & 4095) : 4096;
#pragma unroll
            for (int bj = 0; bj < 2; ++bj) {
                const int cb = cbv[bj];
                f32x4 v0 = acc[ai][bj][m][0], v1 = acc[ai][bj][m][1];
                if (rot[bj]) {
                    const f32x4 cs = bj ? cs1 : cs0, sn = bj ? sn1 : sn0;
                    f32x4 a = v0 * cs - v1 * sn, b = v1 * cs + v0 * sn;
                    if (region[bj] == 4) { a *= RK_SCALE; b *= RK_SCALE; }
                    v0 = a; v1 = b;
                }
                u32x4 pk; pk[0] = cvt_pk_bf16(v0[0], v0[1]); pk[1] = cvt_pk_bf16(v0[2], v0[3]); pk[2] = cvt_pk_bf16(v1[0], v1[1]); pk[3] = cvt_pk_bf16(v1[2], v1[3]);
                *(u32x4*)(Z + (size_t)r * INW + cb) = pk;
                if (region[bj] == 1 || region[bj] == 2) {
                    const int kvh = (cb >> 6) & 1, p = cb & 63;
                    int d0 = p, d1 = p + 4;
                    if (region[bj] == 1 && p < 16) { const int grp = p >> 3; d0 = 4 * grp; d1 = 8 + 4 * grp; }
                    float* dst = nullptr;
                    if (r < TP) { if (pos >= SEQ - 128) dst = out + (region[bj] == 1 ? O_KP : O_VP) + ((size_t)((r >> 12) * 128 + (pos - (SEQ - 128))) * 2 + kvh) * 64; }
                    else dst = out + (region[bj] == 1 ? O_KS : O_VS) + ((size_t)((r - TP) * 128 + 127) * 2 + kvh) * 64;
                    if (dst) { *(f32x4*)(dst + d0) = v0; *(f32x4*)(dst + d1) = v1; }
                }
            }
        }
    }
};

__device__ __forceinline__ void wait_ge(unsigned* pc, unsigned target, unsigned* tmo) {
    unsigned sp = 0;
    while (__hip_atomic_load(pc, __ATOMIC_RELAXED, __HIP_MEMORY_SCOPE_AGENT) < target) {
        __builtin_amdgcn_s_sleep(1);
        if ((++sp & 1023u) == 0u) { if (__hip_atomic_load(tmo, __ATOMIC_RELAXED, __HIP_MEMORY_SCOPE_AGENT) != 0u) break;
                                    if (sp > (1u << 21)) { __hip_atomic_store(tmo, 1u, __ATOMIC_RELAXED, __HIP_MEMORY_SCOPE_AGENT); break; } }
    }
}
template <bool BASE_BF16, bool OUT_BF16>
struct EpiLn {
    static constexpr bool PERM = false, ALIGNED = true;
    const void* base; void* Y; const float* mod; int gate_off; float* stat; unsigned* cnt; const float* lw; const float* lb; bf16_t* H; int h_off; unsigned* tmo;
    __device__ __forceinline__ void operator()(f32x4 (&acc)[2][2][4][2], const Unit& u, int wr, int wc, int fr, int fq) const {
        const float* mrow = mod + (size_t)(128 + (u.pm >> 4)) * 6144 + u.pn * 256;
        const size_t torg = (size_t)u.pm * 256 * DM + u.pn * 256;
        const float* tbf = (const float*)base + torg; const bf16_t* tbh = (const bf16_t*)base + torg; float* tyf = (float*)Y + torg; bf16_t* tyh = (bf16_t*)Y + torg; float* ts = stat + (size_t)u.pm * 512;
        const unsigned lo = (unsigned)((wr * 64 + fr) * DM + wc * 32 + fq * 4), lc = (unsigned)(wc * 32 + fq * 4), lrw = (unsigned)(wr * 64 + fr);
        f32x4 gv[2][2];
#pragma unroll
        for (int bj = 0; bj < 2; ++bj)
#pragma unroll
            for (int n = 0; n < 2; ++n) gv[bj][n] = 1.f + *(const f32x4*)(mrow + gate_off + lc + (bj * 128 + n * 16));
        float sv[8], ssv[8];
        unsigned lod[2] = {lo, lo};
#pragma unroll
        for (int k = 0; k < 8; ++k) {
            const int ai = k >> 2, m = k & 3;
            const unsigned lk = lod[k & 1];
            float s = 0.f, ss = 0.f;
#pragma unroll
            for (int bj = 0; bj < 2; ++bj)
#pragma unroll
                for (int n = 0; n < 2; ++n) {
                    f32x4 xv;
                    if constexpr (BASE_BF16) { const u32x2 xb = *(const u32x2*)(tbh + lk + ((ai * 128 + m * 16) * DM + bj * 128 + n * 16)); xv = (f32x4){bflo(xb[0]), bfhi(xb[0]), bflo(xb[1]), bfhi(xb[1])}; }
                    else xv = *(const f32x4*)(tbf + lk + ((ai * 128 + m * 16) * DM + bj * 128 + n * 16));
                    const f32x4 res = ALPHA * xv + gv[bj][n] * acc[ai][bj][m][n];
                    acc[ai][bj][m][n] = res;
                    s += res[0] + res[1] + res[2] + res[3];
                    ss += res[0] * res[0] + res[1] * res[1] + res[2] * res[2] + res[3] * res[3];
                }
            sv[k] = s; ssv[k] = ss;
            asm volatile("" : "+v"(lod[k & 1]) : "v"(s));
        }
#pragma unroll
        for (int k = 0; k < 8; ++k) {
            float s = sv[k], ss = ssv[k];
            s += __shfl_xor(s, 16); ss += __shfl_xor(ss, 16);
            s += __shfl_xor(s, 32); ss += __shfl_xor(ss, 32);
            if (fq == 0) { float* sp = ts + 2 * (lrw + (k >> 2) * 128 + (k & 3) * 16); __hip_atomic_fetch_add(sp, s, __ATOMIC_RELAXED, __HIP_MEMORY_SCOPE_AGENT); __hip_atomic_fetch_add(sp + 1, ss, __ATOMIC_RELAXED, __HIP_MEMORY_SCOPE_AGENT); }
        }
        asm volatile("s_waitcnt vmcnt(0)" ::: "memory");
        unsigned* pc = cnt + (u.pm * 2 + wr) * 16;
        if (fr + fq == 0) __hip_atomic_fetch_add(pc, 1u, __ATOMIC_RELAXED, __HIP_MEMORY_SCOPE_AGENT);
        wait_ge(pc, 16u, tmo);
        asm volatile("" ::: "memory");
        float sa8[8], sb8[8];
#pragma unroll
        for (int k = 0; k < 8; ++k) { const float* sp = ts + 2 * (lrw + (k >> 2) * 128 + (k & 3) * 16);
            sa8[k] = __hip_atomic_load(sp, __ATOMIC_RELAXED, __HIP_MEMORY_SCOPE_AGENT); sb8[k] = __hip_atomic_load(sp + 1, __ATOMIC_RELAXED, __HIP_MEMORY_SCOPE_AGENT); }
#pragma unroll
        for (int ai = 0; ai < 2; ++ai)
#pragma unroll
            for (int m = 0; m < 4; ++m) {
                const float sa = sa8[ai * 4 + m], sb = sb8[ai * 4 + m];
                const float mu = sa * (1.f / 1024.f), var = sb * (1.f / 1024.f) - mu * mu, rstd = rsqrtf(fmaxf(var, 0.f) + 1e-5f);
#pragma unroll
                for (int bj = 0; bj < 2; ++bj)
#pragma unroll
                    for (int n = 0; n < 2; ++n) {
                        const int co = bj * 128 + n * 16;
                        const f32x4 y = (acc[ai][bj][m][n] - mu) * rstd * *(const f32x4*)(lw + u.pn * 256 + lc + co) + *(const f32x4*)(lb + u.pn * 256 + lc + co);
                        if constexpr (OUT_BF16) { u32x2 yo; yo[0] = cvt_pk_bf16(y[0], y[1]); yo[1] = cvt_pk_bf16(y[2], y[3]); *(u32x2*)(tyh + lo + ((ai * 128 + m * 16) * DM + co)) = yo; }
                        else *(f32x4*)(tyf + lo + ((ai * 128 + m * 16) * DM + co)) = y;
                        if (H) { const f32x4 hv = y * (1.f + *(const f32x4*)(mrow + h_off + 1024 + lc + co)) + *(const f32x4*)(mrow + h_off + lc + co);
                                 u32x2 o; o[0] = cvt_pk_bf16(hv[0], hv[1]); o[1] = cvt_pk_bf16(hv[2], hv[3]); *(u32x2*)(H + torg + lo + ((ai * 128 + m * 16) * DM + co)) = o; }
                    }
            }
    }
};

struct EpiUp {
    static constexpr bool PERM = true, ALIGNED = true;
    bf16_t* F;
    __device__ __forceinline__ void operator()(const f32x4 (&acc)[2][2][4][2], const Unit& u, int wr, int wc, int fr, int fq) const {
#pragma unroll
        for (int ai = 0; ai < 2; ++ai)
#pragma unroll
            for (int m = 0; m < 4; ++m) {
                const int r0 = u.pm * 256 + ai * 128 + wr * 64 + m * 16;
                if (r0 >= TV) continue;
                const int r = r0 + fr;
                float f[8];
#pragma unroll
                for (int n = 0; n < 2; ++n)
#pragma unroll
                    for (int i = 0; i < 4; ++i) { const float g = acc[ai][0][m][n][i]; f[n * 4 + i] = silu_f(g) * acc[ai][1][m][n][i]; }
                u32x4 pk; pk[0] = cvt_pk_bf16(f[0], f[1]); pk[1] = cvt_pk_bf16(f[2], f[3]); pk[2] = cvt_pk_bf16(f[4], f[5]); pk[3] = cvt_pk_bf16(f[6], f[7]);
                *(u32x4*)(F + (size_t)r * DFF + u.pn * 128 + wc * 32 + fq * 8) = pk;
            }
    }
};

__device__ __forceinline__ void prep_tiles(const Params& p, unsigned char* shm, int tt0, int tt1, int stride) {
    const int tid = threadIdx.x;
    bf16_t* tile = (bf16_t*)shm;
    for (int tt = tt0; tt < tt1; tt += stride) {
        const float* src; bf16_t* dst; int ld, K, mode, t;
        if (tt < 176) { t = tt; src = p.w_in; ld = INW; K = DM; dst = (bf16_t*)(p.ws + WS_WIN); mode = 1; }
        else if (tt < 240) { t = tt - 176; src = p.w_out; ld = DM; K = DM; dst = (bf16_t*)(p.ws + WS_WOUT); mode = 0; }
        else if (tt < 592) { t = tt - 240; src = p.w_up; ld = 2 * DFF; K = DM; dst = (bf16_t*)(p.ws + WS_WUP); mode = 2; }
        else if (tt < 768) { t = tt - 592; src = p.w_down; ld = DM; K = DFF; dst = (bf16_t*)(p.ws + WS_WDOWN); mode = 0; }
        else if (tt < 960) { t = tt - 768; src = p.w_ada_mix; ld = 3072; K = DM; dst = (bf16_t*)(p.ws + WS_WADA); mode = 0; }
        else { t = tt - 960; src = p.w_ada_ffn; ld = 3072; K = DM; dst = (bf16_t*)(p.ws + WS_WADA) + (size_t)3072 * DM; mode = 0; }
        const int nkt = K / 256, rt = t / nkt, kt = t % nkt;
        const int P = rt * 64 + (tid & 63);
        const int L = mode == 1 ? in_col(P) : (mode == 2 ? up_col(P) : P);
        const float* sp = src + (size_t)(kt * 256 + (tid >> 6)) * ld + L;
#pragma unroll
        for (int i = 0; i < 32; ++i) tile[(tid & 63) * 264 + (tid >> 6) + 8 * i] = f2bf(sp[(size_t)(8 * i) * ld]);
        __syncthreads();
        { const int pr = tid >> 3, kc = tid & 7;
#pragma unroll
          for (int j = 0; j < 4; ++j) *(u32x4*)(dst + (size_t)(rt * 64 + pr) * K + kt * 256 + (kc + 8 * j) * 8) = *(const u32x4*)(tile + pr * 264 + (kc + 8 * j) * 8); }
        __syncthreads();
    }
}
__device__ __forceinline__ void prep_misc(const Params& p) {
    const int tid = threadIdx.x;
    const int gt = blockIdx.x * 512 + tid, gs = gridDim.x * 512;
    bf16_t* sc = (bf16_t*)(p.ws + WS_SC);
    for (int i = gt; i < 256 * DM; i += gs) { const int r = i >> 10, k = i & 1023; float v = 0.f; if (r < 128) v = silu_f(p.c_sample[r * DM + k]); else if (r < 136) v = silu_f(p.c_prompt[(r - 128) * DM + k]); sc[i] = f2bf(v); }
    float* st = (float*)(p.ws + WS_STAT1);
    for (int i = gt; i < TPAD * 4; i += gs) st[i] = 0.f;
    for (int i = gt; i < 528 * 16; i += gs) ((unsigned*)(p.ws + WS_CNT))[i] = 0u;
    float* ra = (float*)(p.ws + WS_ROPEA); float* rr = (float*)(p.ws + WS_ROPER);
    for (int i = gt; i < 4097 * 72; i += gs) {
        const int pos = i / 72, f = i % 72;
        const double pv = pos < 4096 ? (double)pos : (double)PAST;
        const double inv = f < 8 ? exp(-13.122363377404328 * (double)f / 8.0) : exp(-9.210340371976184 * (double)(f - 8) / 64.0);
        const double ang = pv * inv;
        const double kk = rint(ang * 0.15915494309189535);
        const float red = (float)(ang - kk * 6.283185307179586);
        const float cs = cosf(red), sn = sinf(red);
        if (f < 8) { ra[pos * 16 + f] = cs; ra[pos * 16 + 8 + f] = sn; } else { rr[pos * 128 + (f - 8)] = cs; rr[pos * 128 + 64 + (f - 8)] = sn; }
    }
}

__device__ __forceinline__ void phase_modulate(const Params& p) {
    const float* mod = (const float*)(p.ws + WS_MOD); bf16_t* H = (bf16_t*)(p.ws + WS_H);
    const int gt = blockIdx.x * 512 + threadIdx.x, gs = gridDim.x * 512;
    constexpr int NCH = TV * 128;
    for (int i0 = gt; i0 < NCH; i0 += 4 * gs) {
        f32x4 x0[4], x1[4];
#pragma unroll
        for (int u = 0; u < 4; ++u) { const int i = i0 + u * gs; if (i < NCH) { const int r = i >> 7, c = (i & 127) * 8;
            const float* xr = r < TP ? p.x_prompt + (size_t)r * DM : p.x_sample + (size_t)(r - TP) * DM;
            x0[u] = __builtin_nontemporal_load((const f32x4*)(xr + c)); x1[u] = __builtin_nontemporal_load((const f32x4*)(xr + c + 4)); } }
#pragma unroll
        for (int u = 0; u < 4; ++u) { const int i = i0 + u * gs; if (i < NCH) { const int r = i >> 7, c = (i & 127) * 8;
            const int mrow = r < TP ? 128 + (r >> 12) : r - TP;
            const float* sh = mod + (size_t)mrow * 6144; const float* scl = sh + 1024;
            const f32x4 h0 = x0[u] * (1.f + *(const f32x4*)(scl + c)) + *(const f32x4*)(sh + c), h1 = x1[u] * (1.f + *(const f32x4*)(scl + c + 4)) + *(const f32x4*)(sh + c + 4);
            u32x4 pk; pk[0] = cvt_pk_bf16(h0[0], h0[1]); pk[1] = cvt_pk_bf16(h0[2], h0[3]); pk[2] = cvt_pk_bf16(h1[0], h1[1]); pk[3] = cvt_pk_bf16(h1[2], h1[3]);
            *(u32x4*)(H + (size_t)r * DM + c) = pk; } }
    }
}

__device__ __forceinline__ void attn_item(const Params& p, unsigned char* shm, int item) {
    const int tid = threadIdx.x, wid = tid >> 6, lane = tid & 63, lr = lane & 15, g = lane >> 4;
    const int b = item >> 6, kvh = (item >> 5) & 1, n = item & 31;
    const bf16_t* Z = (const bf16_t*)(p.ws + WS_Z); bf16_t* MIX = (bf16_t*)(p.ws + WS_MIX);
    bf16_t* Ks = (bf16_t*)shm;
    bf16_t* VT = Ks + 256 * 72;
    {
        const int key = tid >> 1, hf = tid & 1;
        const bool valid = (n > 0) || (key >= 128);
        const size_t row = (size_t)b * SEQ + (size_t)(n - 1) * 128 + key;
        const bf16_t* kp = Z + row * INW + 512 + kvh * 64 + hf * 32; const bf16_t* vp = Z + row * INW + 640 + kvh * 64 + hf * 32;
#pragma unroll
        for (int c = 0; c < 4; ++c) {
            u32x4 kv = (u32x4){0u, 0u, 0u, 0u}, vv = (u32x4){0u, 0u, 0u, 0u};
            if (valid) { kv = *(const u32x4*)(kp + c * 8); vv = *(const u32x4*)(vp + c * 8); }
            *(u32x4*)(Ks + key * 72 + hf * 32 + c * 8) = kv;
#pragma unroll
            for (int e = 0; e < 4; ++e) { const int d = hf * 32 + c * 8 + 2 * e; VT[d * 264 + key] = (bf16_t)(vv[e] & 0xffffu); VT[(d + 1) * 264 + key] = (bf16_t)(vv[e] >> 16); }
        }
    }
    __syncthreads();
    for (int qt = 0; qt < 4; ++qt) {
        const int T = wid * 4 + qt, hq = T >> 3, tq = T & 7, t0 = tq * 16, head = kvh * 4 + hq;
        const size_t qrow = (size_t)b * SEQ + (size_t)n * 128 + t0 + lr;
        bf16x8 Qf[2];
#pragma unroll
        for (int kk = 0; kk < 2; ++kk) Qf[kk] = *(const bf16x8*)(Z + qrow * INW + head * 64 + kk * 32 + g * 8);
        const int kt0 = tq < 6 ? tq : 6;
        f32x4 S[10];
#pragma unroll
        for (int jt = 0; jt < 10; ++jt) {
            S[jt] = (f32x4){0.f, 0.f, 0.f, 0.f};
#pragma unroll
            for (int kk = 0; kk < 2; ++kk) {
                const bf16x8 Kf = *(const bf16x8*)(Ks + (16 * (kt0 + jt) + lr) * 72 + kk * 32 + g * 8);
                S[jt] = __builtin_amdgcn_mfma_f32_16x16x32_bf16(Kf, Qf[kk], S[jt], 0, 0, 0);
            }
        }
        const float sink = p.att_sinks[head];
        const int t = t0 + lr;
        float mx = sink;
#pragma unroll
        for (int jt = 0; jt < 10; ++jt)
#pragma unroll
            for (int r = 0; r < 4; ++r) {
                const int i = 16 * (kt0 + jt) + 4 * g + r, dist = 128 + t - i;
                const bool ok = dist >= 0 && dist <= 128 && (n > 0 || i >= 128);
                const float s = ok ? S[jt][r] * 0.125f : -INFINITY;
                S[jt][r] = s; mx = fmaxf(mx, s);
            }
        mx = fmaxf(mx, __shfl_xor(mx, 16)); mx = fmaxf(mx, __shfl_xor(mx, 32));
        float sum = 0.f;
#pragma unroll
        for (int jt = 0; jt < 10; ++jt)
#pragma unroll
            for (int r = 0; r < 4; ++r) { const float e = __expf(S[jt][r] - mx); S[jt][r] = e; sum += e; }
        sum += __shfl_xor(sum, 16); sum += __shfl_xor(sum, 32);
        const float inv = 1.f / (sum + __expf(sink - mx));
        f32x4 O[4];
#pragma unroll
        for (int dt = 0; dt < 4; ++dt) O[dt] = (f32x4){0.f, 0.f, 0.f, 0.f};
#pragma unroll
        for (int jp = 0; jp < 5; ++jp) {
            u32x4 pu; pu[0] = cvt_pk_bf16(S[2 * jp][0] * inv, S[2 * jp][1] * inv); pu[1] = cvt_pk_bf16(S[2 * jp][2] * inv, S[2 * jp][3] * inv);
            pu[2] = cvt_pk_bf16(S[2 * jp + 1][0] * inv, S[2 * jp + 1][1] * inv); pu[3] = cvt_pk_bf16(S[2 * jp + 1][2] * inv, S[2 * jp + 1][3] * inv);
            const bf16x8 Pf = __builtin_bit_cast(bf16x8, pu);
#pragma unroll
            for (int dt = 0; dt < 4; ++dt) {
                const bf16_t* vr = VT + (16 * dt + lr) * 264 + 16 * (kt0 + 2 * jp) + 4 * g;
                const u32x2 a0 = *(const u32x2*)vr, a1 = *(const u32x2*)(vr + 16);
                u32x4 au; au[0] = a0[0]; au[1] = a0[1]; au[2] = a1[0]; au[3] = a1[1];
                O[dt] = __builtin_amdgcn_mfma_f32_16x16x32_bf16(__builtin_bit_cast(bf16x8, au), Pf, O[dt], 0, 0, 0);
            }
        }
#pragma unroll
        for (int dt = 0; dt < 4; ++dt) {
            u32x2 o; o[0] = cvt_pk_bf16(O[dt][0], O[dt][1]); o[1] = cvt_pk_bf16(O[dt][2], O[dt][3]);
            *(u32x2*)(MIX + qrow * DM + head * 64 + 16 * dt + 4 * g) = o;
        }
    }
    __syncthreads();
}

__device__ __forceinline__ void retu_item(const Params& p, unsigned char* shm, int item) {
    const int tid = threadIdx.x, wid = tid >> 6, lane = tid & 63, lr = lane & 15, g = lane >> 4;
    const int b = item >> 7, h = (item >> 5) & 3, c = item & 31;
    const bf16_t* Z = (const bf16_t*)(p.ws + WS_Z); float* UT = (float*)(p.ws + WS_H);
    bf16_t* KT = (bf16_t*)shm;
    bf16_t* VT = KT + 128 * 136;
    const float lg = log_gamma(h);
    {
        const int j = tid >> 2, q = tid & 3;
        const size_t row = (size_t)b * SEQ + (size_t)c * 128 + j;
        const float dec = __expf(lg * (float)(127 - j));
        const bf16_t* kp = Z + row * INW + 1280 + h * 128 + q * 32; const bf16_t* vp = Z + row * INW + 1792 + h * 128 + q * 32;
#pragma unroll
        for (int cc = 0; cc < 4; ++cc) {
            const u32x4 kv = *(const u32x4*)(kp + cc * 8), vv = *(const u32x4*)(vp + cc * 8);
#pragma unroll
            for (int e = 0; e < 4; ++e) {
                const int d = q * 32 + cc * 8 + 2 * e;
                KT[d * 136 + j] = f2bf(bflo(kv[e]) * dec); KT[(d + 1) * 136 + j] = f2bf(bfhi(kv[e]) * dec);
                VT[d * 136 + j] = (bf16_t)(vv[e] & 0xffffu); VT[(d + 1) * 136 + j] = (bf16_t)(vv[e] >> 16);
            }
        }
    }
    __syncthreads();
    f32x4 acc[8];
#pragma unroll
    for (int dt = 0; dt < 8; ++dt) acc[dt] = (f32x4){0.f, 0.f, 0.f, 0.f};
#pragma unroll
    for (int kk = 0; kk < 4; ++kk) {
        const bf16x8 Bf = *(const bf16x8*)(VT + (16 * wid + lr) * 136 + kk * 32 + g * 8);
#pragma unroll
        for (int dt = 0; dt < 8; ++dt) {
            const bf16x8 Af = *(const bf16x8*)(KT + (16 * dt + lr) * 136 + kk * 32 + g * 8);
            acc[dt] = __builtin_amdgcn_mfma_f32_16x16x32_bf16(Af, Bf, acc[dt], 0, 0, 0);
        }
    }
    float* up = UT + (size_t)item * 16384 + (size_t)(16 * wid + lr) * 128;
#pragma unroll
    for (int dt = 0; dt < 8; ++dt) *(f32x4*)(up + 16 * dt + 4 * g) = acc[dt];
    __syncthreads();
}

__device__ __forceinline__ void phase_scan(const Params& p) {
    const float* UT = (const float*)(p.ws + WS_H); bf16_t* SST = (bf16_t*)(p.ws + WS_SST);
    const int gt = blockIdx.x * 512 + threadIdx.x, gs = gridDim.x * 512;
    for (int i = gt; i < 32 * 4096; i += gs) {
        const int bh = i >> 12, ed = (i & 4095) * 4, e = ed >> 7, d = ed & 127, h = bh & 3;
        const float gL = __expf(log_gamma(h) * 128.f);
        f32x4 s = (f32x4){0.f, 0.f, 0.f, 0.f};
        const float* up = UT + (size_t)bh * 32 * 16384 + ed; bf16_t* sp = SST + (size_t)bh * 32 * 16384 + ed;
#pragma unroll
        for (int c0 = 0; c0 < 32; c0 += 16) {
            f32x4 uv[16];
#pragma unroll
            for (int c = 0; c < 16; ++c) uv[c] = __builtin_nontemporal_load((const f32x4*)(up + (size_t)(c0 + c) * 16384));
#pragma unroll
            for (int c = 0; c < 16; ++c) { u32x2 o; o[0] = cvt_pk_bf16(s[0], s[1]); o[1] = cvt_pk_bf16(s[2], s[3]); *(u32x2*)(sp + (size_t)(c0 + c) * 16384) = o; s = gL * s + uv[c]; }
        }
#pragma unroll
        for (int k = 0; k < 4; ++k) p.out[O_RP + ((size_t)bh * 128 + ret_dim(d + k)) * 128 + e] = s[k];
    }
}

typedef short s16x4 __attribute__((ext_vector_type(4)));
__device__ __forceinline__ u32x2 lds_tr_read(const bf16_t* addr) {
    const s16x4 r = __builtin_amdgcn_ds_read_tr16_b64_v4i16((LAS s16x4*)(LAS void*)(unsigned)(size_t)addr);
    return __builtin_bit_cast(u32x2, r);
}
__device__ __forceinline__ void reto_load(const Params& p, int item, u32x4 (&kv)[4], u32x4 (&vv)[4], u32x4 (&sv)[4]) {
    const int tid = threadIdx.x, b = item >> 7, h = (item >> 5) & 3, c = item & 31;
    const bf16_t* Z = (const bf16_t*)(p.ws + WS_Z); const bf16_t* SST = (const bf16_t*)(p.ws + WS_SST);
    const size_t row0 = (size_t)b * SEQ + (size_t)c * 128;
    const int j = tid >> 2, q = tid & 3;
    const bf16_t* kp = Z + (row0 + j) * INW + 1280 + h * 128 + q * 32; const bf16_t* vp = Z + (row0 + j) * INW + 1792 + h * 128 + q * 32;
    const bf16_t* sp = SST + (size_t)item * 16384 + j * 128 + q * 32;
#pragma unroll
    for (int cc = 0; cc < 4; ++cc) { kv[cc] = *(const u32x4*)(kp + cc * 8); vv[cc] = *(const u32x4*)(vp + cc * 8); sv[cc] = *(const u32x4*)(sp + cc * 8); }
}
__device__ __forceinline__ void reto_phase(const Params& p, unsigned char* shm, int first, int stride) {
    u32x4 kvr[4], vvr[4], svr[4];
    if (first < 1024) reto_load(p, first, kvr, vvr, svr);
    for (int item = first; item < 1024; item += stride) {
    const int tid = threadIdx.x, wid = tid >> 6, lane = tid & 63, lr = lane & 15, g = lane >> 4;
    const int b = item >> 7, h = (item >> 5) & 3, c = item & 31;
    const bf16_t* Z = (const bf16_t*)(p.ws + WS_Z); bf16_t* MIX = (bf16_t*)(p.ws + WS_MIX);
    bf16_t* Ks = (bf16_t*)shm;
    bf16_t* VT = Ks + 128 * 136;
    bf16_t* Ss = VT + 128 * 136;
    const float lg = log_gamma(h);
    const size_t row0 = (size_t)b * SEQ + (size_t)c * 128;
    {
        const int j = tid >> 2, q = tid & 3;
#pragma unroll
        for (int cc = 0; cc < 4; ++cc) {
            *(u32x4*)(Ks + j * 136 + q * 32 + cc * 8) = kvr[cc];
            *(u32x4*)(Ss + j * 136 + q * 32 + cc * 8) = svr[cc];
            *(u32x4*)(VT + j * 136 + q * 32 + cc * 8) = vvr[cc];
        }
    }
    __syncthreads();
    const size_t qrow = row0 + 16 * wid + lr;
    bf16x8 Qf[4];
#pragma unroll
    for (int kk = 0; kk < 4; ++kk) Qf[kk] = *(const bf16x8*)(Z + qrow * INW + 768 + h * 128 + kk * 32 + g * 8);
    if (item + stride < 1024) reto_load(p, item + stride, kvr, vvr, svr);
    f32x4 S[8];
#pragma unroll
    for (int jt = 0; jt < 8; ++jt) {
        S[jt] = (f32x4){0.f, 0.f, 0.f, 0.f};
        if (jt <= wid) {
#pragma unroll
            for (int kk = 0; kk < 4; ++kk) {
                const bf16x8 Kf = *(const bf16x8*)(Ks + (16 * jt + lr) * 136 + kk * 32 + g * 8);
                S[jt] = __builtin_amdgcn_mfma_f32_16x16x32_bf16(Kf, Qf[kk], S[jt], 0, 0, 0);
            }
        }
    }
    const int it = 16 * wid + lr;
#pragma unroll
    for (int jt = 0; jt < 8; ++jt)
#pragma unroll
        for (int r = 0; r < 4; ++r) { const int j = 16 * jt + 4 * g + r; S[jt][r] = (j <= it) ? S[jt][r] * __expf(lg * (float)(it - j)) : 0.f; }
    f32x4 O1[8], O2[8];
#pragma unroll
    for (int et = 0; et < 8; ++et) { O1[et] = (f32x4){0.f, 0.f, 0.f, 0.f}; O2[et] = (f32x4){0.f, 0.f, 0.f, 0.f}; }
#pragma unroll
    for (int jp = 0; jp < 4; ++jp) {
        if (2 * jp <= wid) {
            u32x4 pu; pu[0] = cvt_pk_bf16(S[2 * jp][0], S[2 * jp][1]); pu[1] = cvt_pk_bf16(S[2 * jp][2], S[2 * jp][3]);
            pu[2] = cvt_pk_bf16(S[2 * jp + 1][0], S[2 * jp + 1][1]); pu[3] = cvt_pk_bf16(S[2 * jp + 1][2], S[2 * jp + 1][3]);
            const bf16x8 Pf = __builtin_bit_cast(bf16x8, pu);
#pragma unroll
            for (int et = 0; et < 8; ++et) {
                const bf16_t* vr = VT + (32 * jp + 4 * g + (lr >> 2)) * 136 + 16 * et + 4 * (lr & 3);
                const u32x2 a0 = lds_tr_read(vr), a1 = lds_tr_read(vr + 16 * 136);
                u32x4 au; au[0] = a0[0]; au[1] = a0[1]; au[2] = a1[0]; au[3] = a1[1];
                O1[et] = __builtin_amdgcn_mfma_f32_16x16x32_bf16(__builtin_bit_cast(bf16x8, au), Pf, O1[et], 0, 0, 0);
            }
        }
    }
#pragma unroll
    for (int kk = 0; kk < 4; ++kk)
#pragma unroll
        for (int et = 0; et < 8; ++et) {
            const bf16x8 Sf = *(const bf16x8*)(Ss + (16 * et + lr) * 136 + kk * 32 + g * 8);
            O2[et] = __builtin_amdgcn_mfma_f32_16x16x32_bf16(Sf, Qf[kk], O2[et], 0, 0, 0);
        }
    const float qd = __expf(lg * (float)(it + 1));
    float sum = 0.f;
#pragma unroll
    for (int et = 0; et < 8; ++et)
#pragma unroll
        for (int r = 0; r < 4; ++r) { const float o = O1[et][r] + qd * O2[et][r]; O1[et][r] = o; sum += o; }
    sum += __shfl_xor(sum, 16); sum += __shfl_xor(sum, 32);
    const float mu = sum * (1.f / 128.f);
    float vs = 0.f;
#pragma unroll
    for (int et = 0; et < 8; ++et)
#pragma unroll
        for (int r = 0; r < 4; ++r) { const float dlt = O1[et][r] - mu; vs += dlt * dlt; }
    vs += __shfl_xor(vs, 16); vs += __shfl_xor(vs, 32);
    const float rstd = rsqrtf(vs * (1.f / 128.f) + 1e-6f);
#pragma unroll
    for (int et = 0; et < 8; ++et) {
        const int e = 16 * et + 4 * g;
        const u32x2 gz = *(const u32x2*)(Z + qrow * INW + 2304 + h * 128 + e);
        const f32x4 gw = *(const f32x4*)(p.ret_gn_w + h * 128 + e);
        const float r0 = (O1[et][0] - mu) * rstd * gw[0] * silu_f(bflo(gz[0])), r1 = (O1[et][1] - mu) * rstd * gw[1] * silu_f(bfhi(gz[0]));
        const float r2 = (O1[et][2] - mu) * rstd * gw[2] * silu_f(bflo(gz[1])), r3 = (O1[et][3] - mu) * rstd * gw[3] * silu_f(bfhi(gz[1]));
        u32x2 o; o[0] = cvt_pk_bf16(r0, r1); o[1] = cvt_pk_bf16(r2, r3);
        *(u32x2*)(MIX + qrow * DM + 512 + h * 128 + e) = o;
    }
    __syncthreads();
    }
}

__device__ __forceinline__ void sample_att(const Params& p, unsigned char* shm, int b) {
    const int tid = threadIdx.x, wid = tid >> 6, lane = tid & 63;
    const bf16_t* zrow = (const bf16_t*)(p.ws + WS_Z) + (size_t)(TP + b) * INW; bf16_t* mixrow = (bf16_t*)(p.ws + WS_MIX) + (size_t)(TP + b) * DM;
    float* sm = (float*)shm;
    float* qn = sm;
    float* kn = qn + 512;
    float* vn = kn + 128;
    float* scs = vn + 128;
    { const int hh = tid >> 6, pp = tid & 63; qn[hh * 64 + att_dim(pp)] = bf2f(zrow[tid]); }
    if (tid < 128) { const int hh = tid >> 6, pp = tid & 63; kn[hh * 64 + att_dim(pp)] = bf2f(zrow[512 + tid]); vn[tid] = bf2f(zrow[640 + tid]); }
    __syncthreads();
    const float* ck = p.cache_k + (size_t)b * 128 * 128; const float* cv = p.cache_v + (size_t)b * 128 * 128;
#pragma unroll
    for (int itr = 0; itr < 2; ++itr) {
        const int idx = tid + 512 * itr, hd = idx >> 7, w = idx & 127, kvh = hd >> 2;
        const float* kr = ck + (w * 2 + kvh) * 64; const float* qr = qn + hd * 64;
        float s = 0.f;
#pragma unroll
        for (int d = 0; d < 64; d += 4) { const f32x4 kv = *(const f32x4*)(kr + d); s += qr[d] * kv[0] + qr[d + 1] * kv[1] + qr[d + 2] * kv[2] + qr[d + 3] * kv[3]; }
        scs[hd * 132 + w] = s * 0.125f;
    }
    if (tid < 8) { const int kvh = tid >> 2; float s = 0.f; for (int d = 0; d < 64; ++d) s += qn[tid * 64 + d] * kn[kvh * 64 + d]; scs[tid * 132 + 128] = s * 0.125f; }
    __syncthreads();
    {
        const float sink = p.att_sinks[wid];
        const float s0 = scs[wid * 132 + lane], s1 = scs[wid * 132 + 64 + lane], s2 = lane == 0 ? scs[wid * 132 + 128] : -INFINITY;
        float mx = fmaxf(fmaxf(s0, s1), fmaxf(s2, sink));
#pragma unroll
        for (int o = 32; o >= 1; o >>= 1) mx = fmaxf(mx, __shfl_xor(mx, o));
        const float e0 = __expf(s0 - mx), e1 = __expf(s1 - mx), e2 = lane == 0 ? __expf(s2 - mx) : 0.f;
        float sum = e0 + e1 + e2;
#pragma unroll
        for (int o = 32; o >= 1; o >>= 1) sum += __shfl_xor(sum, o);
        const float inv = 1.f / (sum + __expf(sink - mx));
        scs[wid * 132 + lane] = e0 * inv; scs[wid * 132 + 64 + lane] = e1 * inv; if (lane == 0) scs[wid * 132 + 128] = e2 * inv;
    }
    __syncthreads();
    {
        const int hd = tid >> 6, d = tid & 63, kvh = hd >> 2;
        float o = scs[hd * 132 + 128] * vn[kvh * 64 + d];
#pragma unroll 16
        for (int w = 0; w < 128; ++w) o += scs[hd * 132 + w] * cv[(w * 2 + kvh) * 64 + d];
        mixrow[hd * 64 + d] = f2bf(o);
    }
    for (int i = tid; i < 127 * 32; i += 512) {
        *(f32x4*)(p.out + O_KS + (size_t)b * 16384 + i * 4) = *(const f32x4*)(ck + 128 + i * 4);
        *(f32x4*)(p.out + O_VS + (size_t)b * 16384 + i * 4) = *(const f32x4*)(cv + 128 + i * 4);
    }
    __syncthreads();
}
__device__ __forceinline__ void sample_ret(const Params& p, unsigned char* shm, int item) {
    const int tid = threadIdx.x, b = item >> 2, h = item & 3;
    const bf16_t* zrow = (const bf16_t*)(p.ws + WS_Z) + (size_t)(TP + b) * INW; bf16_t* mixrow = (bf16_t*)(p.ws + WS_MIX) + (size_t)(TP + b) * DM;
    float* sm = (float*)shm;
    float* rqn = sm;
    float* rkn = rqn + 128;
    float* red = rkn + 128;
    float* qkp = red + 512;
    float* ov = qkp + 4;
    if (tid < 128) { const int dn = ret_dim(tid); rqn[dn] = bf2f(zrow[768 + h * 128 + tid]); rkn[dn] = bf2f(zrow[1280 + h * 128 + tid]); }
    __syncthreads();
    const float gm = __expf(log_gamma(h));
    const int e = tid & 127, dq = tid >> 7;
    const float* sp = p.state_ret + ((size_t)(b * 4 + h) * 128 + dq * 32) * 128 + e;
    float* so = p.out + O_RS + ((size_t)(b * 4 + h) * 128 + dq * 32) * 128 + e;
    const float ve = bf2f(zrow[1792 + h * 128 + e]);
    float sv[32];
#pragma unroll
    for (int d = 0; d < 32; ++d) sv[d] = sp[d * 128];
    float part = 0.f, qk = 0.f;
#pragma unroll
    for (int d = 0; d < 32; ++d) { const float qd = rqn[dq * 32 + d], kd = rkn[dq * 32 + d]; part += qd * sv[d]; qk += qd * kd; so[d * 128] = gm * sv[d] + kd * ve; }
    red[dq * 128 + e] = part; if (e == 0) qkp[dq] = qk;
    __syncthreads();
    if (tid < 128) ov[tid] = (qkp[0] + qkp[1] + qkp[2] + qkp[3]) * ve + gm * (red[e] + red[128 + e] + red[256 + e] + red[384 + e]);
    __syncthreads();
    if (tid < 64) {
        const float o0 = ov[tid], o1 = ov[tid + 64];
        float sum = o0 + o1;
#pragma unroll
        for (int o = 32; o >= 1; o >>= 1) sum += __shfl_xor(sum, o);
        const float mu = sum * (1.f / 128.f);
        float vs = (o0 - mu) * (o0 - mu) + (o1 - mu) * (o1 - mu);
#pragma unroll
        for (int o = 32; o >= 1; o >>= 1) vs += __shfl_xor(vs, o);
        const float rstd = rsqrtf(vs * (1.f / 128.f) + 1e-6f);
#pragma unroll
        for (int k = 0; k < 2; ++k) { const int ee = tid + 64 * k; const float gz = bf2f(zrow[2304 + h * 128 + ee]);
            mixrow[512 + h * 128 + ee] = f2bf(((k ? o1 : o0) - mu) * rstd * p.ret_gn_w[h * 128 + ee] * silu_f(gz)); }
    }
    __syncthreads();
}

template <int NB>
__device__ __forceinline__ void sg_mma(unsigned char* shm, const bf16_t* A, const bf16_t* b0, const bf16_t* b1, int K, f32x4& out0, f32x4& out1) {
    const int tid = threadIdx.x, wid = tid >> 6, lane = tid & 63, lr = lane & 15, g = lane >> 4;
    const int ks = K >> 3;
    const bf16_t* ap = A + (size_t)(TP + lr) * K + 8 * g + wid * ks;
    b0 += wid * ks; if (NB == 2) b1 += wid * ks;
    f32x4 acc[8][NB];
#pragma unroll
    for (int rg = 0; rg < 8; ++rg)
#pragma unroll
        for (int nb = 0; nb < NB; ++nb) acc[rg][nb] = (f32x4){0.f, 0.f, 0.f, 0.f};
    for (int k = 0; k < ks; k += 32) {
        const bf16x8 w0 = *(const bf16x8*)(b0 + k);
        bf16x8 w1 = w0; if (NB == 2) w1 = *(const bf16x8*)(b1 + k);
        bf16x8 a[8];
#pragma unroll
        for (int rg = 0; rg < 8; ++rg) a[rg] = *(const bf16x8*)(ap + (size_t)(16 * rg) * K + k);
#pragma unroll
        for (int rg = 0; rg < 8; ++rg) {
            acc[rg][0] = __builtin_amdgcn_mfma_f32_16x16x32_bf16(w0, a[rg], acc[rg][0], 0, 0, 0);
            if (NB == 2) acc[rg][NB - 1] = __builtin_amdgcn_mfma_f32_16x16x32_bf16(w1, a[rg], acc[rg][NB - 1], 0, 0, 0);
        }
    }
    f32x4* red = (f32x4*)shm;
#pragma unroll
    for (int nb = 0; nb < NB; ++nb) {
        __syncthreads();
#pragma unroll
        for (int rg = 0; rg < 8; ++rg) red[(wid * 8 + rg) * 64 + lane] = acc[rg][nb];
        __syncthreads();
        f32x4 sum = red[(0 * 8 + wid) * 64 + lane];
#pragma unroll
        for (int w = 1; w < 8; ++w) sum += red[(w * 8 + wid) * 64 + lane];
        if (nb == 0) out0 = sum; else out1 = sum;
    }
    __syncthreads();
}
__device__ __forceinline__ void sg_ln(const Params& p, unsigned char* shm, int item, const bf16_t* A, const bf16_t* Bt, int K, const float* base, int gate_off, float* stat, unsigned* cnt,
                                      const float* lw, const float* lb, bf16_t* H, int h_off) {
    const int tid = threadIdx.x, wid = tid >> 6, lane = tid & 63, lr = lane & 15, g = lane >> 4;
    const int n0 = item * 16, m = 16 * wid + lr;
    f32x4 acc = (f32x4){0.f, 0.f, 0.f, 0.f}, dummy = acc;
    sg_mma<1>(shm, A, Bt + (size_t)(n0 + lr) * K + 8 * g, nullptr, K, acc, dummy);
    const int c = n0 + 4 * g;
    const float* mrow = (const float*)(p.ws + WS_MOD) + (size_t)m * 6144;
    const f32x4 xv = *(const f32x4*)(base + (size_t)m * DM + c), gv = *(const f32x4*)(mrow + gate_off + c);
    const f32x4 res = ALPHA * xv + (1.f + gv) * acc;
    float s = res[0] + res[1] + res[2] + res[3], ss = res[0] * res[0] + res[1] * res[1] + res[2] * res[2] + res[3] * res[3];
    s += __shfl_xor(s, 16); ss += __shfl_xor(ss, 16); s += __shfl_xor(s, 32); ss += __shfl_xor(ss, 32);
    if (g == 0) { __hip_atomic_fetch_add(stat + 2 * (TP + m), s, __ATOMIC_RELAXED, __HIP_MEMORY_SCOPE_AGENT); __hip_atomic_fetch_add(stat + 2 * (TP + m) + 1, ss, __ATOMIC_RELAXED, __HIP_MEMORY_SCOPE_AGENT); }
    asm volatile("s_waitcnt vmcnt(0)" ::: "memory");
    unsigned* pc = cnt + wid * 16;
    if (lane == 0) __hip_atomic_fetch_add(pc, 1u, __ATOMIC_RELAXED, __HIP_MEMORY_SCOPE_AGENT);
    wait_ge(pc, 64u, (unsigned*)(p.ws + WS_CNT) + 527 * 16 + 8);
    asm volatile("" ::: "memory");
    const float sa = __hip_atomic_load(stat + 2 * (TP + m), __ATOMIC_RELAXED, __HIP_MEMORY_SCOPE_AGENT), sb = __hip_atomic_load(stat + 2 * (TP + m) + 1, __ATOMIC_RELAXED, __HIP_MEMORY_SCOPE_AGENT);
    const float mu = sa * (1.f / 1024.f), var = sb * (1.f / 1024.f) - mu * mu, rstd = rsqrtf(fmaxf(var, 0.f) + 1e-5f);
    const f32x4 y = (res - mu) * rstd * *(const f32x4*)(lw + c) + *(const f32x4*)(lb + c);
    *(f32x4*)(p.out + O_YS + (size_t)m * DM + c) = y;
    if (H) { const f32x4 hv = y * (1.f + *(const f32x4*)(mrow + h_off + 1024 + c)) + *(const f32x4*)(mrow + h_off + c);
             u32x2 o; o[0] = cvt_pk_bf16(hv[0], hv[1]); o[1] = cvt_pk_bf16(hv[2], hv[3]); *(u32x2*)(H + (size_t)(TP + m) * DM + c) = o; }
}
__device__ __forceinline__ void sg_up(const Params& p, unsigned char* shm, int item) {
    const int tid = threadIdx.x, wid = tid >> 6, lane = tid & 63, lr = lane & 15, g = lane >> 4;
    const int n0 = item * 16, m = 16 * wid + lr, pn = n0 >> 7, off = n0 & 127;
    const bf16_t* A = (const bf16_t*)(p.ws + WS_H); const bf16_t* Bt = (const bf16_t*)(p.ws + WS_WUP);
    f32x4 ag = (f32x4){0.f, 0.f, 0.f, 0.f}, au = ag;
    sg_mma<2>(shm, A, Bt + (size_t)(256 * pn + off + lr) * DM + 8 * g, Bt + (size_t)(256 * pn + 128 + off + lr) * DM + 8 * g, DM, ag, au);
    u32x2 o; o[0] = cvt_pk_bf16(silu_f(ag[0]) * au[0], silu_f(ag[1]) * au[1]); o[1] = cvt_pk_bf16(silu_f(ag[2]) * au[2], silu_f(ag[3]) * au[3]);
    *(u32x2*)((bf16_t*)(p.ws + WS_Z) + (size_t)(TP + m) * DFF + n0 + 4 * g) = o;
}

#define XB_TMO      128
#define XB_XCNT(j)  (256  + 64 * (j))
#define XB_XSUB(j)  (1280 + 64 * (j))
#define XB_XGEN(j)  (2304 + 64 * (j))
#define XB_TOP      3328
#define XB_TOPGEN   3392
#define XCD_BAR_WORDS 3456
#define XB_SPIN_CAP (1u << 18)
__device__ __forceinline__ unsigned xb_ld(unsigned* p)              { return __hip_atomic_load(p, __ATOMIC_RELAXED, __HIP_MEMORY_SCOPE_AGENT); }
__device__ __forceinline__ unsigned xb_add(unsigned* p, unsigned v) { return __hip_atomic_fetch_add(p, v, __ATOMIC_RELAXED, __HIP_MEMORY_SCOPE_AGENT); }
__device__ __forceinline__ unsigned xb_xcc_id() { return (unsigned)__builtin_amdgcn_s_getreg((3 << 11) | 20) & 0xFu; }
#define XB_SPIN(cond, bar) do { unsigned _sp = 0; while (cond) { __builtin_amdgcn_s_sleep(1); \
    if ((++_sp & 255u) == 0u) { if (xb_ld(&(bar)[XB_TMO])) break; if (_sp > XB_SPIN_CAP) { atomicAdd(&(bar)[XB_TMO], 1u); break; } } } } while (0)
struct XcdBarrier { unsigned* bar; unsigned x; volatile LAS unsigned* st; };
__device__ __forceinline__ XcdBarrier xcd_barrier_post(unsigned* bar, volatile LAS unsigned* st) {
    XcdBarrier b; b.bar = bar; b.x = xb_xcc_id(); b.st = st;
    if (threadIdx.x == 0) (void)xb_add(&bar[XB_XCNT(b.x)], 1u);
    return b;
}
__device__ __forceinline__ void xcd_barrier_complete(unsigned* bar, unsigned x, unsigned& nloc, unsigned& nx) {
    const unsigned G = gridDim.x * gridDim.y * gridDim.z;
    unsigned sum, cnt, mine, sp = 0u;
    for (;;) {
        sum = 0u; cnt = 0u; mine = 0u;
#pragma unroll
        for (unsigned j = 0; j < 16; ++j) { const unsigned c = xb_ld(&bar[XB_XCNT(j)]); sum += c; cnt += (c > 0u) ? 1u : 0u; mine = (j == x) ? c : mine; }
        if (sum == G) break;
        __builtin_amdgcn_s_sleep(1);
        if ((++sp & 255u) == 0u) { if (xb_ld(&bar[XB_TMO])) break; if (sp > XB_SPIN_CAP) { atomicAdd(&bar[XB_TMO], 1u); break; } }
    }
    nloc = mine > 0u ? mine : 1u; nx = cnt > 0u ? cnt : 1u;
}
__device__ __forceinline__ void xcd_barrier(const XcdBarrier& b) {
    asm volatile("s_waitcnt vmcnt(0)" ::: "memory");
    __syncthreads();
    if (threadIdx.x == 0) {
        unsigned* bar = b.bar;
        __builtin_amdgcn_s_waitcnt(0);
        unsigned nloc = b.st[0], nx = b.st[1];
        if (nloc == 0u) { xcd_barrier_complete(bar, b.x, nloc, nx); b.st[0] = nloc; b.st[1] = nx; }
        const unsigned old = xb_add(&bar[XB_XSUB(b.x)], 1u);
        const unsigned gen = old / nloc;
        if (old + 1u == (gen + 1u) * nloc) {
            __builtin_amdgcn_fence(__ATOMIC_RELEASE, "agent");
            asm volatile("s_waitcnt vmcnt(0)" ::: "memory");
            const unsigned og = xb_add(&bar[XB_TOP], 1u);
            const unsigned tg = og / nx;
            if (og + 1u == (tg + 1u) * nx) xb_add(&bar[XB_TOPGEN], 1u);
            else XB_SPIN(xb_ld(&bar[XB_TOPGEN]) == tg, bar);
            __builtin_amdgcn_fence(__ATOMIC_ACQUIRE, "agent");
            xb_add(&bar[XB_XGEN(b.x)], 1u);
            asm volatile("s_waitcnt vmcnt(0)" ::: "memory");
        } else {
            XB_SPIN(xb_ld(&bar[XB_XGEN(b.x)]) == gen, bar);
            __builtin_amdgcn_fence(__ATOMIC_ACQUIRE, "agent");
            asm volatile("s_waitcnt vmcnt(0)" ::: "memory");
        }
    }
    __syncthreads();
}

typedef __attribute__((address_space(4))) const unsigned char* kptr_t;
__device__ __forceinline__ Params load_params() {
#if defined(__HIP_DEVICE_COMPILE__)
    kptr_t k = (kptr_t)__builtin_amdgcn_kernarg_segment_ptr();
    asm volatile("" : "+s"(k));
    Params r;
    __builtin_memcpy(&r, (const __attribute__((address_space(4))) void*)k, sizeof(Params));
    return r;
#else
    return Params{};
#endif
}
__global__ void __launch_bounds__(512, 2) fwd(Params p_arg, int ph_lo, int ph_hi, int coop) {
    extern __shared__ __attribute__((aligned(16))) unsigned char shm[];
    cg::grid_group grid = cg::this_grid();
    LAS unsigned char* lds = (LAS unsigned char*)shm;
    const int G = gridDim.x, bid = blockIdx.x;
    volatile LAS unsigned* bst = (volatile LAS unsigned*)(lds + 131072);
    if (threadIdx.x < 4) bst[threadIdx.x] = 0u;
    __syncthreads();
    (void)xcd_barrier_post((unsigned*)(p_arg.ws + WS_BAR), bst);
    if (coop > 1) grid.sync();
#define GSYNC() do { XcdBarrier xb_; xb_.bar = (unsigned*)(load_params().ws + WS_BAR); xb_.x = xb_xcc_id(); xb_.st = (volatile LAS unsigned*)((LAS unsigned char*)shm + 131072); xcd_barrier(xb_); } while (0)
#ifndef ONLY
#define ONLY -1
#endif
#ifndef REP_PH
#define REP_PH -1
#endif
#ifndef REP_SYNC
#define REP_SYNC 0
#endif
#define PH_BEGIN(n) if ((ONLY < 0 || ONLY == n) && ph_lo <= n && n < ph_hi) { if (n > ph_lo && coop) GSYNC(); for (int rep_ = 0; rep_ < (REP_PH == n ? 2 : 1); ++rep_) { if (rep_) GSYNC(); const Params p = load_params();
#define PH_END } }
    for (int i_ = 0; i_ < REP_SYNC; ++i_) GSYNC();
    PH_BEGIN(0) { prep_tiles(p, shm, 768 + bid, 1152, G); prep_misc(p); } PH_END
    PH_BEGIN(1) { if (bid >= 24) prep_tiles(p, shm, bid - 24, 768, G - 24);
                  pg8::Gemm g{(const bf16_t*)(p.ws + WS_SC), (const bf16_t*)(p.ws + WS_WADA), 256, 6144, DM}; pg8::StaticOrder S; S.init(g.M, g.N, G, bid);
                  EpiAda E{(float*)(p.ws + WS_MOD), p.b_ada_mix, p.b_ada_ffn}; pg8::gemm_phase(lds, g, S, E); } PH_END
    PH_BEGIN(2) phase_modulate(p); PH_END
    PH_BEGIN(3) { pg8::Gemm g{(const bf16_t*)(p.ws + WS_H), (const bf16_t*)(p.ws + WS_WIN), TPAD, INW, DM}; pg8::StaticOrder S; S.init(g.M, g.N, G, bid);
                  EpiIn E{(bf16_t*)(p.ws + WS_Z), (const float*)(p.ws + WS_ROPEA), (const float*)(p.ws + WS_ROPER), p.out}; pg8::gemm_phase(lds, g, S, E); } PH_END
    PH_BEGIN(4) { for (int it = bid; it < 1024; it += G) retu_item(p, shm, it); for (int it = bid; it < 512; it += G) attn_item(p, shm, it); for (int it = G - 1 - bid; it < 512; it += G) sample_ret(p, shm, it); for (int it = bid; it < 128; it += G) sample_att(p, shm, it); } PH_END
    PH_BEGIN(5) phase_scan(p); PH_END
    PH_BEGIN(6) reto_phase(p, shm, bid, G); PH_END
    PH_BEGIN(7) { for (int it = G - 1 - bid; it < 64; it += G) sg_ln(p, shm, it, (const bf16_t*)(p.ws + WS_MIX), (const bf16_t*)(p.ws + WS_WOUT), DM, p.x_sample, 2048, (float*)(p.ws + WS_STAT1),
                                                                       (unsigned*)(p.ws + WS_CNT) + 512 * 16, p.ln1_w, p.ln1_b, (bf16_t*)(p.ws + WS_H), 3072);
                  pg8::Gemm g{(const bf16_t*)(p.ws + WS_MIX), (const bf16_t*)(p.ws + WS_WOUT), TP, DM, DM}; pg8::StaticOrder S; S.init(g.M, g.N, G, bid);
                  EpiLn<false, true> E{p.x_prompt, p.ws + WS_MIX, (const float*)(p.ws + WS_MOD), 2048, (float*)(p.ws + WS_STAT1), (unsigned*)(p.ws + WS_CNT), p.ln1_w, p.ln1_b, (bf16_t*)(p.ws + WS_H), 3072, (unsigned*)(p.ws + WS_CNT) + 527 * 16 + 8};
                  pg8::gemm_phase(lds, g, S, E); } PH_END
    PH_BEGIN(9) { for (int it = G - 1 - bid; it < 176; it += G) sg_up(p, shm, it);
                  pg8::Gemm g{(const bf16_t*)(p.ws + WS_H), (const bf16_t*)(p.ws + WS_WUP), TP, 2 * DFF, DM}; pg8::StaticOrder S; S.init(g.M, g.N, G, bid);
                  EpiUp E{(bf16_t*)(p.ws + WS_Z)}; pg8::gemm_phase(lds, g, S, E); } PH_END
    PH_BEGIN(10) { for (int it = G - 1 - bid; it < 64; it += G) sg_ln(p, shm, it, (const bf16_t*)(p.ws + WS_Z), (const bf16_t*)(p.ws + WS_WDOWN), DFF, p.out + O_YS, 3072 + 2048, (float*)(p.ws + WS_STAT2),
                                                                        (unsigned*)(p.ws + WS_CNT) + 520 * 16, p.ln2_w, p.ln2_b, nullptr, 0);
                   pg8::Gemm g{(const bf16_t*)(p.ws + WS_Z), (const bf16_t*)(p.ws + WS_WDOWN), TP, DM, DFF}; pg8::StaticOrder S; S.init(g.M, g.N, G, bid);
                   EpiLn<true, false> E{p.ws + WS_MIX, p.out, (const float*)(p.ws + WS_MOD), 3072 + 2048, (float*)(p.ws + WS_STAT2), (unsigned*)(p.ws + WS_CNT) + 256 * 16, p.ln2_w, p.ln2_b, nullptr, 0, (unsigned*)(p.ws + WS_CNT) + 527 * 16 + 8};
                   pg8::gemm_phase(lds, g, S, E); } PH_END
}

extern "C" void kernel_launch(void* const* d_in, const int* in_sizes, int n_in, void* d_out, int out_size, void* d_ws, size_t ws_size, hipStream_t stream) {
    constexpr int LDS_BYTES = 131072 + 64;
    static int grid = 0;
    if (!grid) {
        int dev = 0, cus = 0, per_cu = 0;
        (void)hipGetDevice(&dev);
        (void)hipDeviceGetAttribute(&cus, hipDeviceAttributeMultiprocessorCount, dev);
        (void)hipFuncSetAttribute((const void*)fwd, hipFuncAttributeMaxDynamicSharedMemorySize, LDS_BYTES);
        (void)hipOccupancyMaxActiveBlocksPerMultiprocessor(&per_cu, (const void*)fwd, 512, LDS_BYTES);
        grid = cus > 0 ? cus : 256;
        if (ws_size < WS_END) fprintf(stderr, "kernel_launch: workspace too small: %zu < %zu\n", ws_size, (size_t)WS_END);
        fprintf(stderr, "kernel_launch: cus %d per_cu %d grid %d ws %zu need %zu\n", cus, per_cu, grid, ws_size, (size_t)WS_END);
    }
    Params p{};
    const float** f = (const float**)&p;
    for (int i = 0; i < 21; ++i) f[i] = (const float*)d_in[i];
    p.out = (float*)d_out; p.ws = (unsigned char*)d_ws;
#ifndef MULTI_LAUNCH
    (void)hipMemsetAsync((unsigned char*)d_ws + WS_BAR, 0, 16384, stream);
    int lo = 0, hi = 12, coop = 1;
    void* args[] = {&p, &lo, &hi, &coop};
    hipError_t e = hipLaunchCooperativeKernel((const void*)fwd, dim3(grid), dim3(512), args, LDS_BYTES, stream);
    if (e != hipSuccess) fprintf(stderr, "cooperative launch failed: %s (grid %d)\n", hipGetErrorString(e), grid);
#else
    for (int ph = 0; ph < 12; ++ph) hipLaunchKernelGGL(fwd, dim3(grid), dim3(512), LDS_BYTES, stream, p, ph, ph + 1, 0);
#endif
}
```

```cpp
#include <hip/hip_runtime.h>
#include <hip/hip_cooperative_groups.h>
#include <cstdio>
namespace cg = cooperative_groups;

#define LAS __attribute__((address_space(3)))
typedef unsigned short bf16_t;
typedef short bf16x8 __attribute__((ext_vector_type(8)));
typedef float f32x4 __attribute__((ext_vector_type(4)));
typedef unsigned u32x4 __attribute__((ext_vector_type(4)));
typedef unsigned u32x2 __attribute__((ext_vector_type(2)));

constexpr int DM = 1024, SEQ = 4096, NBATCH = 8, TP = NBATCH * SEQ  , NS = 128, TV = TP + NS  , TPAD = TP + 256  ;
constexpr int INW = 2816, DFF = 2816, PAST = 16384;
constexpr float ALPHA = 1.189207115002721f;
constexpr float RK_SCALE = 0.08838834764831845f;
constexpr size_t O_YP = 0, O_YS = (size_t)TP * DM, O_KP = O_YS + (size_t)NS * DM, O_VP = O_KP + 131072, O_RP = O_VP + 131072,
                 O_KS = O_RP + 524288, O_VS = O_KS + 2097152, O_RS = O_VS + 2097152;
constexpr size_t al256(size_t x) { return (x + 255) & ~(size_t)255; }
constexpr size_t WS_WIN = 0;
constexpr size_t WS_WOUT = WS_WIN + (size_t)INW * DM * 2;
constexpr size_t WS_WUP = WS_WOUT + (size_t)DM * DM * 2;
constexpr size_t WS_WDOWN = WS_WUP + (size_t)2 * DFF * DM * 2;
constexpr size_t WS_WADA = WS_WDOWN + (size_t)DM * DFF * 2;
constexpr size_t WS_SC = WS_WADA + (size_t)6144 * DM * 2;
constexpr size_t WS_MOD = WS_SC + (size_t)256 * DM * 2;
constexpr size_t WS_ROPEA = WS_MOD + (size_t)256 * 6144 * 4;
constexpr size_t WS_ROPER = al256(WS_ROPEA + (size_t)4097 * 16 * 4);
constexpr size_t WS_STAT1 = al256(WS_ROPER + (size_t)4097 * 128 * 4);
constexpr size_t WS_STAT2 = WS_STAT1 + (size_t)TPAD * 2 * 4;
constexpr size_t WS_H = al256(WS_STAT2 + (size_t)TPAD * 2 * 4);
constexpr size_t WS_Z = WS_H + (size_t)TPAD * DM * 2;
constexpr size_t WS_MIX = WS_Z + (size_t)TPAD * INW * 2;
constexpr size_t WS_SST = WS_MIX + (size_t)TPAD * DM * 2;
constexpr size_t WS_BAR = WS_SST + (size_t)1024 * 16384 * 2;
constexpr size_t WS_CNT = WS_BAR + 16384;
constexpr size_t WS_END = WS_CNT + 528 * 64;

struct Params {
    const float *x_prompt, *x_sample, *c_prompt, *c_sample, *cache_k, *cache_v, *state_ret, *w_ada_mix, *b_ada_mix, *w_in, *att_sinks, *ret_gn_w, *w_out,
        *ln1_w, *ln1_b, *w_ada_ffn, *b_ada_ffn, *w_up, *w_down, *ln2_w, *ln2_b;
    float* out; unsigned char* ws;
};

__device__ __forceinline__ unsigned cvt_pk_bf16(float lo, float hi) { unsigned r; asm volatile("v_cvt_pk_bf16_f32 %0, %1, %2" : "=v"(r) : "v"(lo), "v"(hi)); return r; }
__device__ __forceinline__ float bf2f(bf16_t b) { return __uint_as_float(((unsigned)b) << 16); }
__device__ __forceinline__ bf16_t f2bf(float f) { return (bf16_t)(cvt_pk_bf16(f, 0.f) & 0xffffu); }
__device__ __forceinline__ float bflo(unsigned u) { return __uint_as_float(u << 16); }
__device__ __forceinline__ float bfhi(unsigned u) { return __uint_as_float(u & 0xffff0000u); }
__device__ __forceinline__ float silu_f(float v) { return v * __builtin_amdgcn_rcpf(1.f + __expf(-v)); }
__device__ __forceinline__ float log_gamma(int h) {
    return h == 0 ? -0.0317486983145803f : (h == 1 ? -0.012479111952334388f : (h == 2 ? -0.004933717393740471f : -0.0019550348358033506f));
}
__device__ __forceinline__ int att_dim(int p) { if (p >= 16) return p; const int g = p >> 3, j = p & 7; return j < 4 ? 4 * g + j : 8 + 4 * g + (j - 4); }
__device__ __forceinline__ int ret_dim(int p) { const int g = p >> 3, j = p & 7; return j < 4 ? 4 * g + j : 64 + 4 * g + (j - 4); }
__device__ __forceinline__ int in_col(int P) {
    if (P < 640) return (P & ~63) + att_dim(P & 63);
    if (P >= 768 && P < 1792) { const int p = (P - 768) & 127; return P - p + ret_dim(p); }
    return P;
}
__device__ __forceinline__ int up_col(int P) { const int pn = P >> 8, q = P & 255; return q < 128 ? pn * 128 + q : DFF + pn * 128 + (q - 128); }

namespace pg8 {
constexpr int BM = 256, BK = 64, HALF = 128, HTB = HALF * BK * 2, STAGE_BYTES = 8 * HTB, NXCD = 8, WGM = 8;
__device__ __forceinline__ int lds_byte(int r, int c) { const int st = (r >> 4) * 2 + (c >> 5), rr = r & 15, cc = c & 31, ob = rr * 64 + cc * 2; return st * 1024 + (ob ^ (((ob >> 9) & 1) << 5)); }
__device__ __forceinline__ void stage_rc(int b, int& R, int& C) { const int st = b / 1024, sb = b % 1024, swz = sb ^ (((sb >> 9) & 1) << 5); R = (st >> 1) * 16 + swz / 64; C = (st & 1) * 32 + (swz % 64) / 2; }
__device__ __forceinline__ int perm32(int rho) { const int n = rho >> 4, i = rho & 15; return 8 * (i >> 2) + 4 * n + (i & 3); }
struct Unit { int pm, pn; };
struct Gemm { const bf16_t* A; const bf16_t* Bt; int M, N, K; };
struct StaticOrder {
    int nM, nN, nwg, G, c;
    __device__ void init(int M, int N, int G_, int c_) { nM = M / BM; nN = N / BM; nwg = nM * nN; G = G_; c = c_; }
    __device__ bool next(int i, Unit& u) const {
        const long L = (long)i * G + c; if (L >= nwg) return false;
        int wgid = (int)L; { const int q = nwg / NXCD, r = nwg % NXCD, xcd = wgid % NXCD, off = wgid / NXCD; wgid = (xcd < r ? xcd * (q + 1) : r * (q + 1) + (xcd - r) * q) + off; }
        const int nig = WGM * nN, gid = wgid / nig, fm = gid * WGM, gsz = (nM - fm) < WGM ? (nM - fm) : WGM;
        u.pm = fm + ((wgid % nig) % gsz); u.pn = (wgid % nig) / gsz; return true;
    }
};

template <class Epi, class Sched>
__device__ __forceinline__ void gemm_phase(LAS unsigned char* lds, const Gemm g, const Sched& S, const Epi& E) {
    const int tid = threadIdx.x, wid = __builtin_amdgcn_readfirstlane(tid >> 6), lane = tid & 63, wr = wid >> 2, wc = wid & 3, fr = lane & 15, fq = lane >> 4;
    const int K = g.K, nt = K / BK;
    unsigned voffA[2], voffB[2];
#pragma unroll
    for (int i = 0; i < 2; ++i) { int R, C; stage_rc(tid * 16 + i * 8192, R, C); const int Rb = Epi::PERM ? ((R & ~31) + perm32(R & 31)) : R;
        voffA[i] = (unsigned)(R * K + C) * 2u; voffB[i] = (unsigned)(Rb * K + C) * 2u; }
    const size_t kstep = (size_t)(BK * 2);
    const size_t hstep = (size_t)HALF * K * 2;
    const size_t tstep = 2 * hstep;
    const unsigned ldsw = (unsigned)wid * 1024u;
    const int aoff = lds_byte(wr * 64 + fr, fq * 8), boff = lds_byte(wc * 32 + fr, fq * 8);
#define PG8_SA(b, h) (((b) * 2 + (h)) * HTB)
#define PG8_SB(b, h) ((4 + (b) * 2 + (h)) * HTB)
#define PG8_STAGE(bufoff, gbase, voff) do { _Pragma("unroll") for (int _i = 0; _i < 2; ++_i) \
        __builtin_amdgcn_global_load_lds((const unsigned*)((const char*)(gbase) + (voff)[_i]), (LAS unsigned*)(lds + (bufoff) + ldsw + _i * 8192), 16, 0, 0); } while (0)
#define PG8_LDA(dst, b, h) do { _Pragma("unroll") for (int m = 0; m < 4; ++m) _Pragma("unroll") for (int k = 0; k < 2; ++k) dst[m][k] = *(const LAS bf16x8*)(lds + PG8_SA(b, h) + aoff + m * 2048 + k * 1024); } while (0)
#define PG8_LDB(dst, b, h) do { _Pragma("unroll") for (int n = 0; n < 2; ++n) _Pragma("unroll") for (int k = 0; k < 2; ++k) dst[n][k] = *(const LAS bf16x8*)(lds + PG8_SB(b, h) + boff + n * 2048 + k * 1024); } while (0)
#define PG8_MMA(ai, bj, At, Bt) do { __builtin_amdgcn_s_setprio(1); _Pragma("unroll") for (int m = 0; m < 4; ++m) _Pragma("unroll") for (int n = 0; n < 2; ++n) _Pragma("unroll") for (int k = 0; k < 2; ++k) \
        acc[ai][bj][m][n] = __builtin_amdgcn_mfma_f32_16x16x32_bf16(Bt[n][k], At[m][k], acc[ai][bj][m][n], 0, 0, 0); __builtin_amdgcn_s_setprio(0); } while (0)
#define PG8_WAIT_V(n) asm volatile("s_waitcnt vmcnt(" #n ")" ::: "memory")
#define PG8_WAIT_L(n) asm volatile("s_waitcnt lgkmcnt(" #n ")" ::: "memory")
#define PG8_BAR __builtin_amdgcn_s_barrier()
#define PG8_SCHED __builtin_amdgcn_sched_barrier(0)
    Unit cur, nxt; int ui = 0;
    if (!S.next(0, cur)) return;
    f32x4 acc[2][2][4][2];
#pragma unroll
    for (int a = 0; a < 2; ++a)
#pragma unroll
        for (int b = 0; b < 2; ++b)
#pragma unroll
            for (int m = 0; m < 4; ++m)
#pragma unroll
                for (int n = 0; n < 2; ++n) acc[a][b][m][n] = (f32x4){0.f, 0.f, 0.f, 0.f};
    bf16x8 At[4][2], B0[2][2], B1[2][2];
    const char* cA = (const char*)g.A + (size_t)cur.pm * tstep; const char* cB = (const char*)g.Bt + (size_t)cur.pn * tstep;
    PG8_STAGE(PG8_SB(0, 0), cB, voffB); PG8_STAGE(PG8_SA(0, 0), cA, voffA); PG8_STAGE(PG8_SB(0, 1), cB + hstep, voffB); PG8_STAGE(PG8_SA(0, 1), cA + hstep, voffA);
    if (wr == 1) PG8_BAR;
    PG8_WAIT_V(4); PG8_BAR;
    PG8_STAGE(PG8_SB(1, 0), cB + kstep, voffB); PG8_STAGE(PG8_SA(1, 0), cA + kstep, voffA); PG8_STAGE(PG8_SB(1, 1), cB + hstep + kstep, voffB);
    PG8_WAIT_V(6); PG8_BAR;
    for (;;) {
        const bool has_next = S.next(ui + 1, nxt);
        const char* nA = has_next ? (const char*)g.A + (size_t)nxt.pm * tstep : cA; const char* nB = has_next ? (const char*)g.Bt + (size_t)nxt.pn * tstep : cB;
        for (int t = 0; t < nt; t += 2) {
            const bool last = (t == nt - 2);
            const char* a1 = cA + (size_t)(t + 1) * kstep;
            const char* a2 = last ? nA : cA + (size_t)(t + 2) * kstep; const char* b2 = last ? nB : cB + (size_t)(t + 2) * kstep;
            const char* a3 = a2 + kstep; const char* b3 = b2 + kstep;
            PG8_LDB(B0, 0, 0); PG8_SCHED; PG8_LDA(At, 0, 0); PG8_STAGE(PG8_SA(1, 1), a1 + hstep, voffA);
            PG8_WAIT_L(8); PG8_BAR; PG8_WAIT_L(0); PG8_MMA(0, 0, At, B0); PG8_BAR; PG8_SCHED;
            PG8_LDB(B1, 0, 1); PG8_STAGE(PG8_SB(0, 0), b2, voffB);
            PG8_BAR; PG8_WAIT_L(0); PG8_MMA(0, 1, At, B1); PG8_BAR;
            PG8_LDA(At, 0, 1); PG8_STAGE(PG8_SA(0, 0), a2, voffA);
            PG8_BAR; PG8_WAIT_L(0); PG8_MMA(1, 0, At, B0); PG8_BAR; PG8_SCHED;
            PG8_STAGE(PG8_SB(0, 1), b2 + hstep, voffB);
            PG8_WAIT_V(6); PG8_BAR; PG8_MMA(1, 1, At, B1); PG8_BAR;
            PG8_LDB(B0, 1, 0); PG8_SCHED; PG8_LDA(At, 1, 0); PG8_STAGE(PG8_SA(0, 1), a2 + hstep, voffA);
            PG8_WAIT_L(8); PG8_BAR; PG8_WAIT_L(0); PG8_MMA(0, 0, At, B0); PG8_BAR; PG8_SCHED;
            PG8_LDB(B1, 1, 1); PG8_STAGE(PG8_SB(1, 0), b3, voffB);
            PG8_BAR; PG8_WAIT_L(0); PG8_MMA(0, 1, At, B1); PG8_BAR;
            PG8_LDA(At, 1, 1); PG8_STAGE(PG8_SA(1, 0), a3, voffA);
            PG8_BAR; PG8_WAIT_L(0); PG8_MMA(1, 0, At, B0); PG8_BAR; PG8_SCHED;
            PG8_STAGE(PG8_SB(1, 1), b3 + hstep, voffB);
            PG8_WAIT_V(6); PG8_BAR; PG8_MMA(1, 1, At, B1); PG8_BAR;
        }
        if constexpr (Epi::ALIGNED) { if (wr == 0) PG8_BAR; }
        E(acc, cur, wr, wc, fr, fq);
        if (!has_next) break;
#pragma unroll
        for (int a = 0; a < 2; ++a)
#pragma unroll
            for (int b = 0; b < 2; ++b)
#pragma unroll
                for (int m = 0; m < 4; ++m)
#pragma unroll
                    for (int n = 0; n < 2; ++n) acc[a][b][m][n] = (f32x4){0.f, 0.f, 0.f, 0.f};
        cur = nxt; cA = nA; cB = nB; ++ui;
        if constexpr (Epi::ALIGNED) { if (wr == 1) PG8_BAR; }
    }
    PG8_WAIT_V(0);
    if constexpr (!Epi::ALIGNED) { if (wr == 0) PG8_BAR; }
    PG8_BAR;
#undef PG8_SA
#undef PG8_SB
#undef PG8_STAGE
#undef PG8_LDA
#undef PG8_LDB
#undef PG8_MMA
#undef PG8_WAIT_V
#undef PG8_WAIT_L
#undef PG8_BAR
#undef PG8_SCHED
}
}
using pg8::Unit;

struct EpiAda {
    static constexpr bool PERM = false, ALIGNED = false;
    float* mod; const float* b_mix; const float* b_ffn;
    __device__ __forceinline__ void operator()(const f32x4 (&acc)[2][2][4][2], const Unit& u, int wr, int wc, int fr, int fq) const {
#pragma unroll
        for (int ai = 0; ai < 2; ++ai)
#pragma unroll
            for (int m = 0; m < 4; ++m) {
                const int r = u.pm * 256 + ai * 128 + wr * 64 + m * 16 + fr;
#pragma unroll
                for (int bj = 0; bj < 2; ++bj)
#pragma unroll
                    for (int n = 0; n < 2; ++n) {
                        const int c = u.pn * 256 + bj * 128 + wc * 32 + n * 16 + fq * 4;
                        const f32x4 bv = c < 3072 ? *(const f32x4*)(b_mix + c) : *(const f32x4*)(b_ffn + c - 3072);
                        *(f32x4*)(mod + (size_t)r * 6144 + c) = acc[ai][bj][m][n] + bv;
                    }
            }
    }
};

struct EpiIn {
    static constexpr bool PERM = true, ALIGNED = true;
    bf16_t* Z; const float* ropeA; const float* ropeR; float* out;
    __device__ __forceinline__ void operator()(const f32x4 (&acc)[2][2][4][2], const Unit& u, int wr, int wc, int fr, int fq) const {
        int region[2], cbv[2]; const float* tab[2]; int tstride[2], toff[2]; bool rot[2];
#pragma unroll
        for (int bj = 0; bj < 2; ++bj) {
            const int cb128 = u.pn * 256 + bj * 128;
            const int cb = cb128 + wc * 32 + fq * 8; cbv[bj] = cb;
            region[bj] = cb128 < 512 ? 0 : (cb128 < 640 ? 1 : (cb128 < 768 ? 2 : (cb128 < 1280 ? 3 : (cb128 < 1792 ? 4 : 5))));
            if (region[bj] <= 1) { const int p = cb & 63; rot[bj] = p < 16; tab[bj] = ropeA; tstride[bj] = 16; toff[bj] = 4 * (p >> 3); }
            else if (region[bj] == 3 || region[bj] == 4) { rot[bj] = true; tab[bj] = ropeR; tstride[bj] = 128; toff[bj] = 4 * ((cb & 127) >> 3); }
            else { rot[bj] = false; tab[bj] = ropeR; tstride[bj] = 128; toff[bj] = 0; }
        }
        f32x4 csn[2], snn[2];
        auto load_tab = [&](int k) {
            const int r0 = u.pm * 256 + (k >> 2) * 128 + wr * 64 + (k & 3) * 16;
            const int r = r0 + fr, pos = r < TP ? (r & 4095) : 4096;
#pragma unroll
            for (int bj = 0; bj < 2; ++bj) if (rot[bj] && r0 < TV) { const float* t = tab[bj] + pos * tstride[bj] + toff[bj]; csn[bj] = *(const f32x4*)t; snn[bj] = *(const f32x4*)(t + (tstride[bj] >> 1)); }
        };
        load_tab(0);
#pragma unroll
        for (int k = 0; k < 8; ++k) {
            const int ai = k >> 2, m = k & 3;
            const int r0 = u.pm * 256 + ai * 128 + wr * 64 + m * 16;
            const f32x4 cs0 = csn[0], cs1 = csn[1], sn0 = snn[0], sn1 = snn[1];
            if (k < 7) load_tab(k + 1);
            if (r0 >= TV) continue;
            const int r = r0 + fr;
            const int pos = r < TP ? (r & 4095) : 4096;
#pragma unroll
            for (int bj = 0; bj < 2; ++bj) {
                const int cb = cbv[bj];
                f32x4 v0 = acc[ai][bj][m][0], v1 = acc[ai][bj][m][1];
                if (rot[bj]) {
                    const f32x4 cs = bj ? cs1 : cs0, sn = bj ? sn1 : sn0;
                    f32x4 a = v0 * cs - v1 * sn, b = v1 * cs + v0 * sn;
                    if (region[bj] == 4) { a *= RK_SCALE; b *= RK_SCALE; }
                    v0 = a; v1 = b;
                }
                u32x4 pk; pk[0] = cvt_pk_bf16(v0[0], v0[1]); pk[1] = cvt_pk_bf16(v0[2], v0[3]); pk[2] = cvt_pk_bf16(v1[0], v1[1]); pk[3] = cvt_pk_bf16(v1[2], v1[3]);
                *(u32x4*)(Z + (size_t)r * INW + cb) = pk;
                if (region[bj] == 1 || region[bj] == 2) {
                    const int kvh = (cb >> 6) & 1, p = cb & 63;
                    int d0 = p, d1 = p + 4;
                    if (region[bj] == 1 && p < 16) { const int grp = p >> 3; d0 = 4 * grp; d1 = 8 + 4 * grp; }
                    float* dst = nullptr;
                    if (r < TP) { if (pos >= SEQ - 128) dst = out + (region[bj] == 1 ? O_KP : O_VP) + ((size_t)((r >> 12) * 128 + (pos - (SEQ - 128))) * 2 + kvh) * 64; }
                    else dst = out + (region[bj] == 1 ? O_KS : O_VS) + ((size_t)((r - TP) * 128 + 127) * 2 + kvh) * 64;
                    if (dst) { *(f32x4*)(dst + d0) = v0; *(f32x4*)(dst + d1) = v1; }
                }
            }
        }
    }
};

__device__ __forceinline__ void wait_ge(unsigned* pc, unsigned target, unsigned* tmo) {
    unsigned sp = 0;
    while (__hip_atomic_load(pc, __ATOMIC_RELAXED, __HIP_MEMORY_SCOPE_AGENT) < target) {
        __builtin_amdgcn_s_sleep(1);
        if ((++sp & 1023u) == 0u) { if (__hip_atomic_load(tmo, __ATOMIC_RELAXED, __HIP_MEMORY_SCOPE_AGENT) != 0u) break;
                                    if (sp > (1u << 21)) { __hip_atomic_store(tmo, 1u, __ATOMIC_RELAXED, __HIP_MEMORY_SCOPE_AGENT); break; } }
    }
}
template <bool BASE_BF16, bool OUT_BF16>
struct EpiLn {
    static constexpr bool PERM = false, ALIGNED = true;
    const void* base; void* Y; const float* mod; int gate_off; float* stat; unsigned* cnt; const float* lw; const float* lb; bf16_t* H; int h_off; unsigned* tmo;
    __device__ __forceinline__ void operator()(f32x4 (&acc)[2][2][4][2], const Unit& u, int wr, int wc, int fr, int fq) const {
        const float* mrow = mod + (size_t)(128 + (u.pm >> 4)) * 6144 + u.pn * 256;
        const size_t torg = (size_t)u.pm * 256 * DM + u.pn * 256;
        const float* tbf = (const float*)base + torg; const bf16_t* tbh = (const bf16_t*)base + torg; float* tyf = (float*)Y + torg; bf16_t* tyh = (bf16_t*)Y + torg; float* ts = stat + (size_t)u.pm * 512;
        const unsigned lo = (unsigned)((wr * 64 + fr) * DM + wc * 32 + fq * 4), lc = (unsigned)(wc * 32 + fq * 4), lrw = (unsigned)(wr * 64 + fr);
        f32x4 gv[2][2];
#pragma unroll
        for (int bj = 0; bj < 2; ++bj)
#pragma unroll
            for (int n = 0; n < 2; ++n) gv[bj][n] = 1.f + *(const f32x4*)(mrow + gate_off + lc + (bj * 128 + n * 16));
        float sv[8], ssv[8];
        unsigned lod[2] = {lo, lo};
        auto ld_row = [&](int k, f32x4 (&x)[4], unsigned lo) {
            const int ai = k >> 2, m = k & 3;
#pragma unroll
            for (int bj = 0; bj < 2; ++bj)
#pragma unroll
                for (int n = 0; n < 2; ++n) {
                    if constexpr (BASE_BF16) { const u32x2 xb = *(const u32x2*)(tbh + lo + ((ai * 128 + m * 16) * DM + bj * 128 + n * 16)); x[bj * 2 + n] = (f32x4){bflo(xb[0]), bfhi(xb[0]), bflo(xb[1]), bfhi(xb[1])}; }
                    else x[bj * 2 + n] = *(const f32x4*)(tbf + lo + ((ai * 128 + m * 16) * DM + bj * 128 + n * 16));
                }
        };
        f32x4 xn[4];
        ld_row(0, xn, lod[0]);
#pragma unroll
        for (int k = 0; k < 8; ++k) {
            const int ai = k >> 2, m = k & 3;
            f32x4 xc[4] = {xn[0], xn[1], xn[2], xn[3]};
            if (k < 7) ld_row(k + 1, xn, lod[(k + 1) & 1]);
            float s = 0.f, ss = 0.f;
#pragma unroll
            for (int bj = 0; bj < 2; ++bj)
#pragma unroll
                for (int n = 0; n < 2; ++n) {
                    const f32x4 res = ALPHA * xc[bj * 2 + n] + gv[bj][n] * acc[ai][bj][m][n];
                    acc[ai][bj][m][n] = res;
                    s += res[0] + res[1] + res[2] + res[3];
                    ss += res[0] * res[0] + res[1] * res[1] + res[2] * res[2] + res[3] * res[3];
                }
            sv[k] = s; ssv[k] = ss;
            asm volatile("" : "+v"(lod[k & 1]) : "v"(s));
        }
#pragma unroll
        for (int k = 0; k < 8; ++k) {
            float s = sv[k], ss = ssv[k];
            s += __shfl_xor(s, 16); ss += __shfl_xor(ss, 16);
            s += __shfl_xor(s, 32); ss += __shfl_xor(ss, 32);
            if (fq == 0) { float* sp = ts + 2 * (lrw + (k >> 2) * 128 + (k & 3) * 16); __hip_atomic_fetch_add(sp, s, __ATOMIC_RELAXED, __HIP_MEMORY_SCOPE_AGENT); __hip_atomic_fetch_add(sp + 1, ss, __ATOMIC_RELAXED, __HIP_MEMORY_SCOPE_AGENT); }
        }
        asm volatile("s_waitcnt vmcnt(0)" ::: "memory");
        unsigned* pc = cnt + (u.pm * 2 + wr) * 16;
        if (fr + fq == 0) __hip_atomic_fetch_add(pc, 1u, __ATOMIC_RELAXED, __HIP_MEMORY_SCOPE_AGENT);
        wait_ge(pc, 16u, tmo);
        asm volatile("" ::: "memory");
        float sa8[8], sb8[8];
#pragma unroll
        for (int k = 0; k < 8; ++k) { const float* sp = ts + 2 * (lrw + (k >> 2) * 128 + (k & 3) * 16);
            sa8[k] = __hip_atomic_load(sp, __ATOMIC_RELAXED, __HIP_MEMORY_SCOPE_AGENT); sb8[k] = __hip_atomic_load(sp + 1, __ATOMIC_RELAXED, __HIP_MEMORY_SCOPE_AGENT); }
#pragma unroll
        for (int k = 0; k < 8; ++k) { const float mu = sa8[k] * (1.f / 1024.f), var = sb8[k] * (1.f / 1024.f) - mu * mu; sa8[k] = mu; sb8[k] = rsqrtf(fmaxf(var, 0.f) + 1e-5f); }
#pragma unroll
        for (int bj = 0; bj < 2; ++bj)
#pragma unroll
            for (int n = 0; n < 2; ++n) {
                const int co = bj * 128 + n * 16;
                const f32x4 w4 = *(const f32x4*)(lw + u.pn * 256 + lc + co), b4 = *(const f32x4*)(lb + u.pn * 256 + lc + co);
                f32x4 sc4 = w4, sh4 = b4;
                if (H) { sc4 = 1.f + *(const f32x4*)(mrow + h_off + 1024 + lc + co); sh4 = *(const f32x4*)(mrow + h_off + lc + co); }
#pragma unroll
                for (int k = 0; k < 8; ++k) {
                    const int ai = k >> 2, m = k & 3;
                    const f32x4 y = (acc[ai][bj][m][n] - sa8[k]) * sb8[k] * w4 + b4;
                    if constexpr (OUT_BF16) { u32x2 yo; yo[0] = cvt_pk_bf16(y[0], y[1]); yo[1] = cvt_pk_bf16(y[2], y[3]); *(u32x2*)(tyh + lo + ((ai * 128 + m * 16) * DM + co)) = yo; }
                    else *(f32x4*)(tyf + lo + ((ai * 128 + m * 16) * DM + co)) = y;
                    if (H) { const f32x4 hv = y * sc4 + sh4;
                             u32x2 o; o[0] = cvt_pk_bf16(hv[0], hv[1]); o[1] = cvt_pk_bf16(hv[2], hv[3]); *(u32x2*)(H + torg + lo + ((ai * 128 + m * 16) * DM + co)) = o; }
                }
            }
    }
};

struct EpiUp {
    static constexpr bool PERM = true, ALIGNED = true;
    bf16_t* F;
    __device__ __forceinline__ void operator()(const f32x4 (&acc)[2][2][4][2], const Unit& u, int wr, int wc, int fr, int fq) const {
#pragma unroll
        for (int ai = 0; ai < 2; ++ai)
#pragma unroll
            for (int m = 0; m < 4; ++m) {
                const int r0 = u.pm * 256 + ai * 128 + wr * 64 + m * 16;
                if (r0 >= TV) continue;
                const int r = r0 + fr;
                float f[8];
#pragma unroll
                for (int n = 0; n < 2; ++n)
#pragma unroll
                    for (int i = 0; i < 4; ++i) { const float g = acc[ai][0][m][n][i]; f[n * 4 + i] = silu_f(g) * acc[ai][1][m][n][i]; }
                u32x4 pk; pk[0] = cvt_pk_bf16(f[0], f[1]); pk[1] = cvt_pk_bf16(f[2], f[3]); pk[2] = cvt_pk_bf16(f[4], f[5]); pk[3] = cvt_pk_bf16(f[6], f[7]);
                *(u32x4*)(F + (size_t)r * DFF + u.pn * 128 + wc * 32 + fq * 8) = pk;
            }
    }
};

__device__ __forceinline__ void prep_tiles(const Params& p, unsigned char* shm, int tt0, int tt1, int stride) {
    const int tid = threadIdx.x;
    bf16_t* tile = (bf16_t*)shm;
    for (int tt = tt0; tt < tt1; tt += stride) {
        const float* src; bf16_t* dst; int ld, K, mode, t;
        if (tt < 176) { t = tt; src = p.w_in; ld = INW; K = DM; dst = (bf16_t*)(p.ws + WS_WIN); mode = 1; }
        else if (tt < 240) { t = tt - 176; src = p.w_out; ld = DM; K = DM; dst = (bf16_t*)(p.ws + WS_WOUT); mode = 0; }
        else if (tt < 592) { t = tt - 240; src = p.w_up; ld = 2 * DFF; K = DM; dst = (bf16_t*)(p.ws + WS_WUP); mode = 2; }
        else if (tt < 768) { t = tt - 592; src = p.w_down; ld = DM; K = DFF; dst = (bf16_t*)(p.ws + WS_WDOWN); mode = 0; }
        else if (tt < 960) { t = tt - 768; src = p.w_ada_mix; ld = 3072; K = DM; dst = (bf16_t*)(p.ws + WS_WADA); mode = 0; }
        else { t = tt - 960; src = p.w_ada_ffn; ld = 3072; K = DM; dst = (bf16_t*)(p.ws + WS_WADA) + (size_t)3072 * DM; mode = 0; }
        const int nkt = K / 256, rt = t / nkt, kt = t % nkt;
        const int P = rt * 64 + (tid & 63);
        const int L = mode == 1 ? in_col(P) : (mode == 2 ? up_col(P) : P);
        const float* sp = src + (size_t)(kt * 256 + (tid >> 6)) * ld + L;
#pragma unroll
        for (int i = 0; i < 32; ++i) tile[(tid & 63) * 264 + (tid >> 6) + 8 * i] = f2bf(sp[(size_t)(8 * i) * ld]);
        __syncthreads();
        { const int pr = tid >> 3, kc = tid & 7;
#pragma unroll
          for (int j = 0; j < 4; ++j) *(u32x4*)(dst + (size_t)(rt * 64 + pr) * K + kt * 256 + (kc + 8 * j) * 8) = *(const u32x4*)(tile + pr * 264 + (kc + 8 * j) * 8); }
        __syncthreads();
    }
}
__device__ __forceinline__ void prep_misc(const Params& p) {
    const int tid = threadIdx.x;
    const int gt = blockIdx.x * 512 + tid, gs = gridDim.x * 512;
    bf16_t* sc = (bf16_t*)(p.ws + WS_SC);
    for (int i = gt; i < 256 * DM; i += gs) { const int r = i >> 10, k = i & 1023; float v = 0.f; if (r < 128) v = silu_f(p.c_sample[r * DM + k]); else if (r < 136) v = silu_f(p.c_prompt[(r - 128) * DM + k]); sc[i] = f2bf(v); }
    float* st = (float*)(p.ws + WS_STAT1);
    for (int i = gt; i < TPAD * 4; i += gs) st[i] = 0.f;
    for (int i = gt; i < 528 * 16; i += gs) ((unsigned*)(p.ws + WS_CNT))[i] = 0u;
    float* ra = (float*)(p.ws + WS_ROPEA); float* rr = (float*)(p.ws + WS_ROPER);
    for (int i = gt; i < 4097 * 72; i += gs) {
        const int pos = i / 72, f = i % 72;
        const double pv = pos < 4096 ? (double)pos : (double)PAST;
        const double inv = f < 8 ? exp(-13.122363377404328 * (double)f / 8.0) : exp(-9.210340371976184 * (double)(f - 8) / 64.0);
        const double ang = pv * inv;
        const double kk = rint(ang * 0.15915494309189535);
        const float red = (float)(ang - kk * 6.283185307179586);
        const float cs = cosf(red), sn = sinf(red);
        if (f < 8) { ra[pos * 16 + f] = cs; ra[pos * 16 + 8 + f] = sn; } else { rr[pos * 128 + (f - 8)] = cs; rr[pos * 128 + 64 + (f - 8)] = sn; }
    }
}

__device__ __forceinline__ void phase_modulate(const Params& p) {
    const float* mod = (const float*)(p.ws + WS_MOD); bf16_t* H = (bf16_t*)(p.ws + WS_H);
    const int gt = blockIdx.x * 512 + threadIdx.x, gs = gridDim.x * 512;
    constexpr int NCH = TV * 128;
    for (int i0 = gt; i0 < NCH; i0 += 4 * gs) {
        f32x4 x0[4], x1[4];
#pragma unroll
        for (int u = 0; u < 4; ++u) { const int i = i0 + u * gs; if (i < NCH) { const int r = i >> 7, c = (i & 127) * 8;
            const float* xr = r < TP ? p.x_prompt + (size_t)r * DM : p.x_sample + (size_t)(r - TP) * DM;
            x0[u] = __builtin_nontemporal_load((const f32x4*)(xr + c)); x1[u] = __builtin_nontemporal_load((const f32x4*)(xr + c + 4)); } }
#pragma unroll
        for (int u = 0; u < 4; ++u) { const int i = i0 + u * gs; if (i < NCH) { const int r = i >> 7, c = (i & 127) * 8;
            const int mrow = r < TP ? 128 + (r >> 12) : r - TP;
            const float* sh = mod + (size_t)mrow * 6144; const float* scl = sh + 1024;
            const f32x4 h0 = x0[u] * (1.f + *(const f32x4*)(scl + c)) + *(const f32x4*)(sh + c), h1 = x1[u] * (1.f + *(const f32x4*)(scl + c + 4)) + *(const f32x4*)(sh + c + 4);
            u32x4 pk; pk[0] = cvt_pk_bf16(h0[0], h0[1]); pk[1] = cvt_pk_bf16(h0[2], h0[3]); pk[2] = cvt_pk_bf16(h1[0], h1[1]); pk[3] = cvt_pk_bf16(h1[2], h1[3]);
            *(u32x4*)(H + (size_t)r * DM + c) = pk; } }
    }
}

__device__ __forceinline__ void attn_item(const Params& p, unsigned char* shm, int item) {
    const int tid = threadIdx.x, wid = tid >> 6, lane = tid & 63, lr = lane & 15, g = lane >> 4;
    const int b = item >> 6, kvh = (item >> 5) & 1, n = item & 31;
    const bf16_t* Z = (const bf16_t*)(p.ws + WS_Z); bf16_t* MIX = (bf16_t*)(p.ws + WS_MIX);
    bf16_t* Ks = (bf16_t*)shm;
    bf16_t* VT = Ks + 256 * 72;
    {
        const int key = tid >> 1, hf = tid & 1;
        const bool valid = (n > 0) || (key >= 128);
        const size_t row = (size_t)b * SEQ + (size_t)(n - 1) * 128 + key;
        const bf16_t* kp = Z + row * INW + 512 + kvh * 64 + hf * 32; const bf16_t* vp = Z + row * INW + 640 + kvh * 64 + hf * 32;
#pragma unroll
        for (int c = 0; c < 4; ++c) {
            u32x4 kv = (u32x4){0u, 0u, 0u, 0u}, vv = (u32x4){0u, 0u, 0u, 0u};
            if (valid) { kv = *(const u32x4*)(kp + c * 8); vv = *(const u32x4*)(vp + c * 8); }
            *(u32x4*)(Ks + key * 72 + hf * 32 + c * 8) = kv;
#pragma unroll
            for (int e = 0; e < 4; ++e) { const int d = hf * 32 + c * 8 + 2 * e; VT[d * 264 + key] = (bf16_t)(vv[e] & 0xffffu); VT[(d + 1) * 264 + key] = (bf16_t)(vv[e] >> 16); }
        }
    }
    __syncthreads();
    for (int qt = 0; qt < 4; ++qt) {
        const int T = wid * 4 + qt, hq = T >> 3, tq = T & 7, t0 = tq * 16, head = kvh * 4 + hq;
        const size_t qrow = (size_t)b * SEQ + (size_t)n * 128 + t0 + lr;
        bf16x8 Qf[2];
#pragma unroll
        for (int kk = 0; kk < 2; ++kk) Qf[kk] = *(const bf16x8*)(Z + qrow * INW + head * 64 + kk * 32 + g * 8);
        const int kt0 = tq < 6 ? tq : 6;
        f32x4 S[10];
#pragma unroll
        for (int jt = 0; jt < 10; ++jt) {
            S[jt] = (f32x4){0.f, 0.f, 0.f, 0.f};
#pragma unroll
            for (int kk = 0; kk < 2; ++kk) {
                const bf16x8 Kf = *(const bf16x8*)(Ks + (16 * (kt0 + jt) + lr) * 72 + kk * 32 + g * 8);
                S[jt] = __builtin_amdgcn_mfma_f32_16x16x32_bf16(Kf, Qf[kk], S[jt], 0, 0, 0);
            }
        }
        const float sink = p.att_sinks[head];
        const int t = t0 + lr;
        float mx = sink;
#pragma unroll
        for (int jt = 0; jt < 10; ++jt)
#pragma unroll
            for (int r = 0; r < 4; ++r) {
                const int i = 16 * (kt0 + jt) + 4 * g + r, dist = 128 + t - i;
                const bool ok = dist >= 0 && dist <= 128 && (n > 0 || i >= 128);
                const float s = ok ? S[jt][r] * 0.125f : -INFINITY;
                S[jt][r] = s; mx = fmaxf(mx, s);
            }
        mx = fmaxf(mx, __shfl_xor(mx, 16)); mx = fmaxf(mx, __shfl_xor(mx, 32));
        float sum = 0.f;
#pragma unroll
        for (int jt = 0; jt < 10; ++jt)
#pragma unroll
            for (int r = 0; r < 4; ++r) { const float e = __expf(S[jt][r] - mx); S[jt][r] = e; sum += e; }
        sum += __shfl_xor(sum, 16); sum += __shfl_xor(sum, 32);
        const float inv = 1.f / (sum + __expf(sink - mx));
        f32x4 O[4];
#pragma unroll
        for (int dt = 0; dt < 4; ++dt) O[dt] = (f32x4){0.f, 0.f, 0.f, 0.f};
#pragma unroll
        for (int jp = 0; jp < 5; ++jp) {
            u32x4 pu; pu[0] = cvt_pk_bf16(S[2 * jp][0] * inv, S[2 * jp][1] * inv); pu[1] = cvt_pk_bf16(S[2 * jp][2] * inv, S[2 * jp][3] * inv);
            pu[2] = cvt_pk_bf16(S[2 * jp + 1][0] * inv, S[2 * jp + 1][1] * inv); pu[3] = cvt_pk_bf16(S[2 * jp + 1][2] * inv, S[2 * jp + 1][3] * inv);
            const bf16x8 Pf = __builtin_bit_cast(bf16x8, pu);
#pragma unroll
            for (int dt = 0; dt < 4; ++dt) {
                const bf16_t* vr = VT + (16 * dt + lr) * 264 + 16 * (kt0 + 2 * jp) + 4 * g;
                const u32x2 a0 = *(const u32x2*)vr, a1 = *(const u32x2*)(vr + 16);
                u32x4 au; au[0] = a0[0]; au[1] = a0[1]; au[2] = a1[0]; au[3] = a1[1];
                O[dt] = __builtin_amdgcn_mfma_f32_16x16x32_bf16(__builtin_bit_cast(bf16x8, au), Pf, O[dt], 0, 0, 0);
            }
        }
#pragma unroll
        for (int dt = 0; dt < 4; ++dt) {
            u32x2 o; o[0] = cvt_pk_bf16(O[dt][0], O[dt][1]); o[1] = cvt_pk_bf16(O[dt][2], O[dt][3]);
            *(u32x2*)(MIX + qrow * DM + head * 64 + 16 * dt + 4 * g) = o;
        }
    }
    __syncthreads();
}

__device__ __forceinline__ void retu_item(const Params& p, unsigned char* shm, int item) {
    const int tid = threadIdx.x, wid = tid >> 6, lane = tid & 63, lr = lane & 15, g = lane >> 4;
    const int b = item >> 7, h = (item >> 5) & 3, c = item & 31;
    const bf16_t* Z = (const bf16_t*)(p.ws + WS_Z); float* UT = (float*)(p.ws + WS_H);
    bf16_t* KT = (bf16_t*)shm;
    bf16_t* VT = KT + 128 * 136;
    const float lg = log_gamma(h);
    {
        const int j = tid >> 2, q = tid & 3;
        const size_t row = (size_t)b * SEQ + (size_t)c * 128 + j;
        const float dec = __expf(lg * (float)(127 - j));
        const bf16_t* kp = Z + row * INW + 1280 + h * 128 + q * 32; const bf16_t* vp = Z + row * INW + 1792 + h * 128 + q * 32;
#pragma unroll
        for (int cc = 0; cc < 4; ++cc) {
            const u32x4 kv = *(const u32x4*)(kp + cc * 8), vv = *(const u32x4*)(vp + cc * 8);
#pragma unroll
            for (int e = 0; e < 4; ++e) {
                const int d = q * 32 + cc * 8 + 2 * e;
                KT[d * 136 + j] = f2bf(bflo(kv[e]) * dec); KT[(d + 1) * 136 + j] = f2bf(bfhi(kv[e]) * dec);
                VT[d * 136 + j] = (bf16_t)(vv[e] & 0xffffu); VT[(d + 1) * 136 + j] = (bf16_t)(vv[e] >> 16);
            }
        }
    }
    __syncthreads();
    f32x4 acc[8];
#pragma unroll
    for (int dt = 0; dt < 8; ++dt) acc[dt] = (f32x4){0.f, 0.f, 0.f, 0.f};
#pragma unroll
    for (int kk = 0; kk < 4; ++kk) {
        const bf16x8 Bf = *(const bf16x8*)(VT + (16 * wid + lr) * 136 + kk * 32 + g * 8);
#pragma unroll
        for (int dt = 0; dt < 8; ++dt) {
            const bf16x8 Af = *(const bf16x8*)(KT + (16 * dt + lr) * 136 + kk * 32 + g * 8);
            acc[dt] = __builtin_amdgcn_mfma_f32_16x16x32_bf16(Af, Bf, acc[dt], 0, 0, 0);
        }
    }
    float* up = UT + (size_t)item * 16384 + (size_t)(16 * wid + lr) * 128;
#pragma unroll
    for (int dt = 0; dt < 8; ++dt) *(f32x4*)(up + 16 * dt + 4 * g) = acc[dt];
    __syncthreads();
}

__device__ __forceinline__ void phase_scan(const Params& p) {
    const float* UT = (const float*)(p.ws + WS_H); bf16_t* SST = (bf16_t*)(p.ws + WS_SST);
    const int gt = blockIdx.x * 512 + threadIdx.x, gs = gridDim.x * 512;
    for (int i = gt; i < 32 * 4096; i += gs) {
        const int bh = i >> 12, ed = (i & 4095) * 4, e = ed >> 7, d = ed & 127, h = bh & 3;
        const float gL = __expf(log_gamma(h) * 128.f);
        f32x4 s = (f32x4){0.f, 0.f, 0.f, 0.f};
        const float* up = UT + (size_t)bh * 32 * 16384 + ed; bf16_t* sp = SST + (size_t)bh * 32 * 16384 + ed;
#pragma unroll
        for (int c0 = 0; c0 < 32; c0 += 16) {
            f32x4 uv[16];
#pragma unroll
            for (int c = 0; c < 16; ++c) uv[c] = __builtin_nontemporal_load((const f32x4*)(up + (size_t)(c0 + c) * 16384));
#pragma unroll
            for (int c = 0; c < 16; ++c) { u32x2 o; o[0] = cvt_pk_bf16(s[0], s[1]); o[1] = cvt_pk_bf16(s[2], s[3]); *(u32x2*)(sp + (size_t)(c0 + c) * 16384) = o; s = gL * s + uv[c]; }
        }
#pragma unroll
        for (int k = 0; k < 4; ++k) p.out[O_RP + ((size_t)bh * 128 + ret_dim(d + k)) * 128 + e] = s[k];
    }
}

typedef short s16x4 __attribute__((ext_vector_type(4)));
__device__ __forceinline__ u32x2 lds_tr_read(const bf16_t* addr) {
    const s16x4 r = __builtin_amdgcn_ds_read_tr16_b64_v4i16((LAS s16x4*)(LAS void*)(unsigned)(size_t)addr);
    return __builtin_bit_cast(u32x2, r);
}
__device__ __forceinline__ void reto_load(const Params& p, int item, u32x4 (&kv)[4], u32x4 (&vv)[4], u32x4 (&sv)[4]) {
    const int tid = threadIdx.x, b = item >> 7, h = (item >> 5) & 3, c = item & 31;
    const bf16_t* Z = (const bf16_t*)(p.ws + WS_Z); const bf16_t* SST = (const bf16_t*)(p.ws + WS_SST);
    const size_t row0 = (size_t)b * SEQ + (size_t)c * 128;
    const int j = tid >> 2, q = tid & 3;
    const bf16_t* kp = Z + (row0 + j) * INW + 1280 + h * 128 + q * 32; const bf16_t* vp = Z + (row0 + j) * INW + 1792 + h * 128 + q * 32;
    const bf16_t* sp = SST + (size_t)item * 16384 + j * 128 + q * 32;
#pragma unroll
    for (int cc = 0; cc < 4; ++cc) { kv[cc] = *(const u32x4*)(kp + cc * 8); vv[cc] = *(const u32x4*)(vp + cc * 8); sv[cc] = *(const u32x4*)(sp + cc * 8); }
}
__device__ __forceinline__ void reto_phase(const Params& p, unsigned char* shm, int first, int stride) {
    u32x4 kvr[4], vvr[4], svr[4];
    if (first < 1024) reto_load(p, first, kvr, vvr, svr);
    for (int item = first; item < 1024; item += stride) {
    const int tid = threadIdx.x, wid = tid >> 6, lane = tid & 63, lr = lane & 15, g = lane >> 4;
    const int b = item >> 7, h = (item >> 5) & 3, c = item & 31;
    const bf16_t* Z = (const bf16_t*)(p.ws + WS_Z); bf16_t* MIX = (bf16_t*)(p.ws + WS_MIX);
    bf16_t* Ks = (bf16_t*)shm;
    bf16_t* VT = Ks + 128 * 136;
    bf16_t* Ss = VT + 128 * 136;
    const float lg = log_gamma(h);
    const size_t row0 = (size_t)b * SEQ + (size_t)c * 128;
    {
        const int j = tid >> 2, q = tid & 3;
#pragma unroll
        for (int cc = 0; cc < 4; ++cc) {
            *(u32x4*)(Ks + j * 136 + q * 32 + cc * 8) = kvr[cc];
            *(u32x4*)(Ss + j * 136 + q * 32 + cc * 8) = svr[cc];
            *(u32x4*)(VT + j * 136 + q * 32 + cc * 8) = vvr[cc];
        }
    }
    __syncthreads();
    const size_t qrow = row0 + 16 * wid + lr;
    bf16x8 Qf[4];
#pragma unroll
    for (int kk = 0; kk < 4; ++kk) Qf[kk] = *(const bf16x8*)(Z + qrow * INW + 768 + h * 128 + kk * 32 + g * 8);
    if (item + stride < 1024) reto_load(p, item + stride, kvr, vvr, svr);
    f32x4 S[8];
#pragma unroll
    for (int jt = 0; jt < 8; ++jt) {
        S[jt] = (f32x4){0.f, 0.f, 0.f, 0.f};
        if (jt <= wid) {
#pragma unroll
            for (int kk = 0; kk < 4; ++kk) {
                const bf16x8 Kf = *(const bf16x8*)(Ks + (16 * jt + lr) * 136 + kk * 32 + g * 8);
                S[jt] = __builtin_amdgcn_mfma_f32_16x16x32_bf16(Kf, Qf[kk], S[jt], 0, 0, 0);
            }
        }
    }
    const int it = 16 * wid + lr;
#pragma unroll
    for (int jt = 0; jt < 8; ++jt)
#pragma unroll
        for (int r = 0; r < 4; ++r) { const int j = 16 * jt + 4 * g + r; S[jt][r] = (j <= it) ? S[jt][r] * __expf(lg * (float)(it - j)) : 0.f; }
    f32x4 O1[8], O2[8];
#pragma unroll
    for (int et = 0; et < 8; ++et) { O1[et] = (f32x4){0.f, 0.f, 0.f, 0.f}; O2[et] = (f32x4){0.f, 0.f, 0.f, 0.f}; }
#pragma unroll
    for (int jp = 0; jp < 4; ++jp) {
        if (2 * jp <= wid) {
            u32x4 pu; pu[0] = cvt_pk_bf16(S[2 * jp][0], S[2 * jp][1]); pu[1] = cvt_pk_bf16(S[2 * jp][2], S[2 * jp][3]);
            pu[2] = cvt_pk_bf16(S[2 * jp + 1][0], S[2 * jp + 1][1]); pu[3] = cvt_pk_bf16(S[2 * jp + 1][2], S[2 * jp + 1][3]);
            const bf16x8 Pf = __builtin_bit_cast(bf16x8, pu);
#pragma unroll
            for (int et = 0; et < 8; ++et) {
                const bf16_t* vr = VT + (32 * jp + 4 * g + (lr >> 2)) * 136 + 16 * et + 4 * (lr & 3);
                const u32x2 a0 = lds_tr_read(vr), a1 = lds_tr_read(vr + 16 * 136);
                u32x4 au; au[0] = a0[0]; au[1] = a0[1]; au[2] = a1[0]; au[3] = a1[1];
                O1[et] = __builtin_amdgcn_mfma_f32_16x16x32_bf16(__builtin_bit_cast(bf16x8, au), Pf, O1[et], 0, 0, 0);
            }
        }
    }
#pragma unroll
    for (int kk = 0; kk < 4; ++kk)
#pragma unroll
        for (int et = 0; et < 8; ++et) {
            const bf16x8 Sf = *(const bf16x8*)(Ss + (16 * et + lr) * 136 + kk * 32 + g * 8);
            O2[et] = __builtin_amdgcn_mfma_f32_16x16x32_bf16(Sf, Qf[kk], O2[et], 0, 0, 0);
        }
    const float qd = __expf(lg * (float)(it + 1));
    float sum = 0.f;
#pragma unroll
    for (int et = 0; et < 8; ++et)
#pragma unroll
        for (int r = 0; r < 4; ++r) { const float o = O1[et][r] + qd * O2[et][r]; O1[et][r] = o; sum += o; }
    sum += __shfl_xor(sum, 16); sum += __shfl_xor(sum, 32);
    const float mu = sum * (1.f / 128.f);
    float vs = 0.f;
#pragma unroll
    for (int et = 0; et < 8; ++et)
#pragma unroll
        for (int r = 0; r < 4; ++r) { const float dlt = O1[et][r] - mu; vs += dlt * dlt; }
    vs += __shfl_xor(vs, 16); vs += __shfl_xor(vs, 32);
    const float rstd = rsqrtf(vs * (1.f / 128.f) + 1e-6f);
#pragma unroll
    for (int et = 0; et < 8; ++et) {
        const int e = 16 * et + 4 * g;
        const u32x2 gz = *(const u32x2*)(Z + qrow * INW + 2304 + h * 128 + e);
        const f32x4 gw = *(const f32x4*)(p.ret_gn_w + h * 128 + e);
        const float r0 = (O1[et][0] - mu) * rstd * gw[0] * silu_f(bflo(gz[0])), r1 = (O1[et][1] - mu) * rstd * gw[1] * silu_f(bfhi(gz[0]));
        const float r2 = (O1[et][2] - mu) * rstd * gw[2] * silu_f(bflo(gz[1])), r3 = (O1[et][3] - mu) * rstd * gw[3] * silu_f(bfhi(gz[1]));
        u32x2 o; o[0] = cvt_pk_bf16(r0, r1); o[1] = cvt_pk_bf16(r2, r3);
        *(u32x2*)(MIX + qrow * DM + 512 + h * 128 + e) = o;
    }
    __syncthreads();
    }
}

__device__ __forceinline__ void sample_att(const Params& p, unsigned char* shm, int b) {
    const int tid = threadIdx.x, wid = tid >> 6, lane = tid & 63;
    const bf16_t* zrow = (const bf16_t*)(p.ws + WS_Z) + (size_t)(TP + b) * INW; bf16_t* mixrow = (bf16_t*)(p.ws + WS_MIX) + (size_t)(TP + b) * DM;
    float* sm = (float*)shm;
    float* qn = sm;
    float* kn = qn + 512;
    float* vn = kn + 128;
    float* scs = vn + 128;
    { const int hh = tid >> 6, pp = tid & 63; qn[hh * 64 + att_dim(pp)] = bf2f(zrow[tid]); }
    if (tid < 128) { const int hh = tid >> 6, pp = tid & 63; kn[hh * 64 + att_dim(pp)] = bf2f(zrow[512 + tid]); vn[tid] = bf2f(zrow[640 + tid]); }
    __syncthreads();
    const float* ck = p.cache_k + (size_t)b * 128 * 128; const float* cv = p.cache_v + (size_t)b * 128 * 128;
#pragma unroll
    for (int itr = 0; itr < 2; ++itr) {
        const int idx = tid + 512 * itr, hd = idx >> 7, w = idx & 127, kvh = hd >> 2;
        const float* kr = ck + (w * 2 + kvh) * 64; const float* qr = qn + hd * 64;
        float s = 0.f;
#pragma unroll
        for (int d = 0; d < 64; d += 4) { const f32x4 kv = *(const f32x4*)(kr + d); s += qr[d] * kv[0] + qr[d + 1] * kv[1] + qr[d + 2] * kv[2] + qr[d + 3] * kv[3]; }
        scs[hd * 132 + w] = s * 0.125f;
    }
    if (tid < 8) { const int kvh = tid >> 2; float s = 0.f; for (int d = 0; d < 64; ++d) s += qn[tid * 64 + d] * kn[kvh * 64 + d]; scs[tid * 132 + 128] = s * 0.125f; }
    __syncthreads();
    {
        const float sink = p.att_sinks[wid];
        const float s0 = scs[wid * 132 + lane], s1 = scs[wid * 132 + 64 + lane], s2 = lane == 0 ? scs[wid * 132 + 128] : -INFINITY;
        float mx = fmaxf(fmaxf(s0, s1), fmaxf(s2, sink));
#pragma unroll
        for (int o = 32; o >= 1; o >>= 1) mx = fmaxf(mx, __shfl_xor(mx, o));
        const float e0 = __expf(s0 - mx), e1 = __expf(s1 - mx), e2 = lane == 0 ? __expf(s2 - mx) : 0.f;
        float sum = e0 + e1 + e2;
#pragma unroll
        for (int o = 32; o >= 1; o >>= 1) sum += __shfl_xor(sum, o);
        const float inv = 1.f / (sum + __expf(sink - mx));
        scs[wid * 132 + lane] = e0 * inv; scs[wid * 132 + 64 + lane] = e1 * inv; if (lane == 0) scs[wid * 132 + 128] = e2 * inv;
    }
    __syncthreads();
    {
        const int hd = tid >> 6, d = tid & 63, kvh = hd >> 2;
        float o = scs[hd * 132 + 128] * vn[kvh * 64 + d];
#pragma unroll 16
        for (int w = 0; w < 128; ++w) o += scs[hd * 132 + w] * cv[(w * 2 + kvh) * 64 + d];
        mixrow[hd * 64 + d] = f2bf(o);
    }
    for (int i = tid; i < 127 * 32; i += 512) {
        *(f32x4*)(p.out + O_KS + (size_t)b * 16384 + i * 4) = *(const f32x4*)(ck + 128 + i * 4);
        *(f32x4*)(p.out + O_VS + (size_t)b * 16384 + i * 4) = *(const f32x4*)(cv + 128 + i * 4);
    }
    __syncthreads();
}
__device__ __forceinline__ void sample_ret(const Params& p, unsigned char* shm, int item) {
    const int tid = threadIdx.x, b = item >> 2, h = item & 3;
    const bf16_t* zrow = (const bf16_t*)(p.ws + WS_Z) + (size_t)(TP + b) * INW; bf16_t* mixrow = (bf16_t*)(p.ws + WS_MIX) + (size_t)(TP + b) * DM;
    float* sm = (float*)shm;
    float* rqn = sm;
    float* rkn = rqn + 128;
    float* red = rkn + 128;
    float* qkp = red + 512;
    float* ov = qkp + 4;
    if (tid < 128) { const int dn = ret_dim(tid); rqn[dn] = bf2f(zrow[768 + h * 128 + tid]); rkn[dn] = bf2f(zrow[1280 + h * 128 + tid]); }
    __syncthreads();
    const float gm = __expf(log_gamma(h));
    const int e = tid & 127, dq = tid >> 7;
    const float* sp = p.state_ret + ((size_t)(b * 4 + h) * 128 + dq * 32) * 128 + e;
    float* so = p.out + O_RS + ((size_t)(b * 4 + h) * 128 + dq * 32) * 128 + e;
    const float ve = bf2f(zrow[1792 + h * 128 + e]);
    float sv[32];
#pragma unroll
    for (int d = 0; d < 32; ++d) sv[d] = sp[d * 128];
    float part = 0.f, qk = 0.f;
#pragma unroll
    for (int d = 0; d < 32; ++d) { const float qd = rqn[dq * 32 + d], kd = rkn[dq * 32 + d]; part += qd * sv[d]; qk += qd * kd; so[d * 128] = gm * sv[d] + kd * ve; }
    red[dq * 128 + e] = part; if (e == 0) qkp[dq] = qk;
    __syncthreads();
    if (tid < 128) ov[tid] = (qkp[0] + qkp[1] + qkp[2] + qkp[3]) * ve + gm * (red[e] + red[128 + e] + red[256 + e] + red[384 + e]);
    __syncthreads();
    if (tid < 64) {
        const float o0 = ov[tid], o1 = ov[tid + 64];
        float sum = o0 + o1;
#pragma unroll
        for (int o = 32; o >= 1; o >>= 1) sum += __shfl_xor(sum, o);
        const float mu = sum * (1.f / 128.f);
        float vs = (o0 - mu) * (o0 - mu) + (o1 - mu) * (o1 - mu);
#pragma unroll
        for (int o = 32; o >= 1; o >>= 1) vs += __shfl_xor(vs, o);
        const float rstd = rsqrtf(vs * (1.f / 128.f) + 1e-6f);
#pragma unroll
        for (int k = 0; k < 2; ++k) { const int ee = tid + 64 * k; const float gz = bf2f(zrow[2304 + h * 128 + ee]);
            mixrow[512 + h * 128 + ee] = f2bf(((k ? o1 : o0) - mu) * rstd * p.ret_gn_w[h * 128 + ee] * silu_f(gz)); }
    }
    __syncthreads();
}

template <int NB>
__device__ __forceinline__ void sg_mma(unsigned char* shm, const bf16_t* A, const bf16_t* b0, const bf16_t* b1, int K, f32x4& out0, f32x4& out1) {
    const int tid = threadIdx.x, wid = tid >> 6, lane = tid & 63, lr = lane & 15, g = lane >> 4;
    const int ks = K >> 3;
    const bf16_t* ap = A + (size_t)(TP + lr) * K + 8 * g + wid * ks;
    b0 += wid * ks; if (NB == 2) b1 += wid * ks;
    f32x4 acc[8][NB];
#pragma unroll
    for (int rg = 0; rg < 8; ++rg)
#pragma unroll
        for (int nb = 0; nb < NB; ++nb) acc[rg][nb] = (f32x4){0.f, 0.f, 0.f, 0.f};
    for (int k = 0; k < ks; k += 32) {
        const bf16x8 w0 = *(const bf16x8*)(b0 + k);
        bf16x8 w1 = w0; if (NB == 2) w1 = *(const bf16x8*)(b1 + k);
        bf16x8 a[8];
#pragma unroll
        for (int rg = 0; rg < 8; ++rg) a[rg] = *(const bf16x8*)(ap + (size_t)(16 * rg) * K + k);
#pragma unroll
        for (int rg = 0; rg < 8; ++rg) {
            acc[rg][0] = __builtin_amdgcn_mfma_f32_16x16x32_bf16(w0, a[rg], acc[rg][0], 0, 0, 0);
            if (NB == 2) acc[rg][NB - 1] = __builtin_amdgcn_mfma_f32_16x16x32_bf16(w1, a[rg], acc[rg][NB - 1], 0, 0, 0);
        }
    }
    f32x4* red = (f32x4*)shm;
#pragma unroll
    for (int nb = 0; nb < NB; ++nb) {
        __syncthreads();
#pragma unroll
        for (int rg = 0; rg < 8; ++rg) red[(wid * 8 + rg) * 64 + lane] = acc[rg][nb];
        __syncthreads();
        f32x4 sum = red[(0 * 8 + wid) * 64 + lane];
#pragma unroll
        for (int w = 1; w < 8; ++w) sum += red[(w * 8 + wid) * 64 + lane];
        if (nb == 0) out0 = sum; else out1 = sum;
    }
    __syncthreads();
}
__device__ __forceinline__ void sg_ln(const Params& p, unsigned char* shm, int item, const bf16_t* A, const bf16_t* Bt, int K, const float* base, int gate_off, float* stat, unsigned* cnt,
                                      const float* lw, const float* lb, bf16_t* H, int h_off) {
    const int tid = threadIdx.x, wid = tid >> 6, lane = tid & 63, lr = lane & 15, g = lane >> 4;
    const int n0 = item * 16, m = 16 * wid + lr;
    f32x4 acc = (f32x4){0.f, 0.f, 0.f, 0.f}, dummy = acc;
    sg_mma<1>(shm, A, Bt + (size_t)(n0 + lr) * K + 8 * g, nullptr, K, acc, dummy);
    const int c = n0 + 4 * g;
    const float* mrow = (const float*)(p.ws + WS_MOD) + (size_t)m * 6144;
    const f32x4 xv = *(const f32x4*)(base + (size_t)m * DM + c), gv = *(const f32x4*)(mrow + gate_off + c);
    const f32x4 res = ALPHA * xv + (1.f + gv) * acc;
    float s = res[0] + res[1] + res[2] + res[3], ss = res[0] * res[0] + res[1] * res[1] + res[2] * res[2] + res[3] * res[3];
    s += __shfl_xor(s, 16); ss += __shfl_xor(ss, 16); s += __shfl_xor(s, 32); ss += __shfl_xor(ss, 32);
    if (g == 0) { __hip_atomic_fetch_add(stat + 2 * (TP + m), s, __ATOMIC_RELAXED, __HIP_MEMORY_SCOPE_AGENT); __hip_atomic_fetch_add(stat + 2 * (TP + m) + 1, ss, __ATOMIC_RELAXED, __HIP_MEMORY_SCOPE_AGENT); }
    asm volatile("s_waitcnt vmcnt(0)" ::: "memory");
    unsigned* pc = cnt + wid * 16;
    if (lane == 0) __hip_atomic_fetch_add(pc, 1u, __ATOMIC_RELAXED, __HIP_MEMORY_SCOPE_AGENT);
    wait_ge(pc, 64u, (unsigned*)(p.ws + WS_CNT) + 527 * 16 + 8);
    asm volatile("" ::: "memory");
    const float sa = __hip_atomic_load(stat + 2 * (TP + m), __ATOMIC_RELAXED, __HIP_MEMORY_SCOPE_AGENT), sb = __hip_atomic_load(stat + 2 * (TP + m) + 1, __ATOMIC_RELAXED, __HIP_MEMORY_SCOPE_AGENT);
    const float mu = sa * (1.f / 1024.f), var = sb * (1.f / 1024.f) - mu * mu, rstd = rsqrtf(fmaxf(var, 0.f) + 1e-5f);
    const f32x4 y = (res - mu) * rstd * *(const f32x4*)(lw + c) + *(const f32x4*)(lb + c);
    *(f32x4*)(p.out + O_YS + (size_t)m * DM + c) = y;
    if (H) { const f32x4 hv = y * (1.f + *(const f32x4*)(mrow + h_off + 1024 + c)) + *(const f32x4*)(mrow + h_off + c);
             u32x2 o; o[0] = cvt_pk_bf16(hv[0], hv[1]); o[1] = cvt_pk_bf16(hv[2], hv[3]); *(u32x2*)(H + (size_t)(TP + m) * DM + c) = o; }
}
__device__ __forceinline__ void sg_up(const Params& p, unsigned char* shm, int item) {
    const int tid = threadIdx.x, wid = tid >> 6, lane = tid & 63, lr = lane & 15, g = lane >> 4;
    const int n0 = item * 16, m = 16 * wid + lr, pn = n0 >> 7, off = n0 & 127;
    const bf16_t* A = (const bf16_t*)(p.ws + WS_H); const bf16_t* Bt = (const bf16_t*)(p.ws + WS_WUP);
    f32x4 ag = (f32x4){0.f, 0.f, 0.f, 0.f}, au = ag;
    sg_mma<2>(shm, A, Bt + (size_t)(256 * pn + off + lr) * DM + 8 * g, Bt + (size_t)(256 * pn + 128 + off + lr) * DM + 8 * g, DM, ag, au);
    u32x2 o; o[0] = cvt_pk_bf16(silu_f(ag[0]) * au[0], silu_f(ag[1]) * au[1]); o[1] = cvt_pk_bf16(silu_f(ag[2]) * au[2], silu_f(ag[3]) * au[3]);
    *(u32x2*)((bf16_t*)(p.ws + WS_Z) + (size_t)(TP + m) * DFF + n0 + 4 * g) = o;
}

#define XB_TMO      128
#define XB_XCNT(j)  (256  + 64 * (j))
#define XB_XSUB(j)  (1280 + 64 * (j))
#define XB_XGEN(j)  (2304 + 64 * (j))
#define XB_TOP      3328
#define XB_TOPGEN   3392
#define XCD_BAR_WORDS 3456
#define XB_SPIN_CAP (1u << 18)
__device__ __forceinline__ unsigned xb_ld(unsigned* p)              { return __hip_atomic_load(p, __ATOMIC_RELAXED, __HIP_MEMORY_SCOPE_AGENT); }
__device__ __forceinline__ unsigned xb_add(unsigned* p, unsigned v) { return __hip_atomic_fetch_add(p, v, __ATOMIC_RELAXED, __HIP_MEMORY_SCOPE_AGENT); }
__device__ __forceinline__ unsigned xb_xcc_id() { return (unsigned)__builtin_amdgcn_s_getreg((3 << 11) | 20) & 0xFu; }
#define XB_SPIN(cond, bar) do { unsigned _sp = 0; while (cond) { __builtin_amdgcn_s_sleep(1); \
    if ((++_sp & 255u) == 0u) { if (xb_ld(&(bar)[XB_TMO])) break; if (_sp > XB_SPIN_CAP) { atomicAdd(&(bar)[XB_TMO], 1u); break; } } } } while (0)
struct XcdBarrier { unsigned* bar; unsigned x; volatile LAS unsigned* st; };
__device__ __forceinline__ XcdBarrier xcd_barrier_post(unsigned* bar, volatile LAS unsigned* st) {
    XcdBarrier b; b.bar = bar; b.x = xb_xcc_id(); b.st = st;
    if (threadIdx.x == 0) (void)xb_add(&bar[XB_XCNT(b.x)], 1u);
    return b;
}
__device__ __forceinline__ void xcd_barrier_complete(unsigned* bar, unsigned x, unsigned& nloc, unsigned& nx) {
    const unsigned G = gridDim.x * gridDim.y * gridDim.z;
    unsigned sum, cnt, mine, sp = 0u;
    for (;;) {
        sum = 0u; cnt = 0u; mine = 0u;
#pragma unroll
        for (unsigned j = 0; j < 16; ++j) { const unsigned c = xb_ld(&bar[XB_XCNT(j)]); sum += c; cnt += (c > 0u) ? 1u : 0u; mine = (j == x) ? c : mine; }
        if (sum == G) break;
        __builtin_amdgcn_s_sleep(1);
        if ((++sp & 255u) == 0u) { if (xb_ld(&bar[XB_TMO])) break; if (sp > XB_SPIN_CAP) { atomicAdd(&bar[XB_TMO], 1u); break; } }
    }
    nloc = mine > 0u ? mine : 1u; nx = cnt > 0u ? cnt : 1u;
}
__device__ __forceinline__ void xcd_barrier(const XcdBarrier& b) {
    asm volatile("s_waitcnt vmcnt(0)" ::: "memory");
    __syncthreads();
    if (threadIdx.x == 0) {
        unsigned* bar = b.bar;
        __builtin_amdgcn_s_waitcnt(0);
        unsigned nloc = b.st[0], nx = b.st[1];
        if (nloc == 0u) { xcd_barrier_complete(bar, b.x, nloc, nx); b.st[0] = nloc; b.st[1] = nx; }
        const unsigned old = xb_add(&bar[XB_XSUB(b.x)], 1u);
        const unsigned gen = old / nloc;
        if (old + 1u == (gen + 1u) * nloc) {
            __builtin_amdgcn_fence(__ATOMIC_RELEASE, "agent");
            asm volatile("s_waitcnt vmcnt(0)" ::: "memory");
            const unsigned og = xb_add(&bar[XB_TOP], 1u);
            const unsigned tg = og / nx;
            if (og + 1u == (tg + 1u) * nx) xb_add(&bar[XB_TOPGEN], 1u);
            else XB_SPIN(xb_ld(&bar[XB_TOPGEN]) == tg, bar);
            __builtin_amdgcn_fence(__ATOMIC_ACQUIRE, "agent");
            xb_add(&bar[XB_XGEN(b.x)], 1u);
            asm volatile("s_waitcnt vmcnt(0)" ::: "memory");
        } else {
            XB_SPIN(xb_ld(&bar[XB_XGEN(b.x)]) == gen, bar);
            __builtin_amdgcn_fence(__ATOMIC_ACQUIRE, "agent");
            asm volatile("s_waitcnt vmcnt(0)" ::: "memory");
        }
    }
    __syncthreads();
}

typedef __attribute__((address_space(4))) const unsigned char* kptr_t;
__device__ __forceinline__ Params load_params() {
#if defined(__HIP_DEVICE_COMPILE__)
    kptr_t k = (kptr_t)__builtin_amdgcn_kernarg_segment_ptr();
    asm volatile("" : "+s"(k));
    Params r;
    __builtin_memcpy(&r, (const __attribute__((address_space(4))) void*)k, sizeof(Params));
    return r;
#else
    return Params{};
#endif
}
__global__ void __launch_bounds__(512, 2) fwd(Params p_arg, int ph_lo, int ph_hi, int coop) {
    extern __shared__ __attribute__((aligned(16))) unsigned char shm[];
    cg::grid_group grid = cg::this_grid();
    LAS unsigned char* lds = (LAS unsigned char*)shm;
    const int G = gridDim.x, bid = blockIdx.x;
    volatile LAS unsigned* bst = (volatile LAS unsigned*)(lds + 131072);
    if (threadIdx.x < 4) bst[threadIdx.x] = 0u;
    __syncthreads();
    (void)xcd_barrier_post((unsigned*)(p_arg.ws + WS_BAR), bst);
    if (coop > 1) grid.sync();
#define GSYNC() do { XcdBarrier xb_; xb_.bar = (unsigned*)(load_params().ws + WS_BAR); xb_.x = xb_xcc_id(); xb_.st = (volatile LAS unsigned*)((LAS unsigned char*)shm + 131072); xcd_barrier(xb_); } while (0)
#ifndef ONLY
#define ONLY -1
#endif
#ifndef REP_PH
#define REP_PH -1
#endif
#ifndef REP_SYNC
#define REP_SYNC 0
#endif
#define PH_BEGIN(n) if ((ONLY < 0 || ONLY == n) && ph_lo <= n && n < ph_hi) { if (n > ph_lo && coop) GSYNC(); for (int rep_ = 0; rep_ < (REP_PH == n ? 2 : 1); ++rep_) { if (rep_) GSYNC(); const Params p = load_params();
#define PH_END } }
    for (int i_ = 0; i_ < REP_SYNC; ++i_) GSYNC();
    PH_BEGIN(0) { prep_tiles(p, shm, 768 + bid, 1152, G); prep_misc(p); } PH_END
    PH_BEGIN(1) { if (bid >= 24) prep_tiles(p, shm, bid - 24, 768, G - 24);
                  pg8::Gemm g{(const bf16_t*)(p.ws + WS_SC), (const bf16_t*)(p.ws + WS_WADA), 256, 6144, DM}; pg8::StaticOrder S; S.init(g.M, g.N, G, bid);
                  EpiAda E{(float*)(p.ws + WS_MOD), p.b_ada_mix, p.b_ada_ffn}; pg8::gemm_phase(lds, g, S, E); } PH_END
    PH_BEGIN(2) phase_modulate(p); PH_END
    PH_BEGIN(3) { pg8::Gemm g{(const bf16_t*)(p.ws + WS_H), (const bf16_t*)(p.ws + WS_WIN), TPAD, INW, DM}; pg8::StaticOrder S; S.init(g.M, g.N, G, bid);
                  EpiIn E{(bf16_t*)(p.ws + WS_Z), (const float*)(p.ws + WS_ROPEA), (const float*)(p.ws + WS_ROPER), p.out}; pg8::gemm_phase(lds, g, S, E); } PH_END
    PH_BEGIN(4) { for (int it = bid; it < 1024; it += G) retu_item(p, shm, it); for (int it = bid; it < 512; it += G) attn_item(p, shm, it); for (int it = G - 1 - bid; it < 512; it += G) sample_ret(p, shm, it); for (int it = bid; it < 128; it += G) sample_att(p, shm, it); } PH_END
    PH_BEGIN(5) phase_scan(p); PH_END
    PH_BEGIN(6) reto_phase(p, shm, bid, G); PH_END
    PH_BEGIN(7) { for (int it = G - 1 - bid; it < 64; it += G) sg_ln(p, shm, it, (const bf16_t*)(p.ws + WS_MIX), (const bf16_t*)(p.ws + WS_WOUT), DM, p.x_sample, 2048, (float*)(p.ws + WS_STAT1),
                                                                       (unsigned*)(p.ws + WS_CNT) + 512 * 16, p.ln1_w, p.ln1_b, (bf16_t*)(p.ws + WS_H), 3072);
                  pg8::Gemm g{(const bf16_t*)(p.ws + WS_MIX), (const bf16_t*)(p.ws + WS_WOUT), TP, DM, DM}; pg8::StaticOrder S; S.init(g.M, g.N, G, bid);
                  EpiLn<false, true> E{p.x_prompt, p.ws + WS_MIX, (const float*)(p.ws + WS_MOD), 2048, (float*)(p.ws + WS_STAT1), (unsigned*)(p.ws + WS_CNT), p.ln1_w, p.ln1_b, (bf16_t*)(p.ws + WS_H), 3072, (unsigned*)(p.ws + WS_CNT) + 527 * 16 + 8};
                  pg8::gemm_phase(lds, g, S, E); } PH_END
    PH_BEGIN(9) { for (int it = G - 1 - bid; it < 176; it += G) sg_up(p, shm, it);
                  pg8::Gemm g{(const bf16_t*)(p.ws + WS_H), (const bf16_t*)(p.ws + WS_WUP), TP, 2 * DFF, DM}; pg8::StaticOrder S; S.init(g.M, g.N, G, bid);
                  EpiUp E{(bf16_t*)(p.ws + WS_Z)}; pg8::gemm_phase(lds, g, S, E); } PH_END
    PH_BEGIN(10) { for (int it = G - 1 - bid; it < 64; it += G) sg_ln(p, shm, it, (const bf16_t*)(p.ws + WS_Z), (const bf16_t*)(p.ws + WS_WDOWN), DFF, p.out + O_YS, 3072 + 2048, (float*)(p.ws + WS_STAT2),
                                                                        (unsigned*)(p.ws + WS_CNT) + 520 * 16, p.ln2_w, p.ln2_b, nullptr, 0);
                   pg8::Gemm g{(const bf16_t*)(p.ws + WS_Z), (const bf16_t*)(p.ws + WS_WDOWN), TP, DM, DFF}; pg8::StaticOrder S; S.init(g.M, g.N, G, bid);
                   EpiLn<true, false> E{p.ws + WS_MIX, p.out, (const float*)(p.ws + WS_MOD), 3072 + 2048, (float*)(p.ws + WS_STAT2), (unsigned*)(p.ws + WS_CNT) + 256 * 16, p.ln2_w, p.ln2_b, nullptr, 0, (unsigned*)(p.ws + WS_CNT) + 527 * 16 + 8};
                   pg8::gemm_phase(lds, g, S, E); } PH_END
}

extern "C" void kernel_launch(void* const* d_in, const int* in_sizes, int n_in, void* d_out, int out_size, void* d_ws, size_t ws_size, hipStream_t stream) {
    constexpr int LDS_BYTES = 131072 + 64;
    static int grid = 0;
    if (!grid) {
        int dev = 0, cus = 0, per_cu = 0;
        (void)hipGetDevice(&dev);
        (void)hipDeviceGetAttribute(&cus, hipDeviceAttributeMultiprocessorCount, dev);
        (void)hipFuncSetAttribute((const void*)fwd, hipFuncAttributeMaxDynamicSharedMemorySize, LDS_BYTES);
        (void)hipOccupancyMaxActiveBlocksPerMultiprocessor(&per_cu, (const void*)fwd, 512, LDS_BYTES);
        grid = cus > 0 ? cus : 256;
        if (ws_size < WS_END) fprintf(stderr, "kernel_launch: workspace too small: %zu < %zu\n", ws_size, (size_t)WS_END);
        fprintf(stderr, "kernel_launch: cus %d per_cu %d grid %d ws %zu need %zu\n", cus, per_cu, grid, ws_size, (size_t)WS_END);
    }
    Params p{};
    const float** f = (const float**)&p;
    for (int i = 0; i < 21; ++i) f[i] = (const float*)d_in[i];
    p.out = (float*)d_out; p.ws = (unsigned char*)d_ws;
#ifndef MULTI_LAUNCH
    (void)hipMemsetAsync((unsigned char*)d_ws + WS_BAR, 0, 16384, stream);
    int lo = 0, hi = 12, coop = 1;
    void* args[] = {&p, &lo, &hi, &coop};
    hipError_t e = hipLaunchCooperativeKernel((const void*)fwd, dim3(grid), dim3(512), args, LDS_BYTES, stream);
    if (e != hipSuccess) fprintf(stderr, "cooperative launch failed: %s (grid %d)\n", hipGetErrorString(e), grid);
#else
    for (int ph = 0; ph < 12; ++ph) hipLaunchKernelGGL(fwd, dim3(grid), dim3(512), LDS_BYTES, stream, p, ph, ph + 1, 0);
#endif
}
```

```cpp
#include <hip/hip_runtime.h>
#include <hip/hip_cooperative_groups.h>
#include <cstdio>
namespace cg = cooperative_groups;

#define LAS __attribute__((address_space(3)))
typedef unsigned short bf16_t;
typedef short bf16x8 __attribute__((ext_vector_type(8)));
typedef float f32x4 __attribute__((ext_vector_type(4)));
typedef unsigned u32x4 __attribute__((ext_vector_type(4)));
typedef unsigned u32x2 __attribute__((ext_vector_type(2)));

constexpr int DM = 1024, SEQ = 4096, NBATCH = 8, TP = NBATCH * SEQ  , NS = 128, TV = TP + NS  , TPAD = TP + 256  ;
constexpr int INW = 2816, DFF = 2816, PAST = 16384;
constexpr float ALPHA = 1.189207115002721f;
constexpr float RK_SCALE = 0.08838834764831845f;
constexpr size_t O_YP = 0, O_YS = (size_t)TP * DM, O_KP = O_YS + (size_t)NS * DM, O_VP = O_KP + 131072, O_RP = O_VP + 131072,
                 O_KS = O_RP + 524288, O_VS = O_KS + 2097152, O_RS = O_VS + 2097152;
constexpr size_t al256(size_t x) { return (x + 255) & ~(size_t)255; }
constexpr size_t WS_WIN = 0;
constexpr size_t WS_WOUT = WS_WIN + (size_t)INW * DM * 2;
constexpr size_t WS_WUP = WS_WOUT + (size_t)DM * DM * 2;
constexpr size_t WS_WDOWN = WS_WUP + (size_t)2 * DFF * DM * 2;
constexpr size_t WS_WADA = WS_WDOWN + (size_t)DM * DFF * 2;
constexpr size_t WS_SC = WS_WADA + (size_t)6144 * DM * 2;
constexpr size_t WS_MOD = WS_SC + (size_t)256 * DM * 2;
constexpr size_t WS_ROPEA = WS_MOD + (size_t)256 * 6144 * 4;
constexpr size_t WS_ROPER = al256(WS_ROPEA + (size_t)4097 * 16 * 4);
constexpr size_t WS_STAT1 = al256(WS_ROPER + (size_t)4097 * 128 * 4);
constexpr size_t WS_STAT2 = WS_STAT1 + (size_t)TPAD * 2 * 4;
constexpr size_t WS_H = al256(WS_STAT2 + (size_t)TPAD * 2 * 4);
constexpr size_t WS_Z = WS_H + (size_t)TPAD * DM * 2;
constexpr size_t WS_MIX = WS_Z + (size_t)TPAD * INW * 2;
constexpr size_t WS_SST = WS_MIX + (size_t)TPAD * DM * 2;
constexpr size_t WS_BAR = WS_SST + (size_t)1024 * 16384 * 2;
constexpr size_t WS_CNT = WS_BAR + 16384;
constexpr size_t WS_END = WS_CNT + 528 * 64;

struct Params {
    const float *x_prompt, *x_sample, *c_prompt, *c_sample, *cache_k, *cache_v, *state_ret, *w_ada_mix, *b_ada_mix, *w_in, *att_sinks, *ret_gn_w, *w_out,
        *ln1_w, *ln1_b, *w_ada_ffn, *b_ada_ffn, *w_up, *w_down, *ln2_w, *ln2_b;
    float* out; unsigned char* ws;
};

__device__ __forceinline__ unsigned cvt_pk_bf16(float lo, float hi) { unsigned r; asm volatile("v_cvt_pk_bf16_f32 %0, %1, %2" : "=v"(r) : "v"(lo), "v"(hi)); return r; }
__device__ __forceinline__ float bf2f(bf16_t b) { return __uint_as_float(((unsigned)b) << 16); }
__device__ __forceinline__ bf16_t f2bf(float f) { return (bf16_t)(cvt_pk_bf16(f, 0.f) & 0xffffu); }
__device__ __forceinline__ float bflo(unsigned u) { return __uint_as_float(u << 16); }
__device__ __forceinline__ float bfhi(unsigned u) { return __uint_as_float(u & 0xffff0000u); }
__device__ __forceinline__ float silu_f(float v) { return v * __builtin_amdgcn_rcpf(1.f + __expf(-v)); }
__device__ __forceinline__ float log_gamma(int h) {
    return h == 0 ? -0.0317486983145803f : (h == 1 ? -0.012479111952334388f : (h == 2 ? -0.004933717393740471f : -0.0019550348358033506f));
}
__device__ __forceinline__ int att_dim(int p) { if (p >= 16) return p; const int g = p >> 3, j = p & 7; return j < 4 ? 4 * g + j : 8 + 4 * g + (j - 4); }
__device__ __forceinline__ int ret_dim(int p) { const int g = p >> 3, j = p & 7; return j < 4 ? 4 * g + j : 64 + 4 * g + (j - 4); }
__device__ __forceinline__ int in_col(int P) {
    if (P < 640) return (P & ~63) + att_dim(P & 63);
    if (P >= 768 && P < 1792) { const int p = (P - 768) & 127; return P - p + ret_dim(p); }
    return P;
}
__device__ __forceinline__ int up_col(int P) { const int pn = P >> 8, q = P & 255; return q < 128 ? pn * 128 + q : DFF + pn * 128 + (q - 128); }

namespace pg8 {
constexpr int BM = 256, BK = 64, HALF = 128, HTB = HALF * BK * 2, STAGE_BYTES = 8 * HTB, NXCD = 8, WGM = 8;
__device__ __forceinline__ int lds_byte(int r, int c) { const int st = (r >> 4) * 2 + (c >> 5), rr = r & 15, cc = c & 31, ob = rr * 64 + cc * 2; return st * 1024 + (ob ^ (((ob >> 9) & 1) << 5)); }
__device__ __forceinline__ void stage_rc(int b, int& R, int& C) { const int st = b / 1024, sb = b % 1024, swz = sb ^ (((sb >> 9) & 1) << 5); R = (st >> 1) * 16 + swz / 64; C = (st & 1) * 32 + (swz % 64) / 2; }
__device__ __forceinline__ int perm32(int rho) { const int n = rho >> 4, i = rho & 15; return 8 * (i >> 2) + 4 * n + (i & 3); }
struct Unit { int pm, pn; };
struct Gemm { const bf16_t* A; const bf16_t* Bt; int M, N, K; };
struct StaticOrder {
    int nM, nN, nwg, G, c;
    __device__ void init(int M, int N, int G_, int c_) { nM = M / BM; nN = N / BM; nwg = nM * nN; G = G_; c = c_; }
    __device__ bool next(int i, Unit& u) const {
        const long L = (long)i * G + c; if (L >= nwg) return false;
        int wgid = (int)L; { const int q = nwg / NXCD, r = nwg % NXCD, xcd = wgid % NXCD, off = wgid / NXCD; wgid = (xcd < r ? xcd * (q + 1) : r * (q + 1) + (xcd - r) * q) + off; }
        const int nig = WGM * nN, gid = wgid / nig, fm = gid * WGM, gsz = (nM - fm) < WGM ? (nM - fm) : WGM;
        u.pm = fm + ((wgid % nig) % gsz); u.pn = (wgid % nig) / gsz; return true;
    }
};

template <class Epi, class Sched>
__device__ __forceinline__ void gemm_phase(LAS unsigned char* lds, const Gemm g, const Sched& S, const Epi& E) {
    const int tid = threadIdx.x, wid = __builtin_amdgcn_readfirstlane(tid >> 6), lane = tid & 63, wr = wid >> 2, wc = wid & 3, fr = lane & 15, fq = lane >> 4;
    const int K = g.K, nt = K / BK;
    unsigned voffA[2], voffB[2];
#pragma unroll
    for (int i = 0; i < 2; ++i) { int R, C; stage_rc(tid * 16 + i * 8192, R, C); const int Rb = Epi::PERM ? ((R & ~31) + perm32(R & 31)) : R;
        voffA[i] = (unsigned)(R * K + C) * 2u; voffB[i] = (unsigned)(Rb * K + C) * 2u; }
    const size_t kstep = (size_t)(BK * 2);
    const size_t hstep = (size_t)HALF * K * 2;
    const size_t tstep = 2 * hstep;
    const unsigned ldsw = (unsigned)wid * 1024u;
    const int aoff = lds_byte(wr * 64 + fr, fq * 8), boff = lds_byte(wc * 32 + fr, fq * 8);
#define PG8_SA(b, h) (((b) * 2 + (h)) * HTB)
#define PG8_SB(b, h) ((4 + (b) * 2 + (h)) * HTB)
#define PG8_STAGE(bufoff, gbase, voff) do { _Pragma("unroll") for (int _i = 0; _i < 2; ++_i) \
        __builtin_amdgcn_global_load_lds((const unsigned*)((const char*)(gbase) + (voff)[_i]), (LAS unsigned*)(lds + (bufoff) + ldsw + _i * 8192), 16, 0, 0); } while (0)
#define PG8_LDA(dst, b, h) do { _Pragma("unroll") for (int m = 0; m < 4; ++m) _Pragma("unroll") for (int k = 0; k < 2; ++k) dst[m][k] = *(const LAS bf16x8*)(lds + PG8_SA(b, h) + aoff + m * 2048 + k * 1024); } while (0)
#define PG8_LDB(dst, b, h) do { _Pragma("unroll") for (int n = 0; n < 2; ++n) _Pragma("unroll") for (int k = 0; k < 2; ++k) dst[n][k] = *(const LAS bf16x8*)(lds + PG8_SB(b, h) + boff + n * 2048 + k * 1024); } while (0)
#define PG8_MMA(ai, bj, At, Bt) do { __builtin_amdgcn_s_setprio(1); _Pragma("unroll") for (int m = 0; m < 4; ++m) _Pragma("unroll") for (int n = 0; n < 2; ++n) _Pragma("unroll") for (int k = 0; k < 2; ++k) \
        acc[ai][bj][m][n] = __builtin_amdgcn_mfma_f32_16x16x32_bf16(Bt[n][k], At[m][k], acc[ai][bj][m][n], 0, 0, 0); __builtin_amdgcn_s_setprio(0); } while (0)
#define PG8_WAIT_V(n) asm volatile("s_waitcnt vmcnt(" #n ")" ::: "memory")
#define PG8_WAIT_L(n) asm volatile("s_waitcnt lgkmcnt(" #n ")" ::: "memory")
#define PG8_BAR __builtin_amdgcn_s_barrier()
#define PG8_SCHED __builtin_amdgcn_sched_barrier(0)
    Unit cur, nxt; int ui = 0;
    if (!S.next(0, cur)) return;
    f32x4 acc[2][2][4][2];
#pragma unroll
    for (int a = 0; a < 2; ++a)
#pragma unroll
        for (int b = 0; b < 2; ++b)
#pragma unroll
            for (int m = 0; m < 4; ++m)
#pragma unroll
                for (int n = 0; n < 2; ++n) acc[a][b][m][n] = (f32x4){0.f, 0.f, 0.f, 0.f};
    bf16x8 At[4][2], B0[2][2], B1[2][2];
    const char* cA = (const char*)g.A + (size_t)cur.pm * tstep; const char* cB = (const char*)g.Bt + (size_t)cur.pn * tstep;
    PG8_STAGE(PG8_SB(0, 0), cB, voffB); PG8_STAGE(PG8_SA(0, 0), cA, voffA); PG8_STAGE(PG8_SB(0, 1), cB + hstep, voffB); PG8_STAGE(PG8_SA(0, 1), cA + hstep, voffA);
    if (wr == 1) PG8_BAR;
    PG8_WAIT_V(4); PG8_BAR;
    PG8_STAGE(PG8_SB(1, 0), cB + kstep, voffB); PG8_STAGE(PG8_SA(1, 0), cA + kstep, voffA); PG8_STAGE(PG8_SB(1, 1), cB + hstep + kstep, voffB);
    PG8_WAIT_V(6); PG8_BAR;
    for (;;) {
        const bool has_next = S.next(ui + 1, nxt);
        const char* nA = has_next ? (const char*)g.A + (size_t)nxt.pm * tstep : cA; const char* nB = has_next ? (const char*)g.Bt + (size_t)nxt.pn * tstep : cB;
        for (int t = 0; t < nt; t += 2) {
            const bool last = (t == nt - 2);
            const char* a1 = cA + (size_t)(t + 1) * kstep;
            const char* a2 = last ? nA : cA + (size_t)(t + 2) * kstep; const char* b2 = last ? nB : cB + (size_t)(t + 2) * kstep;
            const char* a3 = a2 + kstep; const char* b3 = b2 + kstep;
            PG8_LDB(B0, 0, 0); PG8_SCHED; PG8_LDA(At, 0, 0); PG8_STAGE(PG8_SA(1, 1), a1 + hstep, voffA);
            PG8_WAIT_L(8); PG8_BAR; PG8_WAIT_L(0); PG8_MMA(0, 0, At, B0); PG8_BAR; PG8_SCHED;
            PG8_LDB(B1, 0, 1); PG8_STAGE(PG8_SB(0, 0), b2, voffB);
            PG8_BAR; PG8_WAIT_L(0); PG8_MMA(0, 1, At, B1); PG8_BAR;
            PG8_LDA(At, 0, 1); PG8_STAGE(PG8_SA(0, 0), a2, voffA);
            PG8_BAR; PG8_WAIT_L(0); PG8_MMA(1, 0, At, B0); PG8_BAR; PG8_SCHED;
            PG8_STAGE(PG8_SB(0, 1), b2 + hstep, voffB);
            PG8_WAIT_V(6); PG8_BAR; PG8_MMA(1, 1, At, B1); PG8_BAR;
            PG8_LDB(B0, 1, 0); PG8_SCHED; PG8_LDA(At, 1, 0); PG8_STAGE(PG8_SA(0, 1), a2 + hstep, voffA);
            PG8_WAIT_L(8); PG8_BAR; PG8_WAIT_L(0); PG8_MMA(0, 0, At, B0); PG8_BAR; PG8_SCHED;
            PG8_LDB(B1, 1, 1); PG8_STAGE(PG8_SB(1, 0), b3, voffB);
            PG8_BAR; PG8_WAIT_L(0); PG8_MMA(0, 1, At, B1); PG8_BAR;
            PG8_LDA(At, 1, 1); PG8_STAGE(PG8_SA(1, 0), a3, voffA);
            PG8_BAR; PG8_WAIT_L(0); PG8_MMA(1, 0, At, B0); PG8_BAR; PG8_SCHED;
            PG8_STAGE(PG8_SB(1, 1), b3 + hstep, voffB);
            PG8_WAIT_V(6); PG8_BAR; PG8_MMA(1, 1, At, B1); PG8_BAR;
        }
        if constexpr (Epi::ALIGNED) { if (wr == 0) PG8_BAR; }
        E(acc, cur, wr, wc, fr, fq);
        if (!has_next) break;
#pragma unroll
        for (int a = 0; a < 2; ++a)
#pragma unroll
            for (int b = 0; b < 2; ++b)
#pragma unroll
                for (int m = 0; m < 4; ++m)
#pragma unroll
                    for (int n = 0; n < 2; ++n) acc[a][b][m][n] = (f32x4){0.f, 0.f, 0.f, 0.f};
        cur = nxt; cA = nA; cB = nB; ++ui;
        if constexpr (Epi::ALIGNED) { if (wr == 1) PG8_BAR; }
    }
    PG8_WAIT_V(0);
    if constexpr (!Epi::ALIGNED) { if (wr == 0) PG8_BAR; }
    PG8_BAR;
#undef PG8_SA
#undef PG8_SB
#undef PG8_STAGE
#undef PG8_LDA
#undef PG8_LDB
#undef PG8_MMA
#undef PG8_WAIT_V
#undef PG8_WAIT_L
#undef PG8_BAR
#undef PG8_SCHED
}
}
using pg8::Unit;

struct EpiAda {
    static constexpr bool PERM = false, ALIGNED = false;
    float* mod; const float* b_mix; const float* b_ffn;
    __device__ __forceinline__ void operator()(const f32x4 (&acc)[2][2][4][2], const Unit& u, int wr, int wc, int fr, int fq) const {
#pragma unroll
        for (int ai = 0; ai < 2; ++ai)
#pragma unroll
            for (int m = 0; m < 4; ++m) {
                const int r = u.pm * 256 + ai * 128 + wr * 64 + m * 16 + fr;
#pragma unroll
                for (int bj = 0; bj < 2; ++bj)
#pragma unroll
                    for (int n = 0; n < 2; ++n) {
                        const int c = u.pn * 256 + bj * 128 + wc * 32 + n * 16 + fq * 4;
                        const f32x4 bv = c < 3072 ? *(const f32x4*)(b_mix + c) : *(const f32x4*)(b_ffn + c - 3072);
                        *(f32x4*)(mod + (size_t)r * 6144 + c) = acc[ai][bj][m][n] + bv;
                    }
            }
    }
};

struct EpiIn {
    static constexpr bool PERM = true, ALIGNED = true;
    bf16_t* Z; const float* ropeA; const float* ropeR; float* out;
    __device__ __forceinline__ void operator()(const f32x4 (&acc)[2][2][4][2], const Unit& u, int wr, int wc, int fr, int fq) const {
        int region[2], cbv[2]; const float* tab[2]; int tstride[2], toff[2]; bool rot[2];
#pragma unroll
        for (int bj = 0; bj < 2; ++bj) {
            const int cb128 = u.pn * 256 + bj * 128;
            const int cb = cb128 + wc * 32 + fq * 8; cbv[bj] = cb;
            region[bj] = cb128 < 512 ? 0 : (cb128 < 640 ? 1 : (cb128 < 768 ? 2 : (cb128 < 1280 ? 3 : (cb128 < 1792 ? 4 : 5))));
            if (region[bj] <= 1) { const int p = cb & 63; rot[bj] = p < 16; tab[bj] = ropeA; tstride[bj] = 16; toff[bj] = 4 * (p >> 3); }
            else if (region[bj] == 3 || region[bj] == 4) { rot[bj] = true; tab[bj] = ropeR; tstride[bj] = 128; toff[bj] = 4 * ((cb & 127) >> 3); }
            else { rot[bj] = false; tab[bj] = ropeR; tstride[bj] = 128; toff[bj] = 0; }
        }
        f32x4 csn[2], snn[2];
        auto load_tab = [&](int k) {
            const int r0 = u.pm * 256 + (k >> 2) * 128 + wr * 64 + (k & 3) * 16;
            const int r = r0 + fr, pos = r < TP ? (r & 4095) : 4096;
#pragma unroll
            for (int bj = 0; bj < 2; ++bj) if (rot[bj] && r0 < TV) { const float* t = tab[bj] + pos * tstride[bj] + toff[bj]; csn[bj] = *(const f32x4*)t; snn[bj] = *(const f32x4*)(t + (tstride[bj] >> 1)); }
        };
        load_tab(0);
#pragma unroll
        for (int k = 0; k < 8; ++k) {
            const int ai = k >> 2, m = k & 3;
            const int r0 = u.pm * 256 + ai * 128 + wr * 64 + m * 16;
            const f32x4 cs0 = csn[0], cs1 = csn[1], sn0 = snn[0], sn1 = snn[1];
            if (k < 7) load_tab(k + 1);
            if (r0 >= TV) continue;
            const int r = r0 + fr;
            const int pos = r < TP ? (r & 4095) : 4096;
#pragma unroll
            for (int bj = 0; bj < 2; ++bj) {
                const int cb = cbv[bj];
                f32x4 v0 = acc[ai][bj][m][0], v1 = acc[ai][bj][m][1];
                if (rot[bj]) {
                    const f32x4 cs = bj ? cs1 : cs0, sn = bj ? sn1 : sn0;
                    f32x4 a = v0 * cs - v1 * sn, b = v1 * cs + v0 * sn;
                    if (region[bj] == 4) { a *= RK_SCALE; b *= RK_SCALE; }
                    v0 = a; v1 = b;
                }
                u32x4 pk; pk[0] = cvt_pk_bf16(v0[0], v0[1]); pk[1] = cvt_pk_bf16(v0[2], v0[3]); pk[2] = cvt_pk_bf16(v1[0], v1[1]); pk[3] = cvt_pk_bf16(v1[2], v1[3]);
                *(u32x4*)(Z + (size_t)r * INW + cb) = pk;
                if (region[bj] == 1 || region[bj] == 2) {
                    const int kvh = (cb >> 6) & 1, p = cb & 63;
                    int d0 = p, d1 = p + 4;
                    if (region[bj] == 1 && p < 16) { const int grp = p >> 3; d0 = 4 * grp; d1 = 8 + 4 * grp; }
                    float* dst = nullptr;
                    if (r < TP) { if (pos >= SEQ - 128) dst = out + (region[bj] == 1 ? O_KP : O_VP) + ((size_t)((r >> 12) * 128 + (pos - (SEQ - 128))) * 2 + kvh) * 64; }
                    else dst = out + (region[bj] == 1 ? O_KS : O_VS) + ((size_t)((r - TP) * 128 + 127) * 2 + kvh) * 64;
                    if (dst) { *(f32x4*)(dst + d0) = v0; *(f32x4*)(dst + d1) = v1; }
                }
            }
        }
    }
};

__device__ __forceinline__ void wait_ge(unsigned* pc, unsigned target, unsigned* tmo) {
    unsigned sp = 0;
    while (__hip_atomic_load(pc, __ATOMIC_RELAXED, __HIP_MEMORY_SCOPE_AGENT) < target) {
        __builtin_amdgcn_s_sleep(1);
        if ((++sp & 1023u) == 0u) { if (__hip_atomic_load(tmo, __ATOMIC_RELAXED, __HIP_MEMORY_SCOPE_AGENT) != 0u) break;
                                    if (sp > (1u << 21)) { __hip_atomic_store(tmo, 1u, __ATOMIC_RELAXED, __HIP_MEMORY_SCOPE_AGENT); break; } }
    }
}
template <bool BASE_BF16, bool OUT_BF16>
struct EpiLn {
    static constexpr bool PERM = false, ALIGNED = true;
    const void* base; void* Y; const float* mod; int gate_off; float* stat; unsigned* cnt; const float* lw; const float* lb; bf16_t* H; int h_off; unsigned* tmo;
    __device__ __forceinline__ void operator()(f32x4 (&acc)[2][2][4][2], const Unit& u, int wr, int wc, int fr, int fq) const {
        const float* mrow = mod + (size_t)(128 + (u.pm >> 4)) * 6144 + u.pn * 256;
        const size_t torg = (size_t)u.pm * 256 * DM + u.pn * 256;
        const float* tbf = (const float*)base + torg; const bf16_t* tbh = (const bf16_t*)base + torg; float* tyf = (float*)Y + torg; bf16_t* tyh = (bf16_t*)Y + torg; float* ts = stat + (size_t)u.pm * 512;
        const unsigned lo = (unsigned)((wr * 64 + fr) * DM + wc * 32 + fq * 4), lc = (unsigned)(wc * 32 + fq * 4), lrw = (unsigned)(wr * 64 + fr);
        f32x4 gv[2][2];
#pragma unroll
        for (int bj = 0; bj < 2; ++bj)
#pragma unroll
            for (int n = 0; n < 2; ++n) gv[bj][n] = 1.f + *(const f32x4*)(mrow + gate_off + lc + (bj * 128 + n * 16));
        float sv[8], ssv[8];
        unsigned lod[2] = {lo, lo};
        auto ld_row = [&](int k, f32x4 (&x)[4], unsigned lo) {
            const int ai = k >> 2, m = k & 3;
#pragma unroll
            for (int bj = 0; bj < 2; ++bj)
#pragma unroll
                for (int n = 0; n < 2; ++n) {
                    if constexpr (BASE_BF16) { const u32x2 xb = *(const u32x2*)(tbh + lo + ((ai * 128 + m * 16) * DM + bj * 128 + n * 16)); x[bj * 2 + n] = (f32x4){bflo(xb[0]), bfhi(xb[0]), bflo(xb[1]), bfhi(xb[1])}; }
                    else x[bj * 2 + n] = *(const f32x4*)(tbf + lo + ((ai * 128 + m * 16) * DM + bj * 128 + n * 16));
                }
        };
        f32x4 xn[4];
        ld_row(0, xn, lod[0]);
#pragma unroll
        for (int k = 0; k < 8; ++k) {
            const int ai = k >> 2, m = k & 3;
            f32x4 xc[4] = {xn[0], xn[1], xn[2], xn[3]};
            if (k < 7) ld_row(k + 1, xn, lod[(k + 1) & 1]);
            float s = 0.f, ss = 0.f;
#pragma unroll
            for (int bj = 0; bj < 2; ++bj)
#pragma unroll
                for (int n = 0; n < 2; ++n) {
                    const f32x4 res = ALPHA * xc[bj * 2 + n] + gv[bj][n] * acc[ai][bj][m][n];
                    acc[ai][bj][m][n] = res;
                    s += res[0] + res[1] + res[2] + res[3];
                    ss += res[0] * res[0] + res[1] * res[1] + res[2] * res[2] + res[3] * res[3];
                }
            sv[k] = s; ssv[k] = ss;
            asm volatile("" : "+v"(lod[k & 1]) : "v"(s));
        }
#pragma unroll
        for (int k = 0; k < 8; ++k) {
            float s = sv[k], ss = ssv[k];
            s += __shfl_xor(s, 16); ss += __shfl_xor(ss, 16);
            s += __shfl_xor(s, 32); ss += __shfl_xor(ss, 32);
            if (fq == 0) { float* sp = ts + 2 * (lrw + (k >> 2) * 128 + (k & 3) * 16); __hip_atomic_fetch_add(sp, s, __ATOMIC_RELAXED, __HIP_MEMORY_SCOPE_AGENT); __hip_atomic_fetch_add(sp + 1, ss, __ATOMIC_RELAXED, __HIP_MEMORY_SCOPE_AGENT); }
        }
        asm volatile("s_waitcnt vmcnt(0)" ::: "memory");
        unsigned* pc = cnt + (u.pm * 2 + wr) * 16;
        if (fr + fq == 0) __hip_atomic_fetch_add(pc, 1u, __ATOMIC_RELAXED, __HIP_MEMORY_SCOPE_AGENT);
        wait_ge(pc, 16u, tmo);
        asm volatile("" ::: "memory");
        float sa8[8], sb8[8];
#pragma unroll
        for (int k = 0; k < 8; ++k) { const float* sp = ts + 2 * (lrw + (k >> 2) * 128 + (k & 3) * 16);
            sa8[k] = __hip_atomic_load(sp, __ATOMIC_RELAXED, __HIP_MEMORY_SCOPE_AGENT); sb8[k] = __hip_atomic_load(sp + 1, __ATOMIC_RELAXED, __HIP_MEMORY_SCOPE_AGENT); }
#pragma unroll
        for (int k = 0; k < 8; ++k) { const float mu = sa8[k] * (1.f / 1024.f), var = sb8[k] * (1.f / 1024.f) - mu * mu; sa8[k] = mu; sb8[k] = rsqrtf(fmaxf(var, 0.f) + 1e-5f); }
#pragma unroll
        for (int bj = 0; bj < 2; ++bj)
#pragma unroll
            for (int n = 0; n < 2; ++n) {
                const int co = bj * 128 + n * 16;
                const f32x4 w4 = *(const f32x4*)(lw + u.pn * 256 + lc + co), b4 = *(const f32x4*)(lb + u.pn * 256 + lc + co);
                f32x4 sc4 = w4, sh4 = b4;
                if (H) { sc4 = 1.f + *(const f32x4*)(mrow + h_off + 1024 + lc + co); sh4 = *(const f32x4*)(mrow + h_off + lc + co); }
#pragma unroll
                for (int k = 0; k < 8; ++k) {
                    const int ai = k >> 2, m = k & 3;
                    const f32x4 y = (acc[ai][bj][m][n] - sa8[k]) * sb8[k] * w4 + b4;
                    if constexpr (OUT_BF16) { u32x2 yo; yo[0] = cvt_pk_bf16(y[0], y[1]); yo[1] = cvt_pk_bf16(y[2], y[3]); *(u32x2*)(tyh + lo + ((ai * 128 + m * 16) * DM + co)) = yo; }
                    else *(f32x4*)(tyf + lo + ((ai * 128 + m * 16) * DM + co)) = y;
                    if (H) { const f32x4 hv = y * sc4 + sh4;
                             u32x2 o; o[0] = cvt_pk_bf16(hv[0], hv[1]); o[1] = cvt_pk_bf16(hv[2], hv[3]); *(u32x2*)(H + torg + lo + ((ai * 128 + m * 16) * DM + co)) = o; }
                }
            }
    }
};

struct EpiUp {
    static constexpr bool PERM = true, ALIGNED = true;
    bf16_t* F;
    __device__ __forceinline__ void operator()(const f32x4 (&acc)[2][2][4][2], const Unit& u, int wr, int wc, int fr, int fq) const {
#pragma unroll
        for (int ai = 0; ai < 2; ++ai)
#pragma unroll
            for (int m = 0; m < 4; ++m) {
                const int r0 = u.pm * 256 + ai * 128 + wr * 64 + m * 16;
                if (r0 >= TV) continue;
                const int r = r0 + fr;
                float f[8];
#pragma unroll
                for (int n = 0; n < 2; ++n)
#pragma unroll
                    for (int i = 0; i < 4; ++i) { const float g = acc[ai][0][m][n][i]; f[n * 4 + i] = silu_f(g) * acc[ai][1][m][n][i]; }
                u32x4 pk; pk[0] = cvt_pk_bf16(f[0], f[1]); pk[1] = cvt_pk_bf16(f[2], f[3]); pk[2] = cvt_pk_bf16(f[4], f[5]); pk[3] = cvt_pk_bf16(f[6], f[7]);
                *(u32x4*)(F + (size_t)r * DFF + u.pn * 128 + wc * 32 + fq * 8) = pk;
            }
    }
};

__device__ __forceinline__ void prep_tiles(const Params& p, unsigned char* shm, int tt0, int tt1, int stride) {
    const int tid = threadIdx.x;
    bf16_t* tile = (bf16_t*)shm;
    for (int tt = tt0; tt < tt1; tt += stride) {
        const float* src; bf16_t* dst; int ld, K, mode, t;
        if (tt < 176) { t = tt; src = p.w_in; ld = INW; K = DM; dst = (bf16_t*)(p.ws + WS_WIN); mode = 1; }
        else if (tt < 240) { t = tt - 176; src = p.w_out; ld = DM; K = DM; dst = (bf16_t*)(p.ws + WS_WOUT); mode = 0; }
        else if (tt < 592) { t = tt - 240; src = p.w_up; ld = 2 * DFF; K = DM; dst = (bf16_t*)(p.ws + WS_WUP); mode = 2; }
        else if (tt < 768) { t = tt - 592; src = p.w_down; ld = DM; K = DFF; dst = (bf16_t*)(p.ws + WS_WDOWN); mode = 0; }
        else if (tt < 960) { t = tt - 768; src = p.w_ada_mix; ld = 3072; K = DM; dst = (bf16_t*)(p.ws + WS_WADA); mode = 0; }
        else { t = tt - 960; src = p.w_ada_ffn; ld = 3072; K = DM; dst = (bf16_t*)(p.ws + WS_WADA) + (size_t)3072 * DM; mode = 0; }
        const int nkt = K / 256, rt = t / nkt, kt = t % nkt;
        const int P = rt * 64 + (tid & 63);
        const int L = mode == 1 ? in_col(P) : (mode == 2 ? up_col(P) : P);
        const float* sp = src + (size_t)(kt * 256 + (tid >> 6)) * ld + L;
#pragma unroll
        for (int i = 0; i < 32; ++i) tile[(tid & 63) * 264 + (tid >> 6) + 8 * i] = f2bf(sp[(size_t)(8 * i) * ld]);
        __syncthreads();
        { const int pr = tid >> 3, kc = tid & 7;
#pragma unroll
          for (int j = 0; j < 4; ++j) *(u32x4*)(dst + (size_t)(rt * 64 + pr) * K + kt * 256 + (kc + 8 * j) * 8) = *(const u32x4*)(tile + pr * 264 + (kc + 8 * j) * 8); }
        __syncthreads();
    }
}
__device__ __forceinline__ void prep_misc(const Params& p) {
    const int tid = threadIdx.x;
    const int gt = blockIdx.x * 512 + tid, gs = gridDim.x * 512;
    bf16_t* sc = (bf16_t*)(p.ws + WS_SC);
    for (int i = gt; i < 256 * DM; i += gs) { const int r = i >> 10, k = i & 1023; float v = 0.f; if (r < 128) v = silu_f(p.c_sample[r * DM + k]); else if (r < 136) v = silu_f(p.c_prompt[(r - 128) * DM + k]); sc[i] = f2bf(v); }
    float* st = (float*)(p.ws + WS_STAT1);
    for (int i = gt; i < TPAD * 4; i += gs) st[i] = 0.f;
    for (int i = gt; i < 528 * 16; i += gs) ((unsigned*)(p.ws + WS_CNT))[i] = 0u;
    float* ra = (float*)(p.ws + WS_ROPEA); float* rr = (float*)(p.ws + WS_ROPER);
    for (int i = gt; i < 4097 * 72; i += gs) {
        const int pos = i / 72, f = i % 72;
        const double pv = pos < 4096 ? (double)pos : (double)PAST;
        const double inv = f < 8 ? exp(-13.122363377404328 * (double)f / 8.0) : exp(-9.210340371976184 * (double)(f - 8) / 64.0);
        const double ang = pv * inv;
        const double kk = rint(ang * 0.15915494309189535);
        const float red = (float)(ang - kk * 6.283185307179586);
        const float cs = cosf(red), sn = sinf(red);
        if (f < 8) { ra[pos * 16 + f] = cs; ra[pos * 16 + 8 + f] = sn; } else { rr[pos * 128 + (f - 8)] = cs; rr[pos * 128 + 64 + (f - 8)] = sn; }
    }
}

__device__ __forceinline__ void phase_modulate(const Params& p) {
    const float* mod = (const float*)(p.ws + WS_MOD); bf16_t* H = (bf16_t*)(p.ws + WS_H);
    const int gt = blockIdx.x * 512 + threadIdx.x, gs = gridDim.x * 512;
    constexpr int NCH = TV * 128;
    for (int i0 = gt; i0 < NCH; i0 += 4 * gs) {
        f32x4 x0[4], x1[4];
#pragma unroll
        for (int u = 0; u < 4; ++u) { const int i = i0 + u * gs; if (i < NCH) { const int r = i >> 7, c = (i & 127) * 8;
            const float* xr = r < TP ? p.x_prompt + (size_t)r * DM : p.x_sample + (size_t)(r - TP) * DM;
            x0[u] = __builtin_nontemporal_load((const f32x4*)(xr + c)); x1[u] = __builtin_nontemporal_load((const f32x4*)(xr + c + 4)); } }
#pragma unroll
        for (int u = 0; u < 4; ++u) { const int i = i0 + u * gs; if (i < NCH) { const int r = i >> 7, c = (i & 127) * 8;
            const int mrow = r < TP ? 128 + (r >> 12) : r - TP;
            const float* sh = mod + (size_t)mrow * 6144; const float* scl = sh + 1024;
            const f32x4 h0 = x0[u] * (1.f + *(const f32x4*)(scl + c)) + *(const f32x4*)(sh + c), h1 = x1[u] * (1.f + *(const f32x4*)(scl + c + 4)) + *(const f32x4*)(sh + c + 4);
            u32x4 pk; pk[0] = cvt_pk_bf16(h0[0], h0[1]); pk[1] = cvt_pk_bf16(h0[2], h0[3]); pk[2] = cvt_pk_bf16(h1[0], h1[1]); pk[3] = cvt_pk_bf16(h1[2], h1[3]);
            *(u32x4*)(H + (size_t)r * DM + c) = pk; } }
    }
}

__device__ __forceinline__ void attn_item(const Params& p, unsigned char* shm, int item) {
    const int tid = threadIdx.x, wid = tid >> 6, lane = tid & 63, lr = lane & 15, g = lane >> 4;
    const int b = item >> 6, kvh = (item >> 5) & 1, n = item & 31;
    const bf16_t* Z = (const bf16_t*)(p.ws + WS_Z); bf16_t* MIX = (bf16_t*)(p.ws + WS_MIX);
    bf16_t* Ks = (bf16_t*)shm;
    bf16_t* VT = Ks + 256 * 72;
    {
        const int key = tid >> 1, hf = tid & 1;
        const bool valid = (n > 0) || (key >= 128);
        const size_t row = (size_t)b * SEQ + (size_t)(n - 1) * 128 + key;
        const bf16_t* kp = Z + row * INW + 512 + kvh * 64 + hf * 32; const bf16_t* vp = Z + row * INW + 640 + kvh * 64 + hf * 32;
#pragma unroll
        for (int c = 0; c < 4; ++c) {
            u32x4 kv = (u32x4){0u, 0u, 0u, 0u}, vv = (u32x4){0u, 0u, 0u, 0u};
            if (valid) { kv = *(const u32x4*)(kp + c * 8); vv = *(const u32x4*)(vp + c * 8); }
            *(u32x4*)(Ks + key * 72 + hf * 32 + c * 8) = kv;
#pragma unroll
            for (int e = 0; e < 4; ++e) { const int d = hf * 32 + c * 8 + 2 * e; VT[d * 264 + key] = (bf16_t)(vv[e] & 0xffffu); VT[(d + 1) * 264 + key] = (bf16_t)(vv[e] >> 16); }
        }
    }
    __syncthreads();
    for (int qt = 0; qt < 4; ++qt) {
        const int T = wid * 4 + qt, hq = T >> 3, tq = T & 7, t0 = tq * 16, head = kvh * 4 + hq;
        const size_t qrow = (size_t)b * SEQ + (size_t)n * 128 + t0 + lr;
        bf16x8 Qf[2];
#pragma unroll
        for (int kk = 0; kk < 2; ++kk) Qf[kk] = *(const bf16x8*)(Z + qrow * INW + head * 64 + kk * 32 + g * 8);
        const int kt0 = tq < 6 ? tq : 6;
        f32x4 S[10];
#pragma unroll
        for (int jt = 0; jt < 10; ++jt) {
            S[jt] = (f32x4){0.f, 0.f, 0.f, 0.f};
#pragma unroll
            for (int kk = 0; kk < 2; ++kk) {
                const bf16x8 Kf = *(const bf16x8*)(Ks + (16 * (kt0 + jt) + lr) * 72 + kk * 32 + g * 8);
                S[jt] = __builtin_amdgcn_mfma_f32_16x16x32_bf16(Kf, Qf[kk], S[jt], 0, 0, 0);
            }
        }
        const float sink = p.att_sinks[head];
        const int t = t0 + lr;
        float mx = sink;
#pragma unroll
        for (int jt = 0; jt < 10; ++jt)
#pragma unroll
            for (int r = 0; r < 4; ++r) {
                const int i = 16 * (kt0 + jt) + 4 * g + r, dist = 128 + t - i;
                const bool ok = dist >= 0 && dist <= 128 && (n > 0 || i >= 128);
                const float s = ok ? S[jt][r] * 0.125f : -INFINITY;
                S[jt][r] = s; mx = fmaxf(mx, s);
            }
        mx = fmaxf(mx, __shfl_xor(mx, 16)); mx = fmaxf(mx, __shfl_xor(mx, 32));
        float sum = 0.f;
#pragma unroll
        for (int jt = 0; jt < 10; ++jt)
#pragma unroll
            for (int r = 0; r < 4; ++r) { const float e = __expf(S[jt][r] - mx); S[jt][r] = e; sum += e; }
        sum += __shfl_xor(sum, 16); sum += __shfl_xor(sum, 32);
        const float inv = 1.f / (sum + __expf(sink - mx));
        f32x4 O[4];
#pragma unroll
        for (int dt = 0; dt < 4; ++dt) O[dt] = (f32x4){0.f, 0.f, 0.f, 0.f};
#pragma unroll
        for (int jp = 0; jp < 5; ++jp) {
            u32x4 pu; pu[0] = cvt_pk_bf16(S[2 * jp][0] * inv, S[2 * jp][1] * inv); pu[1] = cvt_pk_bf16(S[2 * jp][2] * inv, S[2 * jp][3] * inv);
            pu[2] = cvt_pk_bf16(S[2 * jp + 1][0] * inv, S[2 * jp + 1][1] * inv); pu[3] = cvt_pk_bf16(S[2 * jp + 1][2] * inv, S[2 * jp + 1][3] * inv);
            const bf16x8 Pf = __builtin_bit_cast(bf16x8, pu);
#pragma unroll
            for (int dt = 0; dt < 4; ++dt) {
                const bf16_t* vr = VT + (16 * dt + lr) * 264 + 16 * (kt0 + 2 * jp) + 4 * g;
                const u32x2 a0 = *(const u32x2*)vr, a1 = *(const u32x2*)(vr + 16);
                u32x4 au; au[0] = a0[0]; au[1] = a0[1]; au[2] = a1[0]; au[3] = a1[1];
                O[dt] = __builtin_amdgcn_mfma_f32_16x16x32_bf16(__builtin_bit_cast(bf16x8, au), Pf, O[dt], 0, 0, 0);
            }
        }
#pragma unroll
        for (int dt = 0; dt < 4; ++dt) {
            u32x2 o; o[0] = cvt_pk_bf16(O[dt][0], O[dt][1]); o[1] = cvt_pk_bf16(O[dt][2], O[dt][3]);
            *(u32x2*)(MIX + qrow * DM + head * 64 + 16 * dt + 4 * g) = o;
        }
    }
    __syncthreads();
}

__device__ __forceinline__ void retu_load(const Params& p, int item, u32x4 (&kvr)[4], u32x4 (&vvr)[4]) {
    const int tid = threadIdx.x, b = item >> 7, h = (item >> 5) & 3, c = item & 31;
    const bf16_t* Z = (const bf16_t*)(p.ws + WS_Z);
    const int j = tid >> 2, q = tid & 3;
    const size_t row = (size_t)b * SEQ + (size_t)c * 128 + j;
    const bf16_t* kp = Z + row * INW + 1280 + h * 128 + q * 32; const bf16_t* vp = Z + row * INW + 1792 + h * 128 + q * 32;
#pragma unroll
    for (int cc = 0; cc < 4; ++cc) { kvr[cc] = *(const u32x4*)(kp + cc * 8); vvr[cc] = *(const u32x4*)(vp + cc * 8); }
}
__device__ __forceinline__ void retu_phase(const Params& p, unsigned char* shm, int first, int stride) {
    u32x4 kvr[4], vvr[4];
    if (first < 1024) retu_load(p, first, kvr, vvr);
    for (int item = first; item < 1024; item += stride) {
    const int tid = threadIdx.x, wid = tid >> 6, lane = tid & 63, lr = lane & 15, g = lane >> 4;
    const int h = (item >> 5) & 3;
    float* UT = (float*)(p.ws + WS_H);
    bf16_t* KT = (bf16_t*)shm;
    bf16_t* VT = KT + 128 * 136;
    const float lg = log_gamma(h);
    {
        const int j = tid >> 2, q = tid & 3;
        const float dec = __expf(lg * (float)(127 - j));
#pragma unroll
        for (int cc = 0; cc < 4; ++cc) {
            const u32x4 kv = kvr[cc], vv = vvr[cc];
#pragma unroll
            for (int e = 0; e < 4; ++e) {
                const int d = q * 32 + cc * 8 + 2 * e;
                KT[d * 136 + j] = f2bf(bflo(kv[e]) * dec); KT[(d + 1) * 136 + j] = f2bf(bfhi(kv[e]) * dec);
                VT[d * 136 + j] = (bf16_t)(vv[e] & 0xffffu); VT[(d + 1) * 136 + j] = (bf16_t)(vv[e] >> 16);
            }
        }
    }
    __syncthreads();
    if (item + stride < 1024) retu_load(p, item + stride, kvr, vvr);
    f32x4 acc[8];
#pragma unroll
    for (int dt = 0; dt < 8; ++dt) acc[dt] = (f32x4){0.f, 0.f, 0.f, 0.f};
#pragma unroll
    for (int kk = 0; kk < 4; ++kk) {
        const bf16x8 Bf = *(const bf16x8*)(VT + (16 * wid + lr) * 136 + kk * 32 + g * 8);
#pragma unroll
        for (int dt = 0; dt < 8; ++dt) {
            const bf16x8 Af = *(const bf16x8*)(KT + (16 * dt + lr) * 136 + kk * 32 + g * 8);
            acc[dt] = __builtin_amdgcn_mfma_f32_16x16x32_bf16(Af, Bf, acc[dt], 0, 0, 0);
        }
    }
    float* up = UT + (size_t)item * 16384 + (size_t)(16 * wid + lr) * 128;
#pragma unroll
    for (int dt = 0; dt < 8; ++dt) *(f32x4*)(up + 16 * dt + 4 * g) = acc[dt];
    __syncthreads();
    }
}

__device__ __forceinline__ void phase_scan(const Params& p) {
    const float* UT = (const float*)(p.ws + WS_H); bf16_t* SST = (bf16_t*)(p.ws + WS_SST);
    const int gt = blockIdx.x * 512 + threadIdx.x, gs = gridDim.x * 512;
    for (int i = gt; i < 32 * 4096; i += gs) {
        const int bh = i >> 12, ed = (i & 4095) * 4, e = ed >> 7, d = ed & 127, h = bh & 3;
        const float gL = __expf(log_gamma(h) * 128.f);
        f32x4 s = (f32x4){0.f, 0.f, 0.f, 0.f};
        const float* up = UT + (size_t)bh * 32 * 16384 + ed; bf16_t* sp = SST + (size_t)bh * 32 * 16384 + ed;
#pragma unroll
        for (int c0 = 0; c0 < 32; c0 += 16) {
            f32x4 uv[16];
#pragma unroll
            for (int c = 0; c < 16; ++c) uv[c] = __builtin_nontemporal_load((const f32x4*)(up + (size_t)(c0 + c) * 16384));
#pragma unroll
            for (int c = 0; c < 16; ++c) { u32x2 o; o[0] = cvt_pk_bf16(s[0], s[1]); o[1] = cvt_pk_bf16(s[2], s[3]); *(u32x2*)(sp + (size_t)(c0 + c) * 16384) = o; s = gL * s + uv[c]; }
        }
#pragma unroll
        for (int k = 0; k < 4; ++k) p.out[O_RP + ((size_t)bh * 128 + ret_dim(d + k)) * 128 + e] = s[k];
    }
}

typedef short s16x4 __attribute__((ext_vector_type(4)));
__device__ __forceinline__ u32x2 lds_tr_read(const bf16_t* addr) {
    const s16x4 r = __builtin_amdgcn_ds_read_tr16_b64_v4i16((LAS s16x4*)(LAS void*)(unsigned)(size_t)addr);
    return __builtin_bit_cast(u32x2, r);
}
__device__ __forceinline__ void reto_load(const Params& p, int item, u32x4 (&kv)[4], u32x4 (&vv)[4], u32x4 (&sv)[4]) {
    const int tid = threadIdx.x, b = item >> 7, h = (item >> 5) & 3, c = item & 31;
    const bf16_t* Z = (const bf16_t*)(p.ws + WS_Z); const bf16_t* SST = (const bf16_t*)(p.ws + WS_SST);
    const size_t row0 = (size_t)b * SEQ + (size_t)c * 128;
    const int j = tid >> 2, q = tid & 3;
    const bf16_t* kp = Z + (row0 + j) * INW + 1280 + h * 128 + q * 32; const bf16_t* vp = Z + (row0 + j) * INW + 1792 + h * 128 + q * 32;
    const bf16_t* sp = SST + (size_t)item * 16384 + j * 128 + q * 32;
#pragma unroll
    for (int cc = 0; cc < 4; ++cc) { kv[cc] = *(const u32x4*)(kp + cc * 8); vv[cc] = *(const u32x4*)(vp + cc * 8); sv[cc] = *(const u32x4*)(sp + cc * 8); }
}
__device__ __forceinline__ void reto_phase(const Params& p, unsigned char* shm, int first, int stride) {
    u32x4 kvr[4], vvr[4], svr[4];
    if (first < 1024) reto_load(p, first, kvr, vvr, svr);
    for (int item = first; item < 1024; item += stride) {
    const int tid = threadIdx.x, wid = tid >> 6, lane = tid & 63, lr = lane & 15, g = lane >> 4;
    const int b = item >> 7, h = (item >> 5) & 3, c = item & 31;
    const bf16_t* Z = (const bf16_t*)(p.ws + WS_Z); bf16_t* MIX = (bf16_t*)(p.ws + WS_MIX);
    bf16_t* Ks = (bf16_t*)shm;
    bf16_t* VT = Ks + 128 * 136;
    bf16_t* Ss = VT + 128 * 136;
    const float lg = log_gamma(h);
    const size_t row0 = (size_t)b * SEQ + (size_t)c * 128;
    {
        const int j = tid >> 2, q = tid & 3;
#pragma unroll
        for (int cc = 0; cc < 4; ++cc) {
            *(u32x4*)(Ks + j * 136 + q * 32 + cc * 8) = kvr[cc];
            *(u32x4*)(Ss + j * 136 + q * 32 + cc * 8) = svr[cc];
            *(u32x4*)(VT + j * 136 + q * 32 + cc * 8) = vvr[cc];
        }
    }
    __syncthreads();
    const size_t qrow = row0 + 16 * wid + lr;
    bf16x8 Qf[4];
#pragma unroll
    for (int kk = 0; kk < 4; ++kk) Qf[kk] = *(const bf16x8*)(Z + qrow * INW + 768 + h * 128 + kk * 32 + g * 8);
    if (item + stride < 1024) reto_load(p, item + stride, kvr, vvr, svr);
    f32x4 S[8];
#pragma unroll
    for (int jt = 0; jt < 8; ++jt) {
        S[jt] = (f32x4){0.f, 0.f, 0.f, 0.f};
        if (jt <= wid) {
#pragma unroll
            for (int kk = 0; kk < 4; ++kk) {
                const bf16x8 Kf = *(const bf16x8*)(Ks + (16 * jt + lr) * 136 + kk * 32 + g * 8);
                S[jt] = __builtin_amdgcn_mfma_f32_16x16x32_bf16(Kf, Qf[kk], S[jt], 0, 0, 0);
            }
        }
    }
    const int it = 16 * wid + lr;
#pragma unroll
    for (int jt = 0; jt < 8; ++jt)
#pragma unroll
        for (int r = 0; r < 4; ++r) { const int j = 16 * jt + 4 * g + r; S[jt][r] = (j <= it) ? S[jt][r] * __expf(lg * (float)(it - j)) : 0.f; }
    f32x4 O1[8], O2[8];
#pragma unroll
    for (int et = 0; et < 8; ++et) { O1[et] = (f32x4){0.f, 0.f, 0.f, 0.f}; O2[et] = (f32x4){0.f, 0.f, 0.f, 0.f}; }
#pragma unroll
    for (int jp = 0; jp < 4; ++jp) {
        if (2 * jp <= wid) {
            u32x4 pu; pu[0] = cvt_pk_bf16(S[2 * jp][0], S[2 * jp][1]); pu[1] = cvt_pk_bf16(S[2 * jp][2], S[2 * jp][3]);
            pu[2] = cvt_pk_bf16(S[2 * jp + 1][0], S[2 * jp + 1][1]); pu[3] = cvt_pk_bf16(S[2 * jp + 1][2], S[2 * jp + 1][3]);
            const bf16x8 Pf = __builtin_bit_cast(bf16x8, pu);
#pragma unroll
            for (int et = 0; et < 8; ++et) {
                const bf16_t* vr = VT + (32 * jp + 4 * g + (lr >> 2)) * 136 + 16 * et + 4 * (lr & 3);
                const u32x2 a0 = lds_tr_read(vr), a1 = lds_tr_read(vr + 16 * 136);
                u32x4 au; au[0] = a0[0]; au[1] = a0[1]; au[2] = a1[0]; au[3] = a1[1];
                O1[et] = __builtin_amdgcn_mfma_f32_16x16x32_bf16(__builtin_bit_cast(bf16x8, au), Pf, O1[et], 0, 0, 0);
            }
        }
    }
#pragma unroll
    for (int kk = 0; kk < 4; ++kk)
#pragma unroll
        for (int et = 0; et < 8; ++et) {
            const bf16x8 Sf = *(const bf16x8*)(Ss + (16 * et + lr) * 136 + kk * 32 + g * 8);
            O2[et] = __builtin_amdgcn_mfma_f32_16x16x32_bf16(Sf, Qf[kk], O2[et], 0, 0, 0);
        }
    const float qd = __expf(lg * (float)(it + 1));
    float sum = 0.f;
#pragma unroll
    for (int et = 0; et < 8; ++et)
#pragma unroll
        for (int r = 0; r < 4; ++r) { const float o = O1[et][r] + qd * O2[et][r]; O1[et][r] = o; sum += o; }
    sum += __shfl_xor(sum, 16); sum += __shfl_xor(sum, 32);
    const float mu = sum * (1.f / 128.f);
    float vs = 0.f;
#pragma unroll
    for (int et = 0; et < 8; ++et)
#pragma unroll
        for (int r = 0; r < 4; ++r) { const float dlt = O1[et][r] - mu; vs += dlt * dlt; }
    vs += __shfl_xor(vs, 16); vs += __shfl_xor(vs, 32);
    const float rstd = rsqrtf(vs * (1.f / 128.f) + 1e-6f);
#pragma unroll
    for (int et = 0; et < 8; ++et) {
        const int e = 16 * et + 4 * g;
        const u32x2 gz = *(const u32x2*)(Z + qrow * INW + 2304 + h * 128 + e);
        const f32x4 gw = *(const f32x4*)(p.ret_gn_w + h * 128 + e);
        const float r0 = (O1[et][0] - mu) * rstd * gw[0] * silu_f(bflo(gz[0])), r1 = (O1[et][1] - mu) * rstd * gw[1] * silu_f(bfhi(gz[0]));
        const float r2 = (O1[et][2] - mu) * rstd * gw[2] * silu_f(bflo(gz[1])), r3 = (O1[et][3] - mu) * rstd * gw[3] * silu_f(bfhi(gz[1]));
        u32x2 o; o[0] = cvt_pk_bf16(r0, r1); o[1] = cvt_pk_bf16(r2, r3);
        *(u32x2*)(MIX + qrow * DM + 512 + h * 128 + e) = o;
    }
    __syncthreads();
    }
}

__device__ __forceinline__ void sample_att(const Params& p, unsigned char* shm, int b) {
    const int tid = threadIdx.x, wid = tid >> 6, lane = tid & 63;
    const bf16_t* zrow = (const bf16_t*)(p.ws + WS_Z) + (size_t)(TP + b) * INW; bf16_t* mixrow = (bf16_t*)(p.ws + WS_MIX) + (size_t)(TP + b) * DM;
    float* sm = (float*)shm;
    float* qn = sm;
    float* kn = qn + 512;
    float* vn = kn + 128;
    float* scs = vn + 128;
    { const int hh = tid >> 6, pp = tid & 63; qn[hh * 64 + att_dim(pp)] = bf2f(zrow[tid]); }
    if (tid < 128) { const int hh = tid >> 6, pp = tid & 63; kn[hh * 64 + att_dim(pp)] = bf2f(zrow[512 + tid]); vn[tid] = bf2f(zrow[640 + tid]); }
    __syncthreads();
    const float* ck = p.cache_k + (size_t)b * 128 * 128; const float* cv = p.cache_v + (size_t)b * 128 * 128;
#pragma unroll
    for (int itr = 0; itr < 2; ++itr) {
        const int idx = tid + 512 * itr, hd = idx >> 7, w = idx & 127, kvh = hd >> 2;
        const float* kr = ck + (w * 2 + kvh) * 64; const float* qr = qn + hd * 64;
        float s = 0.f;
#pragma unroll
        for (int d = 0; d < 64; d += 4) { const f32x4 kv = *(const f32x4*)(kr + d); s += qr[d] * kv[0] + qr[d + 1] * kv[1] + qr[d + 2] * kv[2] + qr[d + 3] * kv[3]; }
        scs[hd * 132 + w] = s * 0.125f;
    }
    if (tid < 8) { const int kvh = tid >> 2; float s = 0.f; for (int d = 0; d < 64; ++d) s += qn[tid * 64 + d] * kn[kvh * 64 + d]; scs[tid * 132 + 128] = s * 0.125f; }
    __syncthreads();
    {
        const float sink = p.att_sinks[wid];
        const float s0 = scs[wid * 132 + lane], s1 = scs[wid * 132 + 64 + lane], s2 = lane == 0 ? scs[wid * 132 + 128] : -INFINITY;
        float mx = fmaxf(fmaxf(s0, s1), fmaxf(s2, sink));
#pragma unroll
        for (int o = 32; o >= 1; o >>= 1) mx = fmaxf(mx, __shfl_xor(mx, o));
        const float e0 = __expf(s0 - mx), e1 = __expf(s1 - mx), e2 = lane == 0 ? __expf(s2 - mx) : 0.f;
        float sum = e0 + e1 + e2;
#pragma unroll
        for (int o = 32; o >= 1; o >>= 1) sum += __shfl_xor(sum, o);
        const float inv = 1.f / (sum + __expf(sink - mx));
        scs[wid * 132 + lane] = e0 * inv; scs[wid * 132 + 64 + lane] = e1 * inv; if (lane == 0) scs[wid * 132 + 128] = e2 * inv;
    }
    __syncthreads();
    {
        const int hd = tid >> 6, d = tid & 63, kvh = hd >> 2;
        float o = scs[hd * 132 + 128] * vn[kvh * 64 + d];
#pragma unroll 16
        for (int w = 0; w < 128; ++w) o += scs[hd * 132 + w] * cv[(w * 2 + kvh) * 64 + d];
        mixrow[hd * 64 + d] = f2bf(o);
    }
    for (int i = tid; i < 127 * 32; i += 512) {
        *(f32x4*)(p.out + O_KS + (size_t)b * 16384 + i * 4) = *(const f32x4*)(ck + 128 + i * 4);
        *(f32x4*)(p.out + O_VS + (size_t)b * 16384 + i * 4) = *(const f32x4*)(cv + 128 + i * 4);
    }
    __syncthreads();
}
__device__ __forceinline__ void sample_ret(const Params& p, unsigned char* shm, int item) {
    const int tid = threadIdx.x, b = item >> 2, h = item & 3;
    const bf16_t* zrow = (const bf16_t*)(p.ws + WS_Z) + (size_t)(TP + b) * INW; bf16_t* mixrow = (bf16_t*)(p.ws + WS_MIX) + (size_t)(TP + b) * DM;
    float* sm = (float*)shm;
    float* rqn = sm;
    float* rkn = rqn + 128;
    float* red = rkn + 128;
    float* qkp = red + 512;
    float* ov = qkp + 4;
    if (tid < 128) { const int dn = ret_dim(tid); rqn[dn] = bf2f(zrow[768 + h * 128 + tid]); rkn[dn] = bf2f(zrow[1280 + h * 128 + tid]); }
    __syncthreads();
    const float gm = __expf(log_gamma(h));
    const int e = tid & 127, dq = tid >> 7;
    const float* sp = p.state_ret + ((size_t)(b * 4 + h) * 128 + dq * 32) * 128 + e;
    float* so = p.out + O_RS + ((size_t)(b * 4 + h) * 128 + dq * 32) * 128 + e;
    const float ve = bf2f(zrow[1792 + h * 128 + e]);
    float sv[32];
#pragma unroll
    for (int d = 0; d < 32; ++d) sv[d] = sp[d * 128];
    float part = 0.f, qk = 0.f;
#pragma unroll
    for (int d = 0; d < 32; ++d) { const float qd = rqn[dq * 32 + d], kd = rkn[dq * 32 + d]; part += qd * sv[d]; qk += qd * kd; so[d * 128] = gm * sv[d] + kd * ve; }
    red[dq * 128 + e] = part; if (e == 0) qkp[dq] = qk;
    __syncthreads();
    if (tid < 128) ov[tid] = (qkp[0] + qkp[1] + qkp[2] + qkp[3]) * ve + gm * (red[e] + red[128 + e] + red[256 + e] + red[384 + e]);
    __syncthreads();
    if (tid < 64) {
        const float o0 = ov[tid], o1 = ov[tid + 64];
        float sum = o0 + o1;
#pragma unroll
        for (int o = 32; o >= 1; o >>= 1) sum += __shfl_xor(sum, o);
        const float mu = sum * (1.f / 128.f);
        float vs = (o0 - mu) * (o0 - mu) + (o1 - mu) * (o1 - mu);
#pragma unroll
        for (int o = 32; o >= 1; o >>= 1) vs += __shfl_xor(vs, o);
        const float rstd = rsqrtf(vs * (1.f / 128.f) + 1e-6f);
#pragma unroll
        for (int k = 0; k < 2; ++k) { const int ee = tid + 64 * k; const float gz = bf2f(zrow[2304 + h * 128 + ee]);
            mixrow[512 + h * 128 + ee] = f2bf(((k ? o1 : o0) - mu) * rstd * p.ret_gn_w[h * 128 + ee] * silu_f(gz)); }
    }
    __syncthreads();
}

template <int NB>
__device__ __forceinline__ void sg_mma(unsigned char* shm, const bf16_t* A, const bf16_t* b0, const bf16_t* b1, int K, f32x4& out0, f32x4& out1) {
    const int tid = threadIdx.x, wid = tid >> 6, lane = tid & 63, lr = lane & 15, g = lane >> 4;
    const int ks = K >> 3;
    const bf16_t* ap = A + (size_t)(TP + lr) * K + 8 * g + wid * ks;
    b0 += wid * ks; if (NB == 2) b1 += wid * ks;
    f32x4 acc[8][NB];
#pragma unroll
    for (int rg = 0; rg < 8; ++rg)
#pragma unroll
        for (int nb = 0; nb < NB; ++nb) acc[rg][nb] = (f32x4){0.f, 0.f, 0.f, 0.f};
    for (int k = 0; k < ks; k += 32) {
        const bf16x8 w0 = *(const bf16x8*)(b0 + k);
        bf16x8 w1 = w0; if (NB == 2) w1 = *(const bf16x8*)(b1 + k);
        bf16x8 a[8];
#pragma unroll
        for (int rg = 0; rg < 8; ++rg) a[rg] = *(const bf16x8*)(ap + (size_t)(16 * rg) * K + k);
#pragma unroll
        for (int rg = 0; rg < 8; ++rg) {
            acc[rg][0] = __builtin_amdgcn_mfma_f32_16x16x32_bf16(w0, a[rg], acc[rg][0], 0, 0, 0);
            if (NB == 2) acc[rg][NB - 1] = __builtin_amdgcn_mfma_f32_16x16x32_bf16(w1, a[rg], acc[rg][NB - 1], 0, 0, 0);
        }
    }
    f32x4* red = (f32x4*)shm;
#pragma unroll
    for (int nb = 0; nb < NB; ++nb) {
        __syncthreads();
#pragma unroll
        for (int rg = 0; rg < 8; ++rg) red[(wid * 8 + rg) * 64 + lane] = acc[rg][nb];
        __syncthreads();
        f32x4 sum = red[(0 * 8 + wid) * 64 + lane];
#pragma unroll
        for (int w = 1; w < 8; ++w) sum += red[(w * 8 + wid) * 64 + lane];
        if (nb == 0) out0 = sum; else out1 = sum;
    }
    __syncthreads();
}
__device__ __forceinline__ void sg_ln(const Params& p, unsigned char* shm, int item, const bf16_t* A, const bf16_t* Bt, int K, const float* base, int gate_off, float* stat, unsigned* cnt,
                                      const float* lw, const float* lb, bf16_t* H, int h_off) {
    const int tid = threadIdx.x, wid = tid >> 6, lane = tid & 63, lr = lane & 15, g = lane >> 4;
    const int n0 = item * 16, m = 16 * wid + lr;
    f32x4 acc = (f32x4){0.f, 0.f, 0.f, 0.f}, dummy = acc;
    sg_mma<1>(shm, A, Bt + (size_t)(n0 + lr) * K + 8 * g, nullptr, K, acc, dummy);
    const int c = n0 + 4 * g;
    const float* mrow = (const float*)(p.ws + WS_MOD) + (size_t)m * 6144;
    const f32x4 xv = *(const f32x4*)(base + (size_t)m * DM + c), gv = *(const f32x4*)(mrow + gate_off + c);
    const f32x4 res = ALPHA * xv + (1.f + gv) * acc;
    float s = res[0] + res[1] + res[2] + res[3], ss = res[0] * res[0] + res[1] * res[1] + res[2] * res[2] + res[3] * res[3];
    s += __shfl_xor(s, 16); ss += __shfl_xor(ss, 16); s += __shfl_xor(s, 32); ss += __shfl_xor(ss, 32);
    if (g == 0) { __hip_atomic_fetch_add(stat + 2 * (TP + m), s, __ATOMIC_RELAXED, __HIP_MEMORY_SCOPE_AGENT); __hip_atomic_fetch_add(stat + 2 * (TP + m) + 1, ss, __ATOMIC_RELAXED, __HIP_MEMORY_SCOPE_AGENT); }
    asm volatile("s_waitcnt vmcnt(0)" ::: "memory");
    unsigned* pc = cnt + wid * 16;
    if (lane == 0) __hip_atomic_fetch_add(pc, 1u, __ATOMIC_RELAXED, __HIP_MEMORY_SCOPE_AGENT);
    wait_ge(pc, 64u, (unsigned*)(p.ws + WS_CNT) + 527 * 16 + 8);
    asm volatile("" ::: "memory");
    const float sa = __hip_atomic_load(stat + 2 * (TP + m), __ATOMIC_RELAXED, __HIP_MEMORY_SCOPE_AGENT), sb = __hip_atomic_load(stat + 2 * (TP + m) + 1, __ATOMIC_RELAXED, __HIP_MEMORY_SCOPE_AGENT);
    const float mu = sa * (1.f / 1024.f), var = sb * (1.f / 1024.f) - mu * mu, rstd = rsqrtf(fmaxf(var, 0.f) + 1e-5f);
    const f32x4 y = (res - mu) * rstd * *(const f32x4*)(lw + c) + *(const f32x4*)(lb + c);
    *(f32x4*)(p.out + O_YS + (size_t)m * DM + c) = y;
    if (H) { const f32x4 hv = y * (1.f + *(const f32x4*)(mrow + h_off + 1024 + c)) + *(const f32x4*)(mrow + h_off + c);
             u32x2 o; o[0] = cvt_pk_bf16(hv[0], hv[1]); o[1] = cvt_pk_bf16(hv[2], hv[3]); *(u32x2*)(H + (size_t)(TP + m) * DM + c) = o; }
}
__device__ __forceinline__ void sg_up(const Params& p, unsigned char* shm, int item) {
    const int tid = threadIdx.x, wid = tid >> 6, lane = tid & 63, lr = lane & 15, g = lane >> 4;
    const int n0 = item * 16, m = 16 * wid + lr, pn = n0 >> 7, off = n0 & 127;
    const bf16_t* A = (const bf16_t*)(p.ws + WS_H); const bf16_t* Bt = (const bf16_t*)(p.ws + WS_WUP);
    f32x4 ag = (f32x4){0.f, 0.f, 0.f, 0.f}, au = ag;
    sg_mma<2>(shm, A, Bt + (size_t)(256 * pn + off + lr) * DM + 8 * g, Bt + (size_t)(256 * pn + 128 + off + lr) * DM + 8 * g, DM, ag, au);
    u32x2 o; o[0] = cvt_pk_bf16(silu_f(ag[0]) * au[0], silu_f(ag[1]) * au[1]); o[1] = cvt_pk_bf16(silu_f(ag[2]) * au[2], silu_f(ag[3]) * au[3]);
    *(u32x2*)((bf16_t*)(p.ws + WS_Z) + (size_t)(TP + m) * DFF + n0 + 4 * g) = o;
}

#define XB_TMO      128
#define XB_XCNT(j)  (256  + 64 * (j))
#define XB_XSUB(j)  (1280 + 64 * (j))
#define XB_XGEN(j)  (2304 + 64 * (j))
#define XB_TOP      3328
#define XB_TOPGEN   3392
#define XCD_BAR_WORDS 3456
#define XB_SPIN_CAP (1u << 18)
__device__ __forceinline__ unsigned xb_ld(unsigned* p)              { return __hip_atomic_load(p, __ATOMIC_RELAXED, __HIP_MEMORY_SCOPE_AGENT); }
__device__ __forceinline__ unsigned xb_add(unsigned* p, unsigned v) { return __hip_atomic_fetch_add(p, v, __ATOMIC_RELAXED, __HIP_MEMORY_SCOPE_AGENT); }
__device__ __forceinline__ unsigned xb_xcc_id() { return (unsigned)__builtin_amdgcn_s_getreg((3 << 11) | 20) & 0xFu; }
#define XB_SPIN(cond, bar) do { unsigned _sp = 0; while (cond) { __builtin_amdgcn_s_sleep(1); \
    if ((++_sp & 255u) == 0u) { if (xb_ld(&(bar)[XB_TMO])) break; if (_sp > XB_SPIN_CAP) { atomicAdd(&(bar)[XB_TMO], 1u); break; } } } } while (0)
struct XcdBarrier { unsigned* bar; unsigned x; volatile LAS unsigned* st; };
__device__ __forceinline__ XcdBarrier xcd_barrier_post(unsigned* bar, volatile LAS unsigned* st) {
    XcdBarrier b; b.bar = bar; b.x = xb_xcc_id(); b.st = st;
    if (threadIdx.x == 0) (void)xb_add(&bar[XB_XCNT(b.x)], 1u);
    return b;
}
__device__ __forceinline__ void xcd_barrier_complete(unsigned* bar, unsigned x, unsigned& nloc, unsigned& nx) {
    const unsigned G = gridDim.x * gridDim.y * gridDim.z;
    unsigned sum, cnt, mine, sp = 0u;
    for (;;) {
        sum = 0u; cnt = 0u; mine = 0u;
#pragma unroll
        for (unsigned j = 0; j < 16; ++j) { const unsigned c = xb_ld(&bar[XB_XCNT(j)]); sum += c; cnt += (c > 0u) ? 1u : 0u; mine = (j == x) ? c : mine; }
        if (sum == G) break;
        __builtin_amdgcn_s_sleep(1);
        if ((++sp & 255u) == 0u) { if (xb_ld(&bar[XB_TMO])) break; if (sp > XB_SPIN_CAP) { atomicAdd(&bar[XB_TMO], 1u); break; } }
    }
    nloc = mine > 0u ? mine : 1u; nx = cnt > 0u ? cnt : 1u;
}
__device__ __forceinline__ void xcd_barrier(const XcdBarrier& b) {
    asm volatile("s_waitcnt vmcnt(0)" ::: "memory");
    __syncthreads();
    if (threadIdx.x == 0) {
        unsigned* bar = b.bar;
        __builtin_amdgcn_s_waitcnt(0);
        unsigned nloc = b.st[0], nx = b.st[1];
        if (nloc == 0u) { xcd_barrier_complete(bar, b.x, nloc, nx); b.st[0] = nloc; b.st[1] = nx; }
        const unsigned old = xb_add(&bar[XB_XSUB(b.x)], 1u);
        const unsigned gen = old / nloc;
        if (old + 1u == (gen + 1u) * nloc) {
            __builtin_amdgcn_fence(__ATOMIC_RELEASE, "agent");
            asm volatile("s_waitcnt vmcnt(0)" ::: "memory");
            const unsigned og = xb_add(&bar[XB_TOP], 1u);
            const unsigned tg = og / nx;
            if (og + 1u == (tg + 1u) * nx) xb_add(&bar[XB_TOPGEN], 1u);
            else XB_SPIN(xb_ld(&bar[XB_TOPGEN]) == tg, bar);
            __builtin_amdgcn_fence(__ATOMIC_ACQUIRE, "agent");
            xb_add(&bar[XB_XGEN(b.x)], 1u);
            asm volatile("s_waitcnt vmcnt(0)" ::: "memory");
        } else {
            XB_SPIN(xb_ld(&bar[XB_XGEN(b.x)]) == gen, bar);
            __builtin_amdgcn_fence(__ATOMIC_ACQUIRE, "agent");
            asm volatile("s_waitcnt vmcnt(0)" ::: "memory");
        }
    }
    __syncthreads();
}

typedef __attribute__((address_space(4))) const unsigned char* kptr_t;
__device__ __forceinline__ Params load_params() {
#if defined(__HIP_DEVICE_COMPILE__)
    kptr_t k = (kptr_t)__builtin_amdgcn_kernarg_segment_ptr();
    asm volatile("" : "+s"(k));
    Params r;
    __builtin_memcpy(&r, (const __attribute__((address_space(4))) void*)k, sizeof(Params));
    return r;
#else
    return Params{};
#endif
}
__global__ void __launch_bounds__(512, 2) fwd(Params p_arg, int ph_lo, int ph_hi, int coop) {
    extern __shared__ __attribute__((aligned(16))) unsigned char shm[];
    cg::grid_group grid = cg::this_grid();
    LAS unsigned char* lds = (LAS unsigned char*)shm;
    const int G = gridDim.x, bid = blockIdx.x;
    volatile LAS unsigned* bst = (volatile LAS unsigned*)(lds + 131072);
    if (threadIdx.x < 4) bst[threadIdx.x] = 0u;
    __syncthreads();
    (void)xcd_barrier_post((unsigned*)(p_arg.ws + WS_BAR), bst);
    if (coop > 1) grid.sync();
#define GSYNC() do { XcdBarrier xb_; xb_.bar = (unsigned*)(load_params().ws + WS_BAR); xb_.x = xb_xcc_id(); xb_.st = (volatile LAS unsigned*)((LAS unsigned char*)shm + 131072); xcd_barrier(xb_); } while (0)
#ifndef ONLY
#define ONLY -1
#endif
#ifndef REP_PH
#define REP_PH -1
#endif
#ifndef REP_SYNC
#define REP_SYNC 0
#endif
#define PH_BEGIN(n) if ((ONLY < 0 || ONLY == n) && ph_lo <= n && n < ph_hi) { if (n > ph_lo && coop) GSYNC(); for (int rep_ = 0; rep_ < (REP_PH == n ? 2 : 1); ++rep_) { if (rep_) GSYNC(); const Params p = load_params();
#define PH_END } }
    for (int i_ = 0; i_ < REP_SYNC; ++i_) GSYNC();
    PH_BEGIN(0) { prep_tiles(p, shm, 768 + bid, 1152, G); prep_misc(p); } PH_END
    PH_BEGIN(1) { if (bid >= 24) prep_tiles(p, shm, bid - 24, 768, G - 24);
                  pg8::Gemm g{(const bf16_t*)(p.ws + WS_SC), (const bf16_t*)(p.ws + WS_WADA), 256, 6144, DM}; pg8::StaticOrder S; S.init(g.M, g.N, G, bid);
                  EpiAda E{(float*)(p.ws + WS_MOD), p.b_ada_mix, p.b_ada_ffn}; pg8::gemm_phase(lds, g, S, E); } PH_END
    PH_BEGIN(2) phase_modulate(p); PH_END
    PH_BEGIN(3) { pg8::Gemm g{(const bf16_t*)(p.ws + WS_H), (const bf16_t*)(p.ws + WS_WIN), TPAD, INW, DM}; pg8::StaticOrder S; S.init(g.M, g.N, G, bid);
                  EpiIn E{(bf16_t*)(p.ws + WS_Z), (const float*)(p.ws + WS_ROPEA), (const float*)(p.ws + WS_ROPER), p.out}; pg8::gemm_phase(lds, g, S, E); } PH_END
    PH_BEGIN(4) { retu_phase(p, shm, bid, G); for (int it = bid; it < 512; it += G) attn_item(p, shm, it); for (int it = G - 1 - bid; it < 512; it += G) sample_ret(p, shm, it); for (int it = bid; it < 128; it += G) sample_att(p, shm, it); } PH_END
    PH_BEGIN(5) phase_scan(p); PH_END
    PH_BEGIN(6) reto_phase(p, shm, bid, G); PH_END
    PH_BEGIN(7) { for (int it = G - 1 - bid; it < 64; it += G) sg_ln(p, shm, it, (const bf16_t*)(p.ws + WS_MIX), (const bf16_t*)(p.ws + WS_WOUT), DM, p.x_sample, 2048, (float*)(p.ws + WS_STAT1),
                                                                       (unsigned*)(p.ws + WS_CNT) + 512 * 16, p.ln1_w, p.ln1_b, (bf16_t*)(p.ws + WS_H), 3072);
                  pg8::Gemm g{(const bf16_t*)(p.ws + WS_MIX), (const bf16_t*)(p.ws + WS_WOUT), TP, DM, DM}; pg8::StaticOrder S; S.init(g.M, g.N, G, bid);
                  EpiLn<false, true> E{p.x_prompt, p.ws + WS_MIX, (const float*)(p.ws + WS_MOD), 2048, (float*)(p.ws + WS_STAT1), (unsigned*)(p.ws + WS_CNT), p.ln1_w, p.ln1_b, (bf16_t*)(p.ws + WS_H), 3072, (unsigned*)(p.ws + WS_CNT) + 527 * 16 + 8};
                  pg8::gemm_phase(lds, g, S, E); } PH_END
    PH_BEGIN(9) { for (int it = G - 1 - bid; it < 176; it += G) sg_up(p, shm, it);
                  pg8::Gemm g{(const bf16_t*)(p.ws + WS_H), (const bf16_t*)(p.ws + WS_WUP), TP, 2 * DFF, DM}; pg8::StaticOrder S; S.init(g.M, g.N, G, bid);
                  EpiUp E{(bf16_t*)(p.ws + WS_Z)}; pg8::gemm_phase(lds, g, S, E); } PH_END
    PH_BEGIN(10) { for (int it = G - 1 - bid; it < 64; it += G) sg_ln(p, shm, it, (const bf16_t*)(p.ws + WS_Z), (const bf16_t*)(p.ws + WS_WDOWN), DFF, p.out + O_YS, 3072 + 2048, (float*)(p.ws + WS_STAT2),
                                                                        (unsigned*)(p.ws + WS_CNT) + 520 * 16, p.ln2_w, p.ln2_b, nullptr, 0);
                   pg8::Gemm g{(const bf16_t*)(p.ws + WS_Z), (const bf16_t*)(p.ws + WS_WDOWN), TP, DM, DFF}; pg8::StaticOrder S; S.init(g.M, g.N, G, bid);
                   EpiLn<true, false> E{p.ws + WS_MIX, p.out, (const float*)(p.ws + WS_MOD), 3072 + 2048, (float*)(p.ws + WS_STAT2), (unsigned*)(p.ws + WS_CNT) + 256 * 16, p.ln2_w, p.ln2_b, nullptr, 0, (unsigned*)(p.ws + WS_CNT) + 527 * 16 + 8};
                   pg8::gemm_phase(lds, g, S, E); } PH_END
}

extern "C" void kernel_launch(void* const* d_in, const int* in_sizes, int n_in, void* d_out, int out_size, void* d_ws, size_t ws_size, hipStream_t stream) {
    constexpr int LDS_BYTES = 131072 + 64;
    static int grid = 0;
    if (!grid) {
        int dev = 0, cus = 0, per_cu = 0;
        (void)hipGetDevice(&dev);
        (void)hipDeviceGetAttribute(&cus, hipDeviceAttributeMultiprocessorCount, dev);
        (void)hipFuncSetAttribute((const void*)fwd, hipFuncAttributeMaxDynamicSharedMemorySize, LDS_BYTES);
        (void)hipOccupancyMaxActiveBlocksPerMultiprocessor(&per_cu, (const void*)fwd, 512, LDS_BYTES);
        grid = cus > 0 ? cus : 256;
        if (ws_size < WS_END) fprintf(stderr, "kernel_launch: workspace too small: %zu < %zu\n", ws_size, (size_t)WS_END);
        fprintf(stderr, "kernel_launch: cus %d per_cu %d grid %d ws %zu need %zu\n", cus, per_cu, grid, ws_size, (size_t)WS_END);
    }
    Params p{};
    const float** f = (const float**)&p;
    for (int i = 0; i < 21; ++i) f[i] = (const float*)d_in[i];
    p.out = (float*)d_out; p.ws = (unsigned char*)d_ws;
#ifndef MULTI_LAUNCH
    (void)hipMemsetAsync((unsigned char*)d_ws + WS_BAR, 0, 16384, stream);
    int lo = 0, hi = 12, coop = 1;
    void* args[] = {&p, &lo, &hi, &coop};
    hipError_t e = hipLaunchCooperativeKernel((const void*)fwd, dim3(grid), dim3(512), args, LDS_BYTES, stream);
    if (e != hipSuccess) fprintf(stderr, "cooperative launch failed: %s (grid %d)\n", hipGetErrorString(e), grid);
#else
    for (int ph = 0; ph < 12; ++ph) hipLaunchKernelGGL(fwd, dim3(grid), dim3(512), LDS_BYTES, stream, p, ph, ph + 1, 0);
#endif
}
```

```cpp
#include <hip/hip_runtime.h>
#include <hip/hip_cooperative_groups.h>
#include <cstdio>
namespace cg = cooperative_groups;

#define LAS __attribute__((address_space(3)))
typedef unsigned short bf16_t;
typedef short bf16x8 __attribute__((ext_vector_type(8)));
typedef float f32x4 __attribute__((ext_vector_type(4)));
typedef unsigned u32x4 __attribute__((ext_vector_type(4)));
typedef unsigned u32x2 __attribute__((ext_vector_type(2)));

constexpr int DM = 1024, SEQ = 4096, NBATCH = 8, TP = NBATCH * SEQ  , NS = 128, TV = TP + NS  , TPAD = TP + 256  ;
constexpr int INW = 2816, DFF = 2816, PAST = 16384;
constexpr float ALPHA = 1.189207115002721f;
constexpr float RK_SCALE = 0.08838834764831845f;
constexpr size_t O_YP = 0, O_YS = (size_t)TP * DM, O_KP = O_YS + (size_t)NS * DM, O_VP = O_KP + 131072, O_RP = O_VP + 131072,
                 O_KS = O_RP + 524288, O_VS = O_KS + 2097152, O_RS = O_VS + 2097152;
constexpr size_t al256(size_t x) { return (x + 255) & ~(size_t)255; }
constexpr size_t WS_WIN = 0;
constexpr size_t WS_WOUT = WS_WIN + (size_t)INW * DM * 2;
constexpr size_t WS_WUP = WS_WOUT + (size_t)DM * DM * 2;
constexpr size_t WS_WDOWN = WS_WUP + (size_t)2 * DFF * DM * 2;
constexpr size_t WS_WADA = WS_WDOWN + (size_t)DM * DFF * 2;
constexpr size_t WS_SC = WS_WADA + (size_t)6144 * DM * 2;
constexpr size_t WS_MOD = WS_SC + (size_t)256 * DM * 2;
constexpr size_t WS_ROPEA = WS_MOD + (size_t)256 * 6144 * 4;
constexpr size_t WS_ROPER = al256(WS_ROPEA + (size_t)4097 * 16 * 4);
constexpr size_t WS_STAT1 = al256(WS_ROPER + (size_t)4097 * 128 * 4);
constexpr size_t WS_STAT2 = WS_STAT1 + (size_t)TPAD * 2 * 4;
constexpr size_t WS_H = al256(WS_STAT2 + (size_t)TPAD * 2 * 4);
constexpr size_t WS_Z = WS_H + (size_t)TPAD * DM * 2;
constexpr size_t WS_MIX = WS_Z + (size_t)TPAD * INW * 2;
constexpr size_t WS_SST = WS_MIX + (size_t)TPAD * DM * 2;
constexpr size_t WS_BAR = WS_SST + (size_t)1024 * 16384 * 2;
constexpr size_t WS_CNT = WS_BAR + 16384;
constexpr size_t WS_END = WS_CNT + 528 * 64;

struct Params {
    const float *x_prompt, *x_sample, *c_prompt, *c_sample, *cache_k, *cache_v, *state_ret, *w_ada_mix, *b_ada_mix, *w_in, *att_sinks, *ret_gn_w, *w_out,
        *ln1_w, *ln1_b, *w_ada_ffn, *b_ada_ffn, *w_up, *w_down, *ln2_w, *ln2_b;
    float* out; unsigned char* ws;
};

__device__ __forceinline__ unsigned cvt_pk_bf16(float lo, float hi) { unsigned r; asm volatile("v_cvt_pk_bf16_f32 %0, %1, %2" : "=v"(r) : "v"(lo), "v"(hi)); return r; }
__device__ __forceinline__ float bf2f(bf16_t b) { return __uint_as_float(((unsigned)b) << 16); }
__device__ __forceinline__ bf16_t f2bf(float f) { return (bf16_t)(cvt_pk_bf16(f, 0.f) & 0xffffu); }
__device__ __forceinline__ float bflo(unsigned u) { return __uint_as_float(u << 16); }
__device__ __forceinline__ float bfhi(unsigned u) { return __uint_as_float(u & 0xffff0000u); }
__device__ __forceinline__ float silu_f(float v) { return v * __builtin_amdgcn_rcpf(1.f + __expf(-v)); }
__device__ __forceinline__ float log_gamma(int h) {
    return h == 0 ? -0.0317486983145803f : (h == 1 ? -0.012479111952334388f : (h == 2 ? -0.004933717393740471f : -0.0019550348358033506f));
}
__device__ __forceinline__ int att_dim(int p) { if (p >= 16) return p; const int g = p >> 3, j = p & 7; return j < 4 ? 4 * g + j : 8 + 4 * g + (j - 4); }
__device__ __forceinline__ int ret_dim(int p) { const int g = p >> 3, j = p & 7; return j < 4 ? 4 * g + j : 64 + 4 * g + (j - 4); }
__device__ __forceinline__ int in_col(int P) {
    if (P < 640) return (P & ~63) + att_dim(P & 63);
    if (P >= 768 && P < 1792) { const int p = (P - 768) & 127; return P - p + ret_dim(p); }
    return P;
}
__device__ __forceinline__ int up_col(int P) { const int pn = P >> 8, q = P & 255; return q < 128 ? pn * 128 + q : DFF + pn * 128 + (q - 128); }

namespace pg8 {
constexpr int BM = 256, BK = 64, HALF = 128, HTB = HALF * BK * 2, STAGE_BYTES = 8 * HTB, NXCD = 8, WGM = 8;
__device__ __forceinline__ int lds_byte(int r, int c) { const int st = (r >> 4) * 2 + (c >> 5), rr = r & 15, cc = c & 31, ob = rr * 64 + cc * 2; return st * 1024 + (ob ^ (((ob >> 9) & 1) << 5)); }
__device__ __forceinline__ void stage_rc(int b, int& R, int& C) { const int st = b / 1024, sb = b % 1024, swz = sb ^ (((sb >> 9) & 1) << 5); R = (st >> 1) * 16 + swz / 64; C = (st & 1) * 32 + (swz % 64) / 2; }
__device__ __forceinline__ int perm32(int rho) { const int n = rho >> 4, i = rho & 15; return 8 * (i >> 2) + 4 * n + (i & 3); }
struct Unit { int pm, pn; };
struct Gemm { const bf16_t* A; const bf16_t* Bt; int M, N, K; };
struct StaticOrder {
    int nM, nN, nwg, G, c, wgm;
    __device__ void init(int M, int N, int G_, int c_, int wgm_ = WGM) { nM = M / BM; nN = N / BM; nwg = nM * nN; G = G_; c = c_; wgm = wgm_; }
    __device__ bool next(int i, Unit& u) const {
        const long L = (long)i * G + c; if (L >= nwg) return false;
        int wgid = (int)L; { const int q = nwg / NXCD, r = nwg % NXCD, xcd = wgid % NXCD, off = wgid / NXCD; wgid = (xcd < r ? xcd * (q + 1) : r * (q + 1) + (xcd - r) * q) + off; }
        const int nig = wgm * nN, gid = wgid / nig, fm = gid * wgm, gsz = (nM - fm) < wgm ? (nM - fm) : wgm;
        u.pm = fm + ((wgid % nig) % gsz); u.pn = (wgid % nig) / gsz; return true;
    }
};

template <class Epi, class Sched>
__device__ __forceinline__ void gemm_phase(LAS unsigned char* lds, const Gemm g, const Sched& S, const Epi& E) {
    const int tid = threadIdx.x, wid = __builtin_amdgcn_readfirstlane(tid >> 6), lane = tid & 63, wr = wid >> 2, wc = wid & 3, fr = lane & 15, fq = lane >> 4;
    const int K = g.K, nt = K / BK;
    unsigned voffA[2], voffB[2];
#pragma unroll
    for (int i = 0; i < 2; ++i) { int R, C; stage_rc(tid * 16 + i * 8192, R, C); const int Rb = Epi::PERM ? ((R & ~31) + perm32(R & 31)) : R;
        voffA[i] = (unsigned)(R * K + C) * 2u; voffB[i] = (unsigned)(Rb * K + C) * 2u; }
    const size_t kstep = (size_t)(BK * 2);
    const size_t hstep = (size_t)HALF * K * 2;
    const size_t tstep = 2 * hstep;
    const unsigned ldsw = (unsigned)wid * 1024u;
    const int aoff = lds_byte(wr * 64 + fr, fq * 8), boff = lds_byte(wc * 32 + fr, fq * 8);
#define PG8_SA(b, h) (((b) * 2 + (h)) * HTB)
#define PG8_SB(b, h) ((4 + (b) * 2 + (h)) * HTB)
#define PG8_STAGE(bufoff, gbase, voff) do { _Pragma("unroll") for (int _i = 0; _i < 2; ++_i) \
        __builtin_amdgcn_global_load_lds((const unsigned*)((const char*)(gbase) + (voff)[_i]), (LAS unsigned*)(lds + (bufoff) + ldsw + _i * 8192), 16, 0, 0); } while (0)
#define PG8_LDA(dst, b, h) do { _Pragma("unroll") for (int m = 0; m < 4; ++m) _Pragma("unroll") for (int k = 0; k < 2; ++k) dst[m][k] = *(const LAS bf16x8*)(lds + PG8_SA(b, h) + aoff + m * 2048 + k * 1024); } while (0)
#define PG8_LDB(dst, b, h) do { _Pragma("unroll") for (int n = 0; n < 2; ++n) _Pragma("unroll") for (int k = 0; k < 2; ++k) dst[n][k] = *(const LAS bf16x8*)(lds + PG8_SB(b, h) + boff + n * 2048 + k * 1024); } while (0)
#define PG8_MMA(ai, bj, At, Bt) do { __builtin_amdgcn_s_setprio(1); _Pragma("unroll") for (int m = 0; m < 4; ++m) _Pragma("unroll") for (int n = 0; n < 2; ++n) _Pragma("unroll") for (int k = 0; k < 2; ++k) \
        acc[ai][bj][m][n] = __builtin_amdgcn_mfma_f32_16x16x32_bf16(Bt[n][k], At[m][k], acc[ai][bj][m][n], 0, 0, 0); __builtin_amdgcn_s_setprio(0); } while (0)
#define PG8_WAIT_V(n) asm volatile("s_waitcnt vmcnt(" #n ")" ::: "memory")
#define PG8_WAIT_L(n) asm volatile("s_waitcnt lgkmcnt(" #n ")" ::: "memory")
#define PG8_BAR __builtin_amdgcn_s_barrier()
#define PG8_SCHED __builtin_amdgcn_sched_barrier(0)
    Unit cur, nxt; int ui = 0;
    if (!S.next(0, cur)) return;
    f32x4 acc[2][2][4][2];
#pragma unroll
    for (int a = 0; a < 2; ++a)
#pragma unroll
        for (int b = 0; b < 2; ++b)
#pragma unroll
            for (int m = 0; m < 4; ++m)
#pragma unroll
                for (int n = 0; n < 2; ++n) acc[a][b][m][n] = (f32x4){0.f, 0.f, 0.f, 0.f};
    bf16x8 At[4][2], B0[2][2], B1[2][2];
    const char* cA = (const char*)g.A + (size_t)cur.pm * tstep; const char* cB = (const char*)g.Bt + (size_t)cur.pn * tstep;
    PG8_STAGE(PG8_SB(0, 0), cB, voffB); PG8_STAGE(PG8_SA(0, 0), cA, voffA); PG8_STAGE(PG8_SB(0, 1), cB + hstep, voffB); PG8_STAGE(PG8_SA(0, 1), cA + hstep, voffA);
    if (wr == 1) PG8_BAR;
    PG8_WAIT_V(4); PG8_BAR;
    PG8_STAGE(PG8_SB(1, 0), cB + kstep, voffB); PG8_STAGE(PG8_SA(1, 0), cA + kstep, voffA); PG8_STAGE(PG8_SB(1, 1), cB + hstep + kstep, voffB);
    PG8_WAIT_V(6); PG8_BAR;
    for (;;) {
        const bool has_next = S.next(ui + 1, nxt);
        const char* nA = has_next ? (const char*)g.A + (size_t)nxt.pm * tstep : cA; const char* nB = has_next ? (const char*)g.Bt + (size_t)nxt.pn * tstep : cB;
        for (int t = 0; t < nt; t += 2) {
            const bool last = (t == nt - 2);
            const char* a1 = cA + (size_t)(t + 1) * kstep;
            const char* a2 = last ? nA : cA + (size_t)(t + 2) * kstep; const char* b2 = last ? nB : cB + (size_t)(t + 2) * kstep;
            const char* a3 = a2 + kstep; const char* b3 = b2 + kstep;
            PG8_LDB(B0, 0, 0); PG8_SCHED; PG8_LDA(At, 0, 0); PG8_STAGE(PG8_SA(1, 1), a1 + hstep, voffA);
            PG8_WAIT_L(8); PG8_BAR; PG8_WAIT_L(0); PG8_MMA(0, 0, At, B0); PG8_BAR; PG8_SCHED;
            PG8_LDB(B1, 0, 1); PG8_STAGE(PG8_SB(0, 0), b2, voffB);
            PG8_BAR; PG8_WAIT_L(0); PG8_MMA(0, 1, At, B1); PG8_BAR;
            PG8_LDA(At, 0, 1); PG8_STAGE(PG8_SA(0, 0), a2, voffA);
            PG8_BAR; PG8_WAIT_L(0); PG8_MMA(1, 0, At, B0); PG8_BAR; PG8_SCHED;
            PG8_STAGE(PG8_SB(0, 1), b2 + hstep, voffB);
            PG8_WAIT_V(6); PG8_BAR; PG8_MMA(1, 1, At, B1); PG8_BAR;
            PG8_LDB(B0, 1, 0); PG8_SCHED; PG8_LDA(At, 1, 0); PG8_STAGE(PG8_SA(0, 1), a2 + hstep, voffA);
            PG8_WAIT_L(8); PG8_BAR; PG8_WAIT_L(0); PG8_MMA(0, 0, At, B0); PG8_BAR; PG8_SCHED;
            PG8_LDB(B1, 1, 1); PG8_STAGE(PG8_SB(1, 0), b3, voffB);
            PG8_BAR; PG8_WAIT_L(0); PG8_MMA(0, 1, At, B1); PG8_BAR;
            PG8_LDA(At, 1, 1); PG8_STAGE(PG8_SA(1, 0), a3, voffA);
            PG8_BAR; PG8_WAIT_L(0); PG8_MMA(1, 0, At, B0); PG8_BAR; PG8_SCHED;
            PG8_STAGE(PG8_SB(1, 1), b3 + hstep, voffB);
            PG8_WAIT_V(6); PG8_BAR; PG8_MMA(1, 1, At, B1); PG8_BAR;
        }
        if constexpr (Epi::ALIGNED) { if (wr == 0) PG8_BAR; }
        E(acc, cur, wr, wc, fr, fq);
        if (!has_next) break;
#pragma unroll
        for (int a = 0; a < 2; ++a)
#pragma unroll
            for (int b = 0; b < 2; ++b)
#pragma unroll
                for (int m = 0; m < 4; ++m)
#pragma unroll
                    for (int n = 0; n < 2; ++n) acc[a][b][m][n] = (f32x4){0.f, 0.f, 0.f, 0.f};
        cur = nxt; cA = nA; cB = nB; ++ui;
        if constexpr (Epi::ALIGNED) { if (wr == 1) PG8_BAR; }
    }
    PG8_WAIT_V(0);
    if constexpr (!Epi::ALIGNED) { if (wr == 0) PG8_BAR; }
    PG8_BAR;
#undef PG8_SA
#undef PG8_SB
#undef PG8_STAGE
#undef PG8_LDA
#undef PG8_LDB
#undef PG8_MMA
#undef PG8_WAIT_V
#undef PG8_WAIT_L
#undef PG8_BAR
#undef PG8_SCHED
}
}
using pg8::Unit;

struct EpiAda {
    static constexpr bool PERM = false, ALIGNED = false;
    float* mod; const float* b_mix; const float* b_ffn;
    __device__ __forceinline__ void operator()(const f32x4 (&acc)[2][2][4][2], const Unit& u, int wr, int wc, int fr, int fq) const {
#pragma unroll
        for (int ai = 0; ai < 2; ++ai)
#pragma unroll
            for (int m = 0; m < 4; ++m) {
                const int r = u.pm * 256 + ai * 128 + wr * 64 + m * 16 + fr;
#pragma unroll
                for (int bj = 0; bj < 2; ++bj)
#pragma unroll
                    for (int n = 0; n < 2; ++n) {
                        const int c = u.pn * 256 + bj * 128 + wc * 32 + n * 16 + fq * 4;
                        const f32x4 bv = c < 3072 ? *(const f32x4*)(b_mix + c) : *(const f32x4*)(b_ffn + c - 3072);
                        *(f32x4*)(mod + (size_t)r * 6144 + c) = acc[ai][bj][m][n] + bv;
                    }
            }
    }
};

struct EpiIn {
    static constexpr bool PERM = true, ALIGNED = true;
    bf16_t* Z; const float* ropeA; const float* ropeR; float* out;
    __device__ __forceinline__ void operator()(const f32x4 (&acc)[2][2][4][2], const Unit& u, int wr, int wc, int fr, int fq) const {
        int region[2], cbv[2]; const float* tab[2]; int tstride[2], toff[2]; bool rot[2];
#pragma unroll
        for (int bj = 0; bj < 2; ++bj) {
            const int cb128 = u.pn * 256 + bj * 128;
            const int cb = cb128 + wc * 32 + fq * 8; cbv[bj] = cb;
            region[bj] = cb128 < 512 ? 0 : (cb128 < 640 ? 1 : (cb128 < 768 ? 2 : (cb128 < 1280 ? 3 : (cb128 < 1792 ? 4 : 5))));
            if (region[bj] <= 1) { const int p = cb & 63; rot[bj] = p < 16; tab[bj] = ropeA; tstride[bj] = 16; toff[bj] = 4 * (p >> 3); }
            else if (region[bj] == 3 || region[bj] == 4) { rot[bj] = true; tab[bj] = ropeR; tstride[bj] = 128; toff[bj] = 4 * ((cb & 127) >> 3); }
            else { rot[bj] = false; tab[bj] = ropeR; tstride[bj] = 128; toff[bj] = 0; }
        }
        f32x4 csn[2], snn[2];
        auto load_tab = [&](int k) {
            const int r0 = u.pm * 256 + (k >> 2) * 128 + wr * 64 + (k & 3) * 16;
            const int r = r0 + fr, pos = r < TP ? (r & 4095) : 4096;
#pragma unroll
            for (int bj = 0; bj < 2; ++bj) if (rot[bj] && r0 < TV) { const float* t = tab[bj] + pos * tstride[bj] + toff[bj]; csn[bj] = *(const f32x4*)t; snn[bj] = *(const f32x4*)(t + (tstride[bj] >> 1)); }
        };
        load_tab(0);
#pragma unroll
        for (int k = 0; k < 8; ++k) {
            const int ai = k >> 2, m = k & 3;
            const int r0 = u.pm * 256 + ai * 128 + wr * 64 + m * 16;
            const f32x4 cs0 = csn[0], cs1 = csn[1], sn0 = snn[0], sn1 = snn[1];
            if (k < 7) load_tab(k + 1);
            if (r0 >= TV) continue;
            const int r = r0 + fr;
            const int pos = r < TP ? (r & 4095) : 4096;
#pragma unroll
            for (int bj = 0; bj < 2; ++bj) {
                const int cb = cbv[bj];
                f32x4 v0 = acc[ai][bj][m][0], v1 = acc[ai][bj][m][1];
                if (rot[bj]) {
                    const f32x4 cs = bj ? cs1 : cs0, sn = bj ? sn1 : sn0;
                    f32x4 a = v0 * cs - v1 * sn, b = v1 * cs + v0 * sn;
                    if (region[bj] == 4) { a *= RK_SCALE; b *= RK_SCALE; }
                    v0 = a; v1 = b;
                }
                u32x4 pk; pk[0] = cvt_pk_bf16(v0[0], v0[1]); pk[1] = cvt_pk_bf16(v0[2], v0[3]); pk[2] = cvt_pk_bf16(v1[0], v1[1]); pk[3] = cvt_pk_bf16(v1[2], v1[3]);
                *(u32x4*)(Z + (size_t)r * INW + cb) = pk;
                if (region[bj] == 1 || region[bj] == 2) {
                    const int kvh = (cb >> 6) & 1, p = cb & 63;
                    int d0 = p, d1 = p + 4;
                    if (region[bj] == 1 && p < 16) { const int grp = p >> 3; d0 = 4 * grp; d1 = 8 + 4 * grp; }
                    float* dst = nullptr;
                    if (r < TP) { if (pos >= SEQ - 128) dst = out + (region[bj] == 1 ? O_KP : O_VP) + ((size_t)((r >> 12) * 128 + (pos - (SEQ - 128))) * 2 + kvh) * 64; }
                    else dst = out + (region[bj] == 1 ? O_KS : O_VS) + ((size_t)((r - TP) * 128 + 127) * 2 + kvh) * 64;
                    if (dst) { *(f32x4*)(dst + d0) = v0; *(f32x4*)(dst + d1) = v1; }
                }
            }
        }
    }
};

__device__ __forceinline__ void wait_ge(unsigned* pc, unsigned target, unsigned* tmo) {
    unsigned sp = 0;
    while (__hip_atomic_load(pc, __ATOMIC_RELAXED, __HIP_MEMORY_SCOPE_AGENT) < target) {
        __builtin_amdgcn_s_sleep(1);
        if ((++sp & 1023u) == 0u) { if (__hip_atomic_load(tmo, __ATOMIC_RELAXED, __HIP_MEMORY_SCOPE_AGENT) != 0u) break;
                                    if (sp > (1u << 21)) { __hip_atomic_store(tmo, 1u, __ATOMIC_RELAXED, __HIP_MEMORY_SCOPE_AGENT); break; } }
    }
}
template <bool BASE_BF16, bool OUT_BF16>
struct EpiLn {
    static constexpr bool PERM = false, ALIGNED = true;
    const void* base; void* Y; const float* mod; int gate_off; float* stat; unsigned* cnt; const float* lw; const float* lb; bf16_t* H; int h_off; unsigned* tmo;
    __device__ __forceinline__ void operator()(f32x4 (&acc)[2][2][4][2], const Unit& u, int wr, int wc, int fr, int fq) const {
        const float* mrow = mod + (size_t)(128 + (u.pm >> 4)) * 6144 + u.pn * 256;
        const size_t torg = (size_t)u.pm * 256 * DM + u.pn * 256;
        const float* tbf = (const float*)base + torg; const bf16_t* tbh = (const bf16_t*)base + torg; float* tyf = (float*)Y + torg; bf16_t* tyh = (bf16_t*)Y + torg; float* ts = stat + (size_t)u.pm * 512;
        const unsigned lo = (unsigned)((wr * 64 + fr) * DM + wc * 32 + fq * 4), lc = (unsigned)(wc * 32 + fq * 4), lrw = (unsigned)(wr * 64 + fr);
        f32x4 gv[2][2];
#pragma unroll
        for (int bj = 0; bj < 2; ++bj)
#pragma unroll
            for (int n = 0; n < 2; ++n) gv[bj][n] = 1.f + *(const f32x4*)(mrow + gate_off + lc + (bj * 128 + n * 16));
        float sv[8], ssv[8];
        unsigned lod[2] = {lo, lo};
        auto ld_row = [&](int k, f32x4 (&x)[4], unsigned lo) {
            const int ai = k >> 2, m = k & 3;
#pragma unroll
            for (int bj = 0; bj < 2; ++bj)
#pragma unroll
                for (int n = 0; n < 2; ++n) {
                    if constexpr (BASE_BF16) { const u32x2 xb = *(const u32x2*)(tbh + lo + ((ai * 128 + m * 16) * DM + bj * 128 + n * 16)); x[bj * 2 + n] = (f32x4){bflo(xb[0]), bfhi(xb[0]), bflo(xb[1]), bfhi(xb[1])}; }
                    else x[bj * 2 + n] = *(const f32x4*)(tbf + lo + ((ai * 128 + m * 16) * DM + bj * 128 + n * 16));
                }
        };
        f32x4 xn[4];
        ld_row(0, xn, lod[0]);
#pragma unroll
        for (int k = 0; k < 8; ++k) {
            const int ai = k >> 2, m = k & 3;
            f32x4 xc[4] = {xn[0], xn[1], xn[2], xn[3]};
            if (k < 7) ld_row(k + 1, xn, lod[(k + 1) & 1]);
            float s = 0.f, ss = 0.f;
#pragma unroll
            for (int bj = 0; bj < 2; ++bj)
#pragma unroll
                for (int n = 0; n < 2; ++n) {
                    const f32x4 res = ALPHA * xc[bj * 2 + n] + gv[bj][n] * acc[ai][bj][m][n];
                    acc[ai][bj][m][n] = res;
                    s += res[0] + res[1] + res[2] + res[3];
                    ss += res[0] * res[0] + res[1] * res[1] + res[2] * res[2] + res[3] * res[3];
                }
            sv[k] = s; ssv[k] = ss;
            asm volatile("" : "+v"(lod[k & 1]) : "v"(s));
        }
#pragma unroll
        for (int k = 0; k < 8; ++k) {
            float s = sv[k], ss = ssv[k];
            s += __shfl_xor(s, 16); ss += __shfl_xor(ss, 16);
            s += __shfl_xor(s, 32); ss += __shfl_xor(ss, 32);
            if (fq == 0) { float* sp = ts + 2 * (lrw + (k >> 2) * 128 + (k & 3) * 16); __hip_atomic_fetch_add(sp, s, __ATOMIC_RELAXED, __HIP_MEMORY_SCOPE_AGENT); __hip_atomic_fetch_add(sp + 1, ss, __ATOMIC_RELAXED, __HIP_MEMORY_SCOPE_AGENT); }
        }
        asm volatile("s_waitcnt vmcnt(0)" ::: "memory");
        unsigned* pc = cnt + (u.pm * 2 + wr) * 16;
        if (fr + fq == 0) __hip_atomic_fetch_add(pc, 1u, __ATOMIC_RELAXED, __HIP_MEMORY_SCOPE_AGENT);
        wait_ge(pc, 16u, tmo);
        asm volatile("" ::: "memory");
        float sa8[8], sb8[8];
#pragma unroll
        for (int k = 0; k < 8; ++k) { const float* sp = ts + 2 * (lrw + (k >> 2) * 128 + (k & 3) * 16);
            sa8[k] = __hip_atomic_load(sp, __ATOMIC_RELAXED, __HIP_MEMORY_SCOPE_AGENT); sb8[k] = __hip_atomic_load(sp + 1, __ATOMIC_RELAXED, __HIP_MEMORY_SCOPE_AGENT); }
#pragma unroll
        for (int k = 0; k < 8; ++k) { const float mu = sa8[k] * (1.f / 1024.f), var = sb8[k] * (1.f / 1024.f) - mu * mu; sa8[k] = mu; sb8[k] = rsqrtf(fmaxf(var, 0.f) + 1e-5f); }
#pragma unroll
        for (int bj = 0; bj < 2; ++bj)
#pragma unroll
            for (int n = 0; n < 2; ++n) {
                const int co = bj * 128 + n * 16;
                const f32x4 w4 = *(const f32x4*)(lw + u.pn * 256 + lc + co), b4 = *(const f32x4*)(lb + u.pn * 256 + lc + co);
                f32x4 sc4 = w4, sh4 = b4;
                if (H) { sc4 = 1.f + *(const f32x4*)(mrow + h_off + 1024 + lc + co); sh4 = *(const f32x4*)(mrow + h_off + lc + co); }
#pragma unroll
                for (int k = 0; k < 8; ++k) {
                    const int ai = k >> 2, m = k & 3;
                    const f32x4 y = (acc[ai][bj][m][n] - sa8[k]) * sb8[k] * w4 + b4;
                    if constexpr (OUT_BF16) { u32x2 yo; yo[0] = cvt_pk_bf16(y[0], y[1]); yo[1] = cvt_pk_bf16(y[2], y[3]); *(u32x2*)(tyh + lo + ((ai * 128 + m * 16) * DM + co)) = yo; }
                    else *(f32x4*)(tyf + lo + ((ai * 128 + m * 16) * DM + co)) = y;
                    if (H) { const f32x4 hv = y * sc4 + sh4;
                             u32x2 o; o[0] = cvt_pk_bf16(hv[0], hv[1]); o[1] = cvt_pk_bf16(hv[2], hv[3]); *(u32x2*)(H + torg + lo + ((ai * 128 + m * 16) * DM + co)) = o; }
                }
            }
    }
};

struct EpiUp {
    static constexpr bool PERM = true, ALIGNED = true;
    bf16_t* F;
    __device__ __forceinline__ void operator()(const f32x4 (&acc)[2][2][4][2], const Unit& u, int wr, int wc, int fr, int fq) const {
#pragma unroll
        for (int ai = 0; ai < 2; ++ai)
#pragma unroll
            for (int m = 0; m < 4; ++m) {
                const int r0 = u.pm * 256 + ai * 128 + wr * 64 + m * 16;
                if (r0 >= TV) continue;
                const int r = r0 + fr;
                float f[8];
#pragma unroll
                for (int n = 0; n < 2; ++n)
#pragma unroll
                    for (int i = 0; i < 4; ++i) { const float g = acc[ai][0][m][n][i]; f[n * 4 + i] = silu_f(g) * acc[ai][1][m][n][i]; }
                u32x4 pk; pk[0] = cvt_pk_bf16(f[0], f[1]); pk[1] = cvt_pk_bf16(f[2], f[3]); pk[2] = cvt_pk_bf16(f[4], f[5]); pk[3] = cvt_pk_bf16(f[6], f[7]);
                *(u32x4*)(F + (size_t)r * DFF + u.pn * 128 + wc * 32 + fq * 8) = pk;
            }
    }
};

__device__ __forceinline__ void prep_tiles(const Params& p, unsigned char* shm, int tt0, int tt1, int stride) {
    const int tid = threadIdx.x;
    bf16_t* tile = (bf16_t*)shm;
    for (int tt = tt0; tt < tt1; tt += stride) {
        const float* src; bf16_t* dst; int ld, K, mode, t;
        if (tt < 176) { t = tt; src = p.w_in; ld = INW; K = DM; dst = (bf16_t*)(p.ws + WS_WIN); mode = 1; }
        else if (tt < 240) { t = tt - 176; src = p.w_out; ld = DM; K = DM; dst = (bf16_t*)(p.ws + WS_WOUT); mode = 0; }
        else if (tt < 592) { t = tt - 240; src = p.w_up; ld = 2 * DFF; K = DM; dst = (bf16_t*)(p.ws + WS_WUP); mode = 2; }
        else if (tt < 768) { t = tt - 592; src = p.w_down; ld = DM; K = DFF; dst = (bf16_t*)(p.ws + WS_WDOWN); mode = 0; }
        else if (tt < 960) { t = tt - 768; src = p.w_ada_mix; ld = 3072; K = DM; dst = (bf16_t*)(p.ws + WS_WADA); mode = 0; }
        else { t = tt - 960; src = p.w_ada_ffn; ld = 3072; K = DM; dst = (bf16_t*)(p.ws + WS_WADA) + (size_t)3072 * DM; mode = 0; }
        const int nkt = K / 256, rt = t / nkt, kt = t % nkt;
        const int P = rt * 64 + (tid & 63);
        const int L = mode == 1 ? in_col(P) : (mode == 2 ? up_col(P) : P);
        const float* sp = src + (size_t)(kt * 256 + (tid >> 6)) * ld + L;
#pragma unroll
        for (int i = 0; i < 32; ++i) tile[(tid & 63) * 264 + (tid >> 6) + 8 * i] = f2bf(sp[(size_t)(8 * i) * ld]);
        __syncthreads();
        { const int pr = tid >> 3, kc = tid & 7;
#pragma unroll
          for (int j = 0; j < 4; ++j) *(u32x4*)(dst + (size_t)(rt * 64 + pr) * K + kt * 256 + (kc + 8 * j) * 8) = *(const u32x4*)(tile + pr * 264 + (kc + 8 * j) * 8); }
        __syncthreads();
    }
}
__device__ __forceinline__ void prep_misc(const Params& p) {
    const int tid = threadIdx.x;
    const int gt = blockIdx.x * 512 + tid, gs = gridDim.x * 512;
    bf16_t* sc = (bf16_t*)(p.ws + WS_SC);
    for (int i = gt; i < 256 * DM; i += gs) { const int r = i >> 10, k = i & 1023; float v = 0.f; if (r < 128) v = silu_f(p.c_sample[r * DM + k]); else if (r < 136) v = silu_f(p.c_prompt[(r - 128) * DM + k]); sc[i] = f2bf(v); }
    float* st = (float*)(p.ws + WS_STAT1);
    for (int i = gt; i < TPAD * 4; i += gs) st[i] = 0.f;
    for (int i = gt; i < 528 * 16; i += gs) ((unsigned*)(p.ws + WS_CNT))[i] = 0u;
    float* ra = (float*)(p.ws + WS_ROPEA); float* rr = (float*)(p.ws + WS_ROPER);
    for (int i = gt; i < 4097 * 72; i += gs) {
        const int pos = i / 72, f = i % 72;
        const double pv = pos < 4096 ? (double)pos : (double)PAST;
        const double inv = f < 8 ? exp(-13.122363377404328 * (double)f / 8.0) : exp(-9.210340371976184 * (double)(f - 8) / 64.0);
        const double ang = pv * inv;
        const double kk = rint(ang * 0.15915494309189535);
        const float red = (float)(ang - kk * 6.283185307179586);
        const float cs = cosf(red), sn = sinf(red);
        if (f < 8) { ra[pos * 16 + f] = cs; ra[pos * 16 + 8 + f] = sn; } else { rr[pos * 128 + (f - 8)] = cs; rr[pos * 128 + 64 + (f - 8)] = sn; }
    }
}

__device__ __forceinline__ void phase_modulate(const Params& p) {
    const float* mod = (const float*)(p.ws + WS_MOD); bf16_t* H = (bf16_t*)(p.ws + WS_H);
    const int gt = blockIdx.x * 512 + threadIdx.x, gs = gridDim.x * 512;
    constexpr int NCH = TV * 128;
    for (int i0 = gt; i0 < NCH; i0 += 4 * gs) {
        f32x4 x0[4], x1[4];
#pragma unroll
        for (int u = 0; u < 4; ++u) { const int i = i0 + u * gs; if (i < NCH) { const int r = i >> 7, c = (i & 127) * 8;
            const float* xr = r < TP ? p.x_prompt + (size_t)r * DM : p.x_sample + (size_t)(r - TP) * DM;
            x0[u] = __builtin_nontemporal_load((const f32x4*)(xr + c)); x1[u] = __builtin_nontemporal_load((const f32x4*)(xr + c + 4)); } }
#pragma unroll
        for (int u = 0; u < 4; ++u) { const int i = i0 + u * gs; if (i < NCH) { const int r = i >> 7, c = (i & 127) * 8;
            const int mrow = r < TP ? 128 + (r >> 12) : r - TP;
            const float* sh = mod + (size_t)mrow * 6144; const float* scl = sh + 1024;
            const f32x4 h0 = x0[u] * (1.f + *(const f32x4*)(scl + c)) + *(const f32x4*)(sh + c), h1 = x1[u] * (1.f + *(const f32x4*)(scl + c + 4)) + *(const f32x4*)(sh + c + 4);
            u32x4 pk; pk[0] = cvt_pk_bf16(h0[0], h0[1]); pk[1] = cvt_pk_bf16(h0[2], h0[3]); pk[2] = cvt_pk_bf16(h1[0], h1[1]); pk[3] = cvt_pk_bf16(h1[2], h1[3]);
            *(u32x4*)(H + (size_t)r * DM + c) = pk; } }
    }
}

__device__ __forceinline__ void attn_item(const Params& p, unsigned char* shm, int item) {
    const int tid = threadIdx.x, wid = tid >> 6, lane = tid & 63, lr = lane & 15, g = lane >> 4;
    const int b = item >> 6, kvh = (item >> 5) & 1, n = item & 31;
    const bf16_t* Z = (const bf16_t*)(p.ws + WS_Z); bf16_t* MIX = (bf16_t*)(p.ws + WS_MIX);
    bf16_t* Ks = (bf16_t*)shm;
    bf16_t* VT = Ks + 256 * 72;
    {
        const int key = tid >> 1, hf = tid & 1;
        const bool valid = (n > 0) || (key >= 128);
        const size_t row = (size_t)b * SEQ + (size_t)(n - 1) * 128 + key;
        const bf16_t* kp = Z + row * INW + 512 + kvh * 64 + hf * 32; const bf16_t* vp = Z + row * INW + 640 + kvh * 64 + hf * 32;
#pragma unroll
        for (int c = 0; c < 4; ++c) {
            u32x4 kv = (u32x4){0u, 0u, 0u, 0u}, vv = (u32x4){0u, 0u, 0u, 0u};
            if (valid) { kv = *(const u32x4*)(kp + c * 8); vv = *(const u32x4*)(vp + c * 8); }
            *(u32x4*)(Ks + key * 72 + hf * 32 + c * 8) = kv;
#pragma unroll
            for (int e = 0; e < 4; ++e) { const int d = hf * 32 + c * 8 + 2 * e; VT[d * 264 + key] = (bf16_t)(vv[e] & 0xffffu); VT[(d + 1) * 264 + key] = (bf16_t)(vv[e] >> 16); }
        }
    }
    __syncthreads();
    for (int qt = 0; qt < 4; ++qt) {
        const int T = wid * 4 + qt, hq = T >> 3, tq = T & 7, t0 = tq * 16, head = kvh * 4 + hq;
        const size_t qrow = (size_t)b * SEQ + (size_t)n * 128 + t0 + lr;
        bf16x8 Qf[2];
#pragma unroll
        for (int kk = 0; kk < 2; ++kk) Qf[kk] = *(const bf16x8*)(Z + qrow * INW + head * 64 + kk * 32 + g * 8);
        const int kt0 = tq < 6 ? tq : 6;
        f32x4 S[10];
#pragma unroll
        for (int jt = 0; jt < 10; ++jt) {
            S[jt] = (f32x4){0.f, 0.f, 0.f, 0.f};
#pragma unroll
            for (int kk = 0; kk < 2; ++kk) {
                const bf16x8 Kf = *(const bf16x8*)(Ks + (16 * (kt0 + jt) + lr) * 72 + kk * 32 + g * 8);
                S[jt] = __builtin_amdgcn_mfma_f32_16x16x32_bf16(Kf, Qf[kk], S[jt], 0, 0, 0);
            }
        }
        const float sink = p.att_sinks[head];
        const int t = t0 + lr;
        float mx = sink;
#pragma unroll
        for (int jt = 0; jt < 10; ++jt)
#pragma unroll
            for (int r = 0; r < 4; ++r) {
                const int i = 16 * (kt0 + jt) + 4 * g + r, dist = 128 + t - i;
                const bool ok = dist >= 0 && dist <= 128 && (n > 0 || i >= 128);
                const float s = ok ? S[jt][r] * 0.125f : -INFINITY;
                S[jt][r] = s; mx = fmaxf(mx, s);
            }
        mx = fmaxf(mx, __shfl_xor(mx, 16)); mx = fmaxf(mx, __shfl_xor(mx, 32));
        float sum = 0.f;
#pragma unroll
        for (int jt = 0; jt < 10; ++jt)
#pragma unroll
            for (int r = 0; r < 4; ++r) { const float e = __expf(S[jt][r] - mx); S[jt][r] = e; sum += e; }
        sum += __shfl_xor(sum, 16); sum += __shfl_xor(sum, 32);
        const float inv = 1.f / (sum + __expf(sink - mx));
        f32x4 O[4];
#pragma unroll
        for (int dt = 0; dt < 4; ++dt) O[dt] = (f32x4){0.f, 0.f, 0.f, 0.f};
#pragma unroll
        for (int jp = 0; jp < 5; ++jp) {
            u32x4 pu; pu[0] = cvt_pk_bf16(S[2 * jp][0] * inv, S[2 * jp][1] * inv); pu[1] = cvt_pk_bf16(S[2 * jp][2] * inv, S[2 * jp][3] * inv);
            pu[2] = cvt_pk_bf16(S[2 * jp + 1][0] * inv, S[2 * jp + 1][1] * inv); pu[3] = cvt_pk_bf16(S[2 * jp + 1][2] * inv, S[2 * jp + 1][3] * inv);
            const bf16x8 Pf = __builtin_bit_cast(bf16x8, pu);
#pragma unroll
            for (int dt = 0; dt < 4; ++dt) {
                const bf16_t* vr = VT + (16 * dt + lr) * 264 + 16 * (kt0 + 2 * jp) + 4 * g;
                const u32x2 a0 = *(const u32x2*)vr, a1 = *(const u32x2*)(vr + 16);
                u32x4 au; au[0] = a0[0]; au[1] = a0[1]; au[2] = a1[0]; au[3] = a1[1];
                O[dt] = __builtin_amdgcn_mfma_f32_16x16x32_bf16(__builtin_bit_cast(bf16x8, au), Pf, O[dt], 0, 0, 0);
            }
        }
#pragma unroll
        for (int dt = 0; dt < 4; ++dt) {
            u32x2 o; o[0] = cvt_pk_bf16(O[dt][0], O[dt][1]); o[1] = cvt_pk_bf16(O[dt][2], O[dt][3]);
            *(u32x2*)(MIX + qrow * DM + head * 64 + 16 * dt + 4 * g) = o;
        }
    }
    __syncthreads();
}

__device__ __forceinline__ void retu_load(const Params& p, int item, u32x4 (&kvr)[4], u32x4 (&vvr)[4]) {
    const int tid = threadIdx.x, b = item >> 7, h = (item >> 5) & 3, c = item & 31;
    const bf16_t* Z = (const bf16_t*)(p.ws + WS_Z);
    const int j = tid >> 2, q = tid & 3;
    const size_t row = (size_t)b * SEQ + (size_t)c * 128 + j;
    const bf16_t* kp = Z + row * INW + 1280 + h * 128 + q * 32; const bf16_t* vp = Z + row * INW + 1792 + h * 128 + q * 32;
#pragma unroll
    for (int cc = 0; cc < 4; ++cc) { kvr[cc] = *(const u32x4*)(kp + cc * 8); vvr[cc] = *(const u32x4*)(vp + cc * 8); }
}
__device__ __forceinline__ void retu_phase(const Params& p, unsigned char* shm, int first, int stride) {
    u32x4 kvr[4], vvr[4];
    if (first < 1024) retu_load(p, first, kvr, vvr);
    for (int item = first; item < 1024; item += stride) {
    const int tid = threadIdx.x, wid = tid >> 6, lane = tid & 63, lr = lane & 15, g = lane >> 4;
    const int h = (item >> 5) & 3;
    float* UT = (float*)(p.ws + WS_H);
    bf16_t* KT = (bf16_t*)shm;
    bf16_t* VT = KT + 128 * 136;
    const float lg = log_gamma(h);
    {
        const int j = tid >> 2, q = tid & 3;
        const float dec = __expf(lg * (float)(127 - j));
#pragma unroll
        for (int cc = 0; cc < 4; ++cc) {
            const u32x4 kv = kvr[cc], vv = vvr[cc];
#pragma unroll
            for (int e = 0; e < 4; ++e) {
                const int d = q * 32 + cc * 8 + 2 * e;
                KT[d * 136 + j] = f2bf(bflo(kv[e]) * dec); KT[(d + 1) * 136 + j] = f2bf(bfhi(kv[e]) * dec);
                VT[d * 136 + j] = (bf16_t)(vv[e] & 0xffffu); VT[(d + 1) * 136 + j] = (bf16_t)(vv[e] >> 16);
            }
        }
    }
    __syncthreads();
    if (item + stride < 1024) retu_load(p, item + stride, kvr, vvr);
    f32x4 acc[8];
#pragma unroll
    for (int dt = 0; dt < 8; ++dt) acc[dt] = (f32x4){0.f, 0.f, 0.f, 0.f};
#pragma unroll
    for (int kk = 0; kk < 4; ++kk) {
        const bf16x8 Bf = *(const bf16x8*)(VT + (16 * wid + lr) * 136 + kk * 32 + g * 8);
#pragma unroll
        for (int dt = 0; dt < 8; ++dt) {
            const bf16x8 Af = *(const bf16x8*)(KT + (16 * dt + lr) * 136 + kk * 32 + g * 8);
            acc[dt] = __builtin_amdgcn_mfma_f32_16x16x32_bf16(Af, Bf, acc[dt], 0, 0, 0);
        }
    }
    float* up = UT + (size_t)item * 16384 + (size_t)(16 * wid + lr) * 128;
#pragma unroll
    for (int dt = 0; dt < 8; ++dt) *(f32x4*)(up + 16 * dt + 4 * g) = acc[dt];
    __syncthreads();
    }
}

__device__ __forceinline__ void phase_scan(const Params& p) {
    const float* UT = (const float*)(p.ws + WS_H); bf16_t* SST = (bf16_t*)(p.ws + WS_SST);
    const int gt = blockIdx.x * 512 + threadIdx.x, gs = gridDim.x * 512;
    for (int i = gt; i < 32 * 4096; i += gs) {
        const int bh = i >> 12, ed = (i & 4095) * 4, e = ed >> 7, d = ed & 127, h = bh & 3;
        const float gL = __expf(log_gamma(h) * 128.f);
        f32x4 s = (f32x4){0.f, 0.f, 0.f, 0.f};
        const float* up = UT + (size_t)bh * 32 * 16384 + ed; bf16_t* sp = SST + (size_t)bh * 32 * 16384 + ed;
#pragma unroll
        for (int c0 = 0; c0 < 32; c0 += 16) {
            f32x4 uv[16];
#pragma unroll
            for (int c = 0; c < 16; ++c) uv[c] = __builtin_nontemporal_load((const f32x4*)(up + (size_t)(c0 + c) * 16384));
#pragma unroll
            for (int c = 0; c < 16; ++c) { u32x2 o; o[0] = cvt_pk_bf16(s[0], s[1]); o[1] = cvt_pk_bf16(s[2], s[3]); *(u32x2*)(sp + (size_t)(c0 + c) * 16384) = o; s = gL * s + uv[c]; }
        }
#pragma unroll
        for (int k = 0; k < 4; ++k) p.out[O_RP + ((size_t)bh * 128 + ret_dim(d + k)) * 128 + e] = s[k];
    }
}

typedef short s16x4 __attribute__((ext_vector_type(4)));
__device__ __forceinline__ u32x2 lds_tr_read(const bf16_t* addr) {
    const s16x4 r = __builtin_amdgcn_ds_read_tr16_b64_v4i16((LAS s16x4*)(LAS void*)(unsigned)(size_t)addr);
    return __builtin_bit_cast(u32x2, r);
}
__device__ __forceinline__ void reto_load(const Params& p, int item, u32x4 (&kv)[4], u32x4 (&vv)[4], u32x4 (&sv)[4]) {
    const int tid = threadIdx.x, b = item >> 7, h = (item >> 5) & 3, c = item & 31;
    const bf16_t* Z = (const bf16_t*)(p.ws + WS_Z); const bf16_t* SST = (const bf16_t*)(p.ws + WS_SST);
    const size_t row0 = (size_t)b * SEQ + (size_t)c * 128;
    const int j = tid >> 2, q = tid & 3;
    const bf16_t* kp = Z + (row0 + j) * INW + 1280 + h * 128 + q * 32; const bf16_t* vp = Z + (row0 + j) * INW + 1792 + h * 128 + q * 32;
    const bf16_t* sp = SST + (size_t)item * 16384 + j * 128 + q * 32;
#pragma unroll
    for (int cc = 0; cc < 4; ++cc) { kv[cc] = *(const u32x4*)(kp + cc * 8); vv[cc] = *(const u32x4*)(vp + cc * 8); sv[cc] = *(const u32x4*)(sp + cc * 8); }
}
__device__ __forceinline__ void reto_phase(const Params& p, unsigned char* shm, int first, int stride) {
    u32x4 kvr[4], vvr[4], svr[4];
    if (first < 1024) reto_load(p, first, kvr, vvr, svr);
    for (int item = first; item < 1024; item += stride) {
    const int tid = threadIdx.x, wid = tid >> 6, lane = tid & 63, lr = lane & 15, g = lane >> 4;
    const int b = item >> 7, h = (item >> 5) & 3, c = item & 31;
    const bf16_t* Z = (const bf16_t*)(p.ws + WS_Z); bf16_t* MIX = (bf16_t*)(p.ws + WS_MIX);
    bf16_t* Ks = (bf16_t*)shm;
    bf16_t* VT = Ks + 128 * 136;
    bf16_t* Ss = VT + 128 * 136;
    const float lg = log_gamma(h);
    const size_t row0 = (size_t)b * SEQ + (size_t)c * 128;
    {
        const int j = tid >> 2, q = tid & 3;
#pragma unroll
        for (int cc = 0; cc < 4; ++cc) {
            *(u32x4*)(Ks + j * 136 + q * 32 + cc * 8) = kvr[cc];
            *(u32x4*)(Ss + j * 136 + q * 32 + cc * 8) = svr[cc];
            *(u32x4*)(VT + j * 136 + q * 32 + cc * 8) = vvr[cc];
        }
    }
    __syncthreads();
    const size_t qrow = row0 + 16 * wid + lr;
    bf16x8 Qf[4];
#pragma unroll
    for (int kk = 0; kk < 4; ++kk) Qf[kk] = *(const bf16x8*)(Z + qrow * INW + 768 + h * 128 + kk * 32 + g * 8);
    if (item + stride < 1024) reto_load(p, item + stride, kvr, vvr, svr);
    f32x4 S[8];
#pragma unroll
    for (int jt = 0; jt < 8; ++jt) {
        S[jt] = (f32x4){0.f, 0.f, 0.f, 0.f};
        if (jt <= wid) {
#pragma unroll
            for (int kk = 0; kk < 4; ++kk) {
                const bf16x8 Kf = *(const bf16x8*)(Ks + (16 * jt + lr) * 136 + kk * 32 + g * 8);
                S[jt] = __builtin_amdgcn_mfma_f32_16x16x32_bf16(Kf, Qf[kk], S[jt], 0, 0, 0);
            }
        }
    }
    const int it = 16 * wid + lr;
#pragma unroll
    for (int jt = 0; jt < 8; ++jt)
#pragma unroll
        for (int r = 0; r < 4; ++r) { const int j = 16 * jt + 4 * g + r; S[jt][r] = (j <= it) ? S[jt][r] * __expf(lg * (float)(it - j)) : 0.f; }
    f32x4 O1[8], O2[8];
#pragma unroll
    for (int et = 0; et < 8; ++et) { O1[et] = (f32x4){0.f, 0.f, 0.f, 0.f}; O2[et] = (f32x4){0.f, 0.f, 0.f, 0.f}; }
#pragma unroll
    for (int jp = 0; jp < 4; ++jp) {
        if (2 * jp <= wid) {
            u32x4 pu; pu[0] = cvt_pk_bf16(S[2 * jp][0], S[2 * jp][1]); pu[1] = cvt_pk_bf16(S[2 * jp][2], S[2 * jp][3]);
            pu[2] = cvt_pk_bf16(S[2 * jp + 1][0], S[2 * jp + 1][1]); pu[3] = cvt_pk_bf16(S[2 * jp + 1][2], S[2 * jp + 1][3]);
            const bf16x8 Pf = __builtin_bit_cast(bf16x8, pu);
#pragma unroll
            for (int et = 0; et < 8; ++et) {
                const bf16_t* vr = VT + (32 * jp + 4 * g + (lr >> 2)) * 136 + 16 * et + 4 * (lr & 3);
                const u32x2 a0 = lds_tr_read(vr), a1 = lds_tr_read(vr + 16 * 136);
                u32x4 au; au[0] = a0[0]; au[1] = a0[1]; au[2] = a1[0]; au[3] = a1[1];
                O1[et] = __builtin_amdgcn_mfma_f32_16x16x32_bf16(__builtin_bit_cast(bf16x8, au), Pf, O1[et], 0, 0, 0);
            }
        }
    }
#pragma unroll
    for (int kk = 0; kk < 4; ++kk)
#pragma unroll
        for (int et = 0; et < 8; ++et) {
            const bf16x8 Sf = *(const bf16x8*)(Ss + (16 * et + lr) * 136 + kk * 32 + g * 8);
            O2[et] = __builtin_amdgcn_mfma_f32_16x16x32_bf16(Sf, Qf[kk], O2[et], 0, 0, 0);
        }
    const float qd = __expf(lg * (float)(it + 1));
    float sum = 0.f;
#pragma unroll
    for (int et = 0; et < 8; ++et)
#pragma unroll
        for (int r = 0; r < 4; ++r) { const float o = O1[et][r] + qd * O2[et][r]; O1[et][r] = o; sum += o; }
    sum += __shfl_xor(sum, 16); sum += __shfl_xor(sum, 32);
    const float mu = sum * (1.f / 128.f);
    float vs = 0.f;
#pragma unroll
    for (int et = 0; et < 8; ++et)
#pragma unroll
        for (int r = 0; r < 4; ++r) { const float dlt = O1[et][r] - mu; vs += dlt * dlt; }
    vs += __shfl_xor(vs, 16); vs += __shfl_xor(vs, 32);
    const float rstd = rsqrtf(vs * (1.f / 128.f) + 1e-6f);
#pragma unroll
    for (int et = 0; et < 8; ++et) {
        const int e = 16 * et + 4 * g;
        const u32x2 gz = *(const u32x2*)(Z + qrow * INW + 2304 + h * 128 + e);
        const f32x4 gw = *(const f32x4*)(p.ret_gn_w + h * 128 + e);
        const float r0 = (O1[et][0] - mu) * rstd * gw[0] * silu_f(bflo(gz[0])), r1 = (O1[et][1] - mu) * rstd * gw[1] * silu_f(bfhi(gz[0]));
        const float r2 = (O1[et][2] - mu) * rstd * gw[2] * silu_f(bflo(gz[1])), r3 = (O1[et][3] - mu) * rstd * gw[3] * silu_f(bfhi(gz[1]));
        u32x2 o; o[0] = cvt_pk_bf16(r0, r1); o[1] = cvt_pk_bf16(r2, r3);
        *(u32x2*)(MIX + qrow * DM + 512 + h * 128 + e) = o;
    }
    __syncthreads();
    }
}

__device__ __forceinline__ void sample_att(const Params& p, unsigned char* shm, int b) {
    const int tid = threadIdx.x, wid = tid >> 6, lane = tid & 63;
    const bf16_t* zrow = (const bf16_t*)(p.ws + WS_Z) + (size_t)(TP + b) * INW; bf16_t* mixrow = (bf16_t*)(p.ws + WS_MIX) + (size_t)(TP + b) * DM;
    float* sm = (float*)shm;
    float* qn = sm;
    float* kn = qn + 512;
    float* vn = kn + 128;
    float* scs = vn + 128;
    { const int hh = tid >> 6, pp = tid & 63; qn[hh * 64 + att_dim(pp)] = bf2f(zrow[tid]); }
    if (tid < 128) { const int hh = tid >> 6, pp = tid & 63; kn[hh * 64 + att_dim(pp)] = bf2f(zrow[512 + tid]); vn[tid] = bf2f(zrow[640 + tid]); }
    __syncthreads();
    const float* ck = p.cache_k + (size_t)b * 128 * 128; const float* cv = p.cache_v + (size_t)b * 128 * 128;
#pragma unroll
    for (int itr = 0; itr < 2; ++itr) {
        const int idx = tid + 512 * itr, hd = idx >> 7, w = idx & 127, kvh = hd >> 2;
        const float* kr = ck + (w * 2 + kvh) * 64; const float* qr = qn + hd * 64;
        float s = 0.f;
#pragma unroll
        for (int d = 0; d < 64; d += 4) { const f32x4 kv = *(const f32x4*)(kr + d); s += qr[d] * kv[0] + qr[d + 1] * kv[1] + qr[d + 2] * kv[2] + qr[d + 3] * kv[3]; }
        scs[hd * 132 + w] = s * 0.125f;
    }
    if (tid < 8) { const int kvh = tid >> 2; float s = 0.f; for (int d = 0; d < 64; ++d) s += qn[tid * 64 + d] * kn[kvh * 64 + d]; scs[tid * 132 + 128] = s * 0.125f; }
    __syncthreads();
    {
        const float sink = p.att_sinks[wid];
        const float s0 = scs[wid * 132 + lane], s1 = scs[wid * 132 + 64 + lane], s2 = lane == 0 ? scs[wid * 132 + 128] : -INFINITY;
        float mx = fmaxf(fmaxf(s0, s1), fmaxf(s2, sink));
#pragma unroll
        for (int o = 32; o >= 1; o >>= 1) mx = fmaxf(mx, __shfl_xor(mx, o));
        const float e0 = __expf(s0 - mx), e1 = __expf(s1 - mx), e2 = lane == 0 ? __expf(s2 - mx) : 0.f;
        float sum = e0 + e1 + e2;
#pragma unroll
        for (int o = 32; o >= 1; o >>= 1) sum += __shfl_xor(sum, o);
        const float inv = 1.f / (sum + __expf(sink - mx));
        scs[wid * 132 + lane] = e0 * inv; scs[wid * 132 + 64 + lane] = e1 * inv; if (lane == 0) scs[wid * 132 + 128] = e2 * inv;
    }
    __syncthreads();
    {
        const int hd = tid >> 6, d = tid & 63, kvh = hd >> 2;
        float o = scs[hd * 132 + 128] * vn[kvh * 64 + d];
#pragma unroll 16
        for (int w = 0; w < 128; ++w) o += scs[hd * 132 + w] * cv[(w * 2 + kvh) * 64 + d];
        mixrow[hd * 64 + d] = f2bf(o);
    }
    for (int i = tid; i < 127 * 32; i += 512) {
        *(f32x4*)(p.out + O_KS + (size_t)b * 16384 + i * 4) = *(const f32x4*)(ck + 128 + i * 4);
        *(f32x4*)(p.out + O_VS + (size_t)b * 16384 + i * 4) = *(const f32x4*)(cv + 128 + i * 4);
    }
    __syncthreads();
}
__device__ __forceinline__ void sample_ret(const Params& p, unsigned char* shm, int item) {
    const int tid = threadIdx.x, b = item >> 2, h = item & 3;
    const bf16_t* zrow = (const bf16_t*)(p.ws + WS_Z) + (size_t)(TP + b) * INW; bf16_t* mixrow = (bf16_t*)(p.ws + WS_MIX) + (size_t)(TP + b) * DM;
    float* sm = (float*)shm;
    float* rqn = sm;
    float* rkn = rqn + 128;
    float* red = rkn + 128;
    float* qkp = red + 512;
    float* ov = qkp + 4;
    if (tid < 128) { const int dn = ret_dim(tid); rqn[dn] = bf2f(zrow[768 + h * 128 + tid]); rkn[dn] = bf2f(zrow[1280 + h * 128 + tid]); }
    __syncthreads();
    const float gm = __expf(log_gamma(h));
    const int e = tid & 127, dq = tid >> 7;
    const float* sp = p.state_ret + ((size_t)(b * 4 + h) * 128 + dq * 32) * 128 + e;
    float* so = p.out + O_RS + ((size_t)(b * 4 + h) * 128 + dq * 32) * 128 + e;
    const float ve = bf2f(zrow[1792 + h * 128 + e]);
    float sv[32];
#pragma unroll
    for (int d = 0; d < 32; ++d) sv[d] = sp[d * 128];
    float part = 0.f, qk = 0.f;
#pragma unroll
    for (int d = 0; d < 32; ++d) { const float qd = rqn[dq * 32 + d], kd = rkn[dq * 32 + d]; part += qd * sv[d]; qk += qd * kd; so[d * 128] = gm * sv[d] + kd * ve; }
    red[dq * 128 + e] = part; if (e == 0) qkp[dq] = qk;
    __syncthreads();
    if (tid < 128) ov[tid] = (qkp[0] + qkp[1] + qkp[2] + qkp[3]) * ve + gm * (red[e] + red[128 + e] + red[256 + e] + red[384 + e]);
    __syncthreads();
    if (tid < 64) {
        const float o0 = ov[tid], o1 = ov[tid + 64];
        float sum = o0 + o1;
#pragma unroll
        for (int o = 32; o >= 1; o >>= 1) sum += __shfl_xor(sum, o);
        const float mu = sum * (1.f / 128.f);
        float vs = (o0 - mu) * (o0 - mu) + (o1 - mu) * (o1 - mu);
#pragma unroll
        for (int o = 32; o >= 1; o >>= 1) vs += __shfl_xor(vs, o);
        const float rstd = rsqrtf(vs * (1.f / 128.f) + 1e-6f);
#pragma unroll
        for (int k = 0; k < 2; ++k) { const int ee = tid + 64 * k; const float gz = bf2f(zrow[2304 + h * 128 + ee]);
            mixrow[512 + h * 128 + ee] = f2bf(((k ? o1 : o0) - mu) * rstd * p.ret_gn_w[h * 128 + ee] * silu_f(gz)); }
    }
    __syncthreads();
}

template <int NB>
__device__ __forceinline__ void sg_mma(unsigned char* shm, const bf16_t* A, const bf16_t* b0, const bf16_t* b1, int K, f32x4& out0, f32x4& out1) {
    const int tid = threadIdx.x, wid = tid >> 6, lane = tid & 63, lr = lane & 15, g = lane >> 4;
    const int ks = K >> 3;
    const bf16_t* ap = A + (size_t)(TP + lr) * K + 8 * g + wid * ks;
    b0 += wid * ks; if (NB == 2) b1 += wid * ks;
    f32x4 acc[8][NB];
#pragma unroll
    for (int rg = 0; rg < 8; ++rg)
#pragma unroll
        for (int nb = 0; nb < NB; ++nb) acc[rg][nb] = (f32x4){0.f, 0.f, 0.f, 0.f};
    for (int k = 0; k < ks; k += 32) {
        const bf16x8 w0 = *(const bf16x8*)(b0 + k);
        bf16x8 w1 = w0; if (NB == 2) w1 = *(const bf16x8*)(b1 + k);
        bf16x8 a[8];
#pragma unroll
        for (int rg = 0; rg < 8; ++rg) a[rg] = *(const bf16x8*)(ap + (size_t)(16 * rg) * K + k);
#pragma unroll
        for (int rg = 0; rg < 8; ++rg) {
            acc[rg][0] = __builtin_amdgcn_mfma_f32_16x16x32_bf16(w0, a[rg], acc[rg][0], 0, 0, 0);
            if (NB == 2) acc[rg][NB - 1] = __builtin_amdgcn_mfma_f32_16x16x32_bf16(w1, a[rg], acc[rg][NB - 1], 0, 0, 0);
        }
    }
    f32x4* red = (f32x4*)shm;
#pragma unroll
    for (int nb = 0; nb < NB; ++nb) {
        __syncthreads();
#pragma unroll
        for (int rg = 0; rg < 8; ++rg) red[(wid * 8 + rg) * 64 + lane] = acc[rg][nb];
        __syncthreads();
        f32x4 sum = red[(0 * 8 + wid) * 64 + lane];
#pragma unroll
        for (int w = 1; w < 8; ++w) sum += red[(w * 8 + wid) * 64 + lane];
        if (nb == 0) out0 = sum; else out1 = sum;
    }
    __syncthreads();
}
__device__ __forceinline__ void sg_ln(const Params& p, unsigned char* shm, int item, const bf16_t* A, const bf16_t* Bt, int K, const float* base, int gate_off, float* stat, unsigned* cnt,
                                      const float* lw, const float* lb, bf16_t* H, int h_off) {
    const int tid = threadIdx.x, wid = tid >> 6, lane = tid & 63, lr = lane & 15, g = lane >> 4;
    const int n0 = item * 16, m = 16 * wid + lr;
    f32x4 acc = (f32x4){0.f, 0.f, 0.f, 0.f}, dummy = acc;
    sg_mma<1>(shm, A, Bt + (size_t)(n0 + lr) * K + 8 * g, nullptr, K, acc, dummy);
    const int c = n0 + 4 * g;
    const float* mrow = (const float*)(p.ws + WS_MOD) + (size_t)m * 6144;
    const f32x4 xv = *(const f32x4*)(base + (size_t)m * DM + c), gv = *(const f32x4*)(mrow + gate_off + c);
    const f32x4 res = ALPHA * xv + (1.f + gv) * acc;
    float s = res[0] + res[1] + res[2] + res[3], ss = res[0] * res[0] + res[1] * res[1] + res[2] * res[2] + res[3] * res[3];
    s += __shfl_xor(s, 16); ss += __shfl_xor(ss, 16); s += __shfl_xor(s, 32); ss += __shfl_xor(ss, 32);
    if (g == 0) { __hip_atomic_fetch_add(stat + 2 * (TP + m), s, __ATOMIC_RELAXED, __HIP_MEMORY_SCOPE_AGENT); __hip_atomic_fetch_add(stat + 2 * (TP + m) + 1, ss, __ATOMIC_RELAXED, __HIP_MEMORY_SCOPE_AGENT); }
    asm volatile("s_waitcnt vmcnt(0)" ::: "memory");
    unsigned* pc = cnt + wid * 16;
    if (lane == 0) __hip_atomic_fetch_add(pc, 1u, __ATOMIC_RELAXED, __HIP_MEMORY_SCOPE_AGENT);
    wait_ge(pc, 64u, (unsigned*)(p.ws + WS_CNT) + 527 * 16 + 8);
    asm volatile("" ::: "memory");
    const float sa = __hip_atomic_load(stat + 2 * (TP + m), __ATOMIC_RELAXED, __HIP_MEMORY_SCOPE_AGENT), sb = __hip_atomic_load(stat + 2 * (TP + m) + 1, __ATOMIC_RELAXED, __HIP_MEMORY_SCOPE_AGENT);
    const float mu = sa * (1.f / 1024.f), var = sb * (1.f / 1024.f) - mu * mu, rstd = rsqrtf(fmaxf(var, 0.f) + 1e-5f);
    const f32x4 y = (res - mu) * rstd * *(const f32x4*)(lw + c) + *(const f32x4*)(lb + c);
    *(f32x4*)(p.out + O_YS + (size_t)m * DM + c) = y;
    if (H) { const f32x4 hv = y * (1.f + *(const f32x4*)(mrow + h_off + 1024 + c)) + *(const f32x4*)(mrow + h_off + c);
             u32x2 o; o[0] = cvt_pk_bf16(hv[0], hv[1]); o[1] = cvt_pk_bf16(hv[2], hv[3]); *(u32x2*)(H + (size_t)(TP + m) * DM + c) = o; }
}
__device__ __forceinline__ void sg_up(const Params& p, unsigned char* shm, int item) {
    const int tid = threadIdx.x, wid = tid >> 6, lane = tid & 63, lr = lane & 15, g = lane >> 4;
    const int n0 = item * 16, m = 16 * wid + lr, pn = n0 >> 7, off = n0 & 127;
    const bf16_t* A = (const bf16_t*)(p.ws + WS_H); const bf16_t* Bt = (const bf16_t*)(p.ws + WS_WUP);
    f32x4 ag = (f32x4){0.f, 0.f, 0.f, 0.f}, au = ag;
    sg_mma<2>(shm, A, Bt + (size_t)(256 * pn + off + lr) * DM + 8 * g, Bt + (size_t)(256 * pn + 128 + off + lr) * DM + 8 * g, DM, ag, au);
    u32x2 o; o[0] = cvt_pk_bf16(silu_f(ag[0]) * au[0], silu_f(ag[1]) * au[1]); o[1] = cvt_pk_bf16(silu_f(ag[2]) * au[2], silu_f(ag[3]) * au[3]);
    *(u32x2*)((bf16_t*)(p.ws + WS_Z) + (size_t)(TP + m) * DFF + n0 + 4 * g) = o;
}

#define XB_TMO      128
#define XB_XCNT(j)  (256  + 64 * (j))
#define XB_XSUB(j)  (1280 + 64 * (j))
#define XB_XGEN(j)  (2304 + 64 * (j))
#define XB_TOP      3328
#define XB_TOPGEN   3392
#define XCD_BAR_WORDS 3456
#define XB_SPIN_CAP (1u << 18)
__device__ __forceinline__ unsigned xb_ld(unsigned* p)              { return __hip_atomic_load(p, __ATOMIC_RELAXED, __HIP_MEMORY_SCOPE_AGENT); }
__device__ __forceinline__ unsigned xb_add(unsigned* p, unsigned v) { return __hip_atomic_fetch_add(p, v, __ATOMIC_RELAXED, __HIP_MEMORY_SCOPE_AGENT); }
__device__ __forceinline__ unsigned xb_xcc_id() { return (unsigned)__builtin_amdgcn_s_getreg((3 << 11) | 20) & 0xFu; }
#define XB_SPIN(cond, bar) do { unsigned _sp = 0; while (cond) { __builtin_amdgcn_s_sleep(1); \
    if ((++_sp & 255u) == 0u) { if (xb_ld(&(bar)[XB_TMO])) break; if (_sp > XB_SPIN_CAP) { atomicAdd(&(bar)[XB_TMO], 1u); break; } } } } while (0)
struct XcdBarrier { unsigned* bar; unsigned x; volatile LAS unsigned* st; };
__device__ __forceinline__ XcdBarrier xcd_barrier_post(unsigned* bar, volatile LAS unsigned* st) {
    XcdBarrier b; b.bar = bar; b.x = xb_xcc_id(); b.st = st;
    if (threadIdx.x == 0) (void)xb_add(&bar[XB_XCNT(b.x)], 1u);
    return b;
}
__device__ __forceinline__ void xcd_barrier_complete(unsigned* bar, unsigned x, unsigned& nloc, unsigned& nx) {
    const unsigned G = gridDim.x * gridDim.y * gridDim.z;
    unsigned sum, cnt, mine, sp = 0u;
    for (;;) {
        sum = 0u; cnt = 0u; mine = 0u;
#pragma unroll
        for (unsigned j = 0; j < 16; ++j) { const unsigned c = xb_ld(&bar[XB_XCNT(j)]); sum += c; cnt += (c > 0u) ? 1u : 0u; mine = (j == x) ? c : mine; }
        if (sum == G) break;
        __builtin_amdgcn_s_sleep(1);
        if ((++sp & 255u) == 0u) { if (xb_ld(&bar[XB_TMO])) break; if (sp > XB_SPIN_CAP) { atomicAdd(&bar[XB_TMO], 1u); break; } }
    }
    nloc = mine > 0u ? mine : 1u; nx = cnt > 0u ? cnt : 1u;
}
__device__ __forceinline__ void xcd_barrier(const XcdBarrier& b) {
    asm volatile("s_waitcnt vmcnt(0)" ::: "memory");
    __syncthreads();
    if (threadIdx.x == 0) {
        unsigned* bar = b.bar;
        __builtin_amdgcn_s_waitcnt(0);
        unsigned nloc = b.st[0], nx = b.st[1];
        if (nloc == 0u) { xcd_barrier_complete(bar, b.x, nloc, nx); b.st[0] = nloc; b.st[1] = nx; }
        const unsigned old = xb_add(&bar[XB_XSUB(b.x)], 1u);
        const unsigned gen = old / nloc;
        if (old + 1u == (gen + 1u) * nloc) {
            __builtin_amdgcn_fence(__ATOMIC_RELEASE, "agent");
            asm volatile("s_waitcnt vmcnt(0)" ::: "memory");
            const unsigned og = xb_add(&bar[XB_TOP], 1u);
            const unsigned tg = og / nx;
            if (og + 1u == (tg + 1u) * nx) xb_add(&bar[XB_TOPGEN], 1u);
            else XB_SPIN(xb_ld(&bar[XB_TOPGEN]) == tg, bar);
            __builtin_amdgcn_fence(__ATOMIC_ACQUIRE, "agent");
            xb_add(&bar[XB_XGEN(b.x)], 1u);
            asm volatile("s_waitcnt vmcnt(0)" ::: "memory");
        } else {
            XB_SPIN(xb_ld(&bar[XB_XGEN(b.x)]) == gen, bar);
            __builtin_amdgcn_fence(__ATOMIC_ACQUIRE, "agent");
            asm volatile("s_waitcnt vmcnt(0)" ::: "memory");
        }
    }
    __syncthreads();
}

typedef __attribute__((address_space(4))) const unsigned char* kptr_t;
__device__ __forceinline__ Params load_params() {
#if defined(__HIP_DEVICE_COMPILE__)
    kptr_t k = (kptr_t)__builtin_amdgcn_kernarg_segment_ptr();
    asm volatile("" : "+s"(k));
    Params r;
    __builtin_memcpy(&r, (const __attribute__((address_space(4))) void*)k, sizeof(Params));
    return r;
#else
    return Params{};
#endif
}
__global__ void __launch_bounds__(512, 2) fwd(Params p_arg, int ph_lo, int ph_hi, int coop) {
    extern __shared__ __attribute__((aligned(16))) unsigned char shm[];
    cg::grid_group grid = cg::this_grid();
    LAS unsigned char* lds = (LAS unsigned char*)shm;
    const int G = gridDim.x, bid = blockIdx.x;
    volatile LAS unsigned* bst = (volatile LAS unsigned*)(lds + 131072);
    if (threadIdx.x < 4) bst[threadIdx.x] = 0u;
    __syncthreads();
    (void)xcd_barrier_post((unsigned*)(p_arg.ws + WS_BAR), bst);
    if (coop > 1) grid.sync();
#define GSYNC() do { XcdBarrier xb_; xb_.bar = (unsigned*)(load_params().ws + WS_BAR); xb_.x = xb_xcc_id(); xb_.st = (volatile LAS unsigned*)((LAS unsigned char*)shm + 131072); xcd_barrier(xb_); } while (0)
#ifndef ONLY
#define ONLY -1
#endif
#ifndef UPWGM
#define UPWGM 4
#endif
#ifndef REP_PH
#define REP_PH -1
#endif
#ifndef REP_SYNC
#define REP_SYNC 0
#endif
#define PH_BEGIN(n) if ((ONLY < 0 || ONLY == n) && ph_lo <= n && n < ph_hi) { if (n > ph_lo && coop) GSYNC(); for (int rep_ = 0; rep_ < (REP_PH == n ? 2 : 1); ++rep_) { if (rep_) GSYNC(); const Params p = load_params();
#define PH_END } }
    for (int i_ = 0; i_ < REP_SYNC; ++i_) GSYNC();
    PH_BEGIN(0) { prep_tiles(p, shm, 768 + bid, 1152, G); prep_misc(p); } PH_END
    PH_BEGIN(1) { if (bid >= 24) prep_tiles(p, shm, bid - 24, 768, G - 24);
                  pg8::Gemm g{(const bf16_t*)(p.ws + WS_SC), (const bf16_t*)(p.ws + WS_WADA), 256, 6144, DM}; pg8::StaticOrder S; S.init(g.M, g.N, G, bid);
                  EpiAda E{(float*)(p.ws + WS_MOD), p.b_ada_mix, p.b_ada_ffn}; pg8::gemm_phase(lds, g, S, E); } PH_END
    PH_BEGIN(2) phase_modulate(p); PH_END
    PH_BEGIN(3) { pg8::Gemm g{(const bf16_t*)(p.ws + WS_H), (const bf16_t*)(p.ws + WS_WIN), TPAD, INW, DM}; pg8::StaticOrder S; S.init(g.M, g.N, G, bid);
                  EpiIn E{(bf16_t*)(p.ws + WS_Z), (const float*)(p.ws + WS_ROPEA), (const float*)(p.ws + WS_ROPER), p.out}; pg8::gemm_phase(lds, g, S, E); } PH_END
    PH_BEGIN(4) { retu_phase(p, shm, bid, G); for (int it = bid; it < 512; it += G) attn_item(p, shm, it); for (int it = G - 1 - bid; it < 512; it += G) sample_ret(p, shm, it); for (int it = bid; it < 128; it += G) sample_att(p, shm, it); } PH_END
    PH_BEGIN(5) phase_scan(p); PH_END
    PH_BEGIN(6) reto_phase(p, shm, bid, G); PH_END
    PH_BEGIN(7) { for (int it = G - 1 - bid; it < 64; it += G) sg_ln(p, shm, it, (const bf16_t*)(p.ws + WS_MIX), (const bf16_t*)(p.ws + WS_WOUT), DM, p.x_sample, 2048, (float*)(p.ws + WS_STAT1),
                                                                       (unsigned*)(p.ws + WS_CNT) + 512 * 16, p.ln1_w, p.ln1_b, (bf16_t*)(p.ws + WS_H), 3072);
                  pg8::Gemm g{(const bf16_t*)(p.ws + WS_MIX), (const bf16_t*)(p.ws + WS_WOUT), TP, DM, DM}; pg8::StaticOrder S; S.init(g.M, g.N, G, bid);
                  EpiLn<false, true> E{p.x_prompt, p.ws + WS_MIX, (const float*)(p.ws + WS_MOD), 2048, (float*)(p.ws + WS_STAT1), (unsigned*)(p.ws + WS_CNT), p.ln1_w, p.ln1_b, (bf16_t*)(p.ws + WS_H), 3072, (unsigned*)(p.ws + WS_CNT) + 527 * 16 + 8};
                  pg8::gemm_phase(lds, g, S, E); } PH_END
    PH_BEGIN(9) { for (int it = G - 1 - bid; it < 176; it += G) sg_up(p, shm, it);
                  pg8::Gemm g{(const bf16_t*)(p.ws + WS_H), (const bf16_t*)(p.ws + WS_WUP), TP, 2 * DFF, DM}; pg8::StaticOrder S; S.init(g.M, g.N, G, bid, UPWGM);
                  EpiUp E{(bf16_t*)(p.ws + WS_Z)}; pg8::gemm_phase(lds, g, S, E); } PH_END
    PH_BEGIN(10) { for (int it = G - 1 - bid; it < 64; it += G) sg_ln(p, shm, it, (const bf16_t*)(p.ws + WS_Z), (const bf16_t*)(p.ws + WS_WDOWN), DFF, p.out + O_YS, 3072 + 2048, (float*)(p.ws + WS_STAT2),
                                                                        (unsigned*)(p.ws + WS_CNT) + 520 * 16, p.ln2_w, p.ln2_b, nullptr, 0);
                   pg8::Gemm g{(const bf16_t*)(p.ws + WS_Z), (const bf16_t*)(p.ws + WS_WDOWN), TP, DM, DFF}; pg8::StaticOrder S; S.init(g.M, g.N, G, bid);
                   EpiLn<true, false> E{p.ws + WS_MIX, p.out, (const float*)(p.ws + WS_MOD), 3072 + 2048, (float*)(p.ws + WS_STAT2), (unsigned*)(p.ws + WS_CNT) + 256 * 16, p.ln2_w, p.ln2_b, nullptr, 0, (unsigned*)(p.ws + WS_CNT) + 527 * 16 + 8};
                   pg8::gemm_phase(lds, g, S, E); } PH_END
}

extern "C" void kernel_launch(void* const* d_in, const int* in_sizes, int n_in, void* d_out, int out_size, void* d_ws, size_t ws_size, hipStream_t stream) {
    constexpr int LDS_BYTES = 131072 + 64;
    static int grid = 0;
    if (!grid) {
        int dev = 0, cus = 0, per_cu = 0;
        (void)hipGetDevice(&dev);
        (void)hipDeviceGetAttribute(&cus, hipDeviceAttributeMultiprocessorCount, dev);
        (void)hipFuncSetAttribute((const void*)fwd, hipFuncAttributeMaxDynamicSharedMemorySize, LDS_BYTES);
        (void)hipOccupancyMaxActiveBlocksPerMultiprocessor(&per_cu, (const void*)fwd, 512, LDS_BYTES);
        grid = cus > 0 ? cus : 256;
        if (ws_size < WS_END) fprintf(stderr, "kernel_launch: workspace too small: %zu < %zu\n", ws_size, (size_t)WS_END);
        fprintf(stderr, "kernel_launch: cus %d per_cu %d grid %d ws %zu need %zu\n", cus, per_cu, grid, ws_size, (size_t)WS_END);
    }
    Params p{};
    const float** f = (const float**)&p;
    for (int i = 0; i < 21; ++i) f[i] = (const float*)d_in[i];
    p.out = (float*)d_out; p.ws = (unsigned char*)d_ws;
#ifndef MULTI_LAUNCH
    (void)hipMemsetAsync((unsigned char*)d_ws + WS_BAR, 0, 16384, stream);
    int lo = 0, hi = 12, coop = 1;
    void* args[] = {&p, &lo, &hi, &coop};
    hipError_t e = hipLaunchCooperativeKernel((const void*)fwd, dim3(grid), dim3(512), args, LDS_BYTES, stream);
    if (e != hipSuccess) fprintf(stderr, "cooperative launch failed: %s (grid %d)\n", hipGetErrorString(e), grid);
#else
    for (int ph = 0; ph < 12; ++ph) hipLaunchKernelGGL(fwd, dim3(grid), dim3(512), LDS_BYTES, stream, p, ph, ph + 1, 0);
#endif
}
```
